# Optimizing an MI355X kernel written in HIP

```python
import math
import jax, jax.numpy as jnp
from jax import lax
import numpy as np

D_MODEL = 2048
BATCH = 4
SEQ = 8192
DEPTH = 4

HEAD_DIM = 128
N_HEADS_SB = 4
N_HEADS_DIL = 4
D_SB = N_HEADS_SB * HEAD_DIM
D_DIL = N_HEADS_DIL * HEAD_DIM
D_MIX = D_SB + D_DIL
D_IN = 3 * D_MIX
DILATED_CONFIGS = ((128, 1), (512, 4), (2048, 16))
SB_BLOCK = 128
D_FF = 5632
D_FF_EXPERT = 1408
N_EXPERTS = 8
TOP_K = 2
ROPE_THETA = 10000.0
EPS = 1e-6
NEG_INF = -1e30
N_DENSE = (DEPTH + 1) // 2
N_MOE = DEPTH // 2

kernel_name = "hymba_stickbreak_dilated_moe_trunk"


def rmsnorm(x, g):
    x32 = x.astype(jnp.float32)
    y = x32 * lax.rsqrt(jnp.mean(x32 * x32, axis=-1, keepdims=True) + EPS)
    return (y * g.astype(jnp.float32)).astype(x.dtype)


def rope_tables(positions):
    inv = ROPE_THETA ** (-jnp.arange(0, HEAD_DIM, 2, dtype=jnp.float32) / HEAD_DIM)
    ang = positions.astype(jnp.float32)[..., None] * inv
    cos = jnp.concatenate([jnp.cos(ang), jnp.cos(ang)], -1)[:, :, None, :]
    sin = jnp.concatenate([jnp.sin(ang), jnp.sin(ang)], -1)[:, :, None, :]
    return cos, sin


def apply_rope(x, cos, sin):
    x32 = x.astype(jnp.float32)
    x1, x2 = jnp.split(x32, 2, axis=-1)
    rot = jnp.concatenate([-x2, x1], axis=-1)
    return (x32 * cos + rot * sin).astype(x.dtype)


def stick_breaking(q, k, v):
    B, S, H, dh = q.shape
    C = SB_BLOCK
    nb = S // C
    scale = 1.0 / math.sqrt(dh)
    qt = q.astype(jnp.float32).transpose(0, 2, 1, 3) * scale
    kt = k.astype(jnp.float32).transpose(0, 2, 1, 3)
    vt = v.astype(jnp.float32).transpose(0, 2, 1, 3)
    ar = jnp.arange(C)
    incl = (ar[:, None] >= ar[None, :]).astype(jnp.float32)
    strict = ar[:, None] > ar[None, :]
    outs = []
    for n in range(nb):
        qn = qt[:, :, n * C:(n + 1) * C]
        z_d = jnp.einsum('bhtd,bhsd->bhts', qn, kt[:, :, n * C:(n + 1) * C])
        sp_d = jnp.where(strict, jnp.log1p(jnp.exp(z_d)), 0.0)
        r_d = jnp.einsum('bhtj,js->bhts', sp_d, incl)
        a_d = jnp.where(strict, jnp.exp(z_d - r_d), 0.0)
        o = jnp.einsum('bhts,bhsd->bhtd', a_d, vt[:, :, n * C:(n + 1) * C])
        if n > 0:
            ko = kt[:, :, :n * C].reshape(B, H, n, C, dh)
            vo = vt[:, :, :n * C].reshape(B, H, n, C, dh)
            z_o = jnp.einsum('bhtd,bhcsd->bhtcs', qn, ko)
            sp_o = jnp.log1p(jnp.exp(z_o))
            r_o = jnp.einsum('bhtcj,js->bhtcs', sp_o, incl)
            tot = r_o[..., 0]
            later = lax.cumsum(tot, axis=3, reverse=True) - tot + r_d[..., :1]
            a_o = jnp.exp(z_o - r_o - later[..., None])
            o = o + jnp.einsum('bhtcs,bhcsd->bhtd', a_o, vo)
        outs.append(o)
    o = jnp.concatenate(outs, axis=2)
    return o.transpose(0, 2, 1, 3).reshape(B, S, H * dh).astype(q.dtype)


def dilated_branch(q, k, v, steps, dil):
    B, S, H, dh = q.shape
    span = steps * dil
    Sp = -(-S // span) * span
    pad = [(0, 0), (0, Sp - S), (0, 0), (0, 0)]
    L = Sp // dil
    nb = L // steps
    scale = 1.0 / math.sqrt(dh)

    def regroup(t):
        t = jnp.pad(t.astype(jnp.float32), pad)
        return t.reshape(B, L, dil, H, dh).transpose(0, 2, 1, 3, 4).reshape(B, dil, nb, steps, H, dh)

    def with_prev(t):
        prev = jnp.concatenate([jnp.zeros_like(t[:, :, :1]), t[:, :, :-1]], axis=2)
        return jnp.concatenate([prev, t], axis=3)

    qs = regroup(q)
    kk = with_prev(regroup(k))
    vv = with_prev(regroup(v))
    s = jnp.einsum('brnqhd,brnkhd->brnhqk', qs, kk) * scale
    qi = jnp.arange(steps)[:, None]
    ki = jnp.arange(2 * steps)[None, :]
    dist = qi + steps - ki
    band = (dist >= 0) & (dist <= steps)
    has_prev = (jnp.arange(nb)[:, None, None] > 0) | (ki[None] >= steps)
    mask = (band[None] & has_prev)[:, None]
    s = jnp.where(mask, s, NEG_INF)
    m = jnp.max(s, axis=-1, keepdims=True)
    p = jnp.exp(s - m)
    den = jnp.sum(p, axis=-1, keepdims=True)
    o = jnp.einsum('brnhqk,brnkhd->brnqhd', p / den, vv)
    lse = (m + jnp.log(den))[..., 0]
    o = o.reshape(B, dil, L, H, dh).transpose(0, 2, 1, 3, 4).reshape(B, Sp, H, dh)[:, :S]
    lse = lse.transpose(0, 1, 2, 4, 3).reshape(B, dil, L, H).transpose(0, 2, 1, 3).reshape(B, Sp, H)[:, :S]
    return o, lse


def dilated_attention(q, k, v):
    B, S, H, dh = q.shape
    outs, lses = [], []
    for window, dil in DILATED_CONFIGS:
        o, l = dilated_branch(q, k, v, window // dil, dil)
        outs.append(o)
        lses.append(l)
    alpha = jax.nn.softmax(jnp.stack(lses, 0), axis=0)
    o = jnp.einsum('gbsh,gbshd->bshd', alpha, jnp.stack(outs, 0))
    return o.reshape(B, S, H * dh).astype(q.dtype)


def mixer_layer(x, cos, sin, g_norm, w_in, q_norm_sb, k_norm_sb, q_norm_dil, k_norm_dil,
                g_out_sb, g_out_dil, w_out):
    B, S, _ = x.shape
    h = rmsnorm(x, g_norm) @ w_in
    qa, ka, va, qb, kb, vb = jnp.split(
        h, [D_SB, 2 * D_SB, 3 * D_SB, 3 * D_SB + D_DIL, 3 * D_SB + 2 * D_DIL], axis=-1)
    heads = lambda t: t.reshape(B, S, -1, HEAD_DIM)
    o_sb = stick_breaking(rmsnorm(heads(qa), q_norm_sb), rmsnorm(heads(ka), k_norm_sb),
                          heads(va))
    qb = apply_rope(rmsnorm(heads(qb), q_norm_dil), cos, sin)
    kb = apply_rope(rmsnorm(heads(kb), k_norm_dil), cos, sin)
    o_dil = dilated_attention(qb, kb, heads(vb))
    o = jnp.concatenate([rmsnorm(o_sb, g_out_sb), rmsnorm(o_dil, g_out_dil)], axis=-1)
    return x + o @ w_out


def swiglu(x, wg, wu, wd):
    return (jax.nn.silu(x @ wg) * (x @ wu)) @ wd


def moe(xn, w_router, wg, wu, wd):
    B, S, D = xn.shape
    t = xn.reshape(-1, D)
    logits = (t @ w_router).astype(jnp.float32)
    top_vals, top_idx = lax.top_k(logits, TOP_K)
    gates = jax.nn.softmax(top_vals, axis=-1)
    comb = jnp.einsum('nk,nke->ne', gates, jax.nn.one_hot(top_idx, N_EXPERTS, dtype=jnp.float32))
    y = jnp.zeros_like(t)
    for e in range(N_EXPERTS):
        y = y + comb[:, e:e + 1].astype(t.dtype) * swiglu(t, wg[e], wu[e], wd[e])
    return y.reshape(B, S, D)


def setup_inputs(seed: int = 0) -> dict:
    key = jax.random.key(seed)
    ks = jax.random.split(key, 20)
    f32 = jnp.float32
    nrm = lambda k, shape, fan_in: jax.random.normal(k, shape, f32) * fan_in ** -0.5
    gain = lambda k, shape: 1.0 + 0.02 * jax.random.normal(k, shape, f32)
    x = jax.random.normal(ks[0], (BATCH, SEQ, D_MODEL), f32)
    positions = jnp.broadcast_to(jnp.arange(SEQ, dtype=jnp.int32)[None, :], (BATCH, SEQ))
    return {
        "x": x,
        "positions": positions,
        "norm_mix": gain(ks[1], (DEPTH, D_MODEL)),
        "w_in": nrm(ks[2], (DEPTH, D_MODEL, D_IN), D_MODEL),
        "q_norm_sb": gain(ks[3], (DEPTH, HEAD_DIM)),
        "k_norm_sb": gain(ks[4], (DEPTH, HEAD_DIM)),
        "q_norm_dil": gain(ks[5], (DEPTH, HEAD_DIM)),
        "k_norm_dil": gain(ks[6], (DEPTH, HEAD_DIM)),
        "out_norm_sb": gain(ks[7], (DEPTH, D_SB)),
        "out_norm_dil": gain(ks[8], (DEPTH, D_DIL)),
        "w_out": nrm(ks[9], (DEPTH, D_MIX, D_MODEL), D_MIX),
        "norm_ffn": gain(ks[10], (DEPTH, D_MODEL)),
        "w_gate_dense": nrm(ks[11], (N_DENSE, D_MODEL, D_FF), D_MODEL),
        "w_up_dense": nrm(ks[12], (N_DENSE, D_MODEL, D_FF), D_MODEL),
        "w_down_dense": nrm(ks[13], (N_DENSE, D_FF, D_MODEL), D_FF),
        "w_router": nrm(ks[14], (N_MOE, D_MODEL, N_EXPERTS), D_MODEL),
        "w_gate_moe": nrm(ks[15], (N_MOE, N_EXPERTS, D_MODEL, D_FF_EXPERT), D_MODEL),
        "w_up_moe": nrm(ks[16], (N_MOE, N_EXPERTS, D_MODEL, D_FF_EXPERT), D_MODEL),
        "w_down_moe": nrm(ks[17], (N_MOE, N_EXPERTS, D_FF_EXPERT, D_MODEL), D_FF_EXPERT),
    }


def reference(x, positions, norm_mix, w_in, q_norm_sb, k_norm_sb, q_norm_dil, k_norm_dil,
              out_norm_sb, out_norm_dil, w_out, norm_ffn, w_gate_dense, w_up_dense, w_down_dense,
              w_router, w_gate_moe, w_up_moe, w_down_moe):
    cos, sin = rope_tables(positions)
    for i in range(DEPTH):
        x = mixer_layer(x, cos, sin, norm_mix[i], w_in[i], q_norm_sb[i], k_norm_sb[i],
                        q_norm_dil[i], k_norm_dil[i], out_norm_sb[i], out_norm_dil[i], w_out[i])
        xn = rmsnorm(x, norm_ffn[i])
        j = i // 2
        if i % 2 == 0:
            x = x + swiglu(xn, w_gate_dense[j], w_up_dense[j], w_down_dense[j])
        else:
            x = x + moe(xn, w_router[j], w_gate_moe[j], w_up_moe[j], w_down_moe[j])
    return x
```

```cpp
#include <hip/hip_runtime.h>
#include <cstdio>
#include <cstdint>
namespace pg8 {
#define PG8_LAS __attribute__((address_space(3)))
typedef unsigned short bf16_t;
typedef short bf16x8 __attribute__((ext_vector_type(8)));
typedef float f32x4 __attribute__((ext_vector_type(4)));
typedef unsigned u32x4 __attribute__((ext_vector_type(4)));
constexpr int BM = 256, BK = 64, HALF = 128, HTB = HALF * BK * 2  , STAGE_BYTES = 8 * HTB, NXCD = 8, WGM = 8;

__host__ __device__ __forceinline__ int lds_byte(int r, int c) { const int st = (r >> 4) * 2 + (c >> 5), rr = r & 15, cc = c & 31, ob = rr * 64 + cc * 2; return st * 1024 + (ob ^ (((ob >> 9) & 1) << 5)); }
__host__ __device__ __forceinline__ void stage_rc(int b, int& R, int& C) { const int st = b / 1024, sb = b % 1024, swz = sb ^ (((sb >> 9) & 1) << 5); R = (st >> 1) * 16 + swz / 64; C = (st & 1) * 32 + (swz % 64) / 2; }
__host__ __device__ __forceinline__ int perm32(int rho) { const int n = rho >> 4, i = rho & 15; return 8 * (i >> 2) + 4 * n + (i & 3); }

struct Unit { int pm, pn; };
struct Gemm { const bf16_t* A; const bf16_t* Bt; int M, N, K; };

struct StaticOrder {
    int nM, nN, nwg, G, c;
    __host__ __device__ void init(int M, int N, int G_, int c_) { nM = M / BM; nN = N / BM; nwg = nM * nN; G = G_; c = c_; }
    __host__ __device__ bool next(int i, Unit& u) const {
        const long L = (long)i * G + c; if (L >= nwg) return false;
        int wgid = (int)L; { const int q = nwg / NXCD, r = nwg % NXCD, xcd = wgid % NXCD, off = wgid / NXCD; wgid = (xcd < r ? xcd * (q + 1) : r * (q + 1) + (xcd - r) * q) + off; }
        const int nig = WGM * nN, gid = wgid / nig, fm = gid * WGM, gsz = (nM - fm) < WGM ? (nM - fm) : WGM;
        u.pm = fm + ((wgid % nig) % gsz); u.pn = (wgid % nig) / gsz; return true;
    }
    __device__ __forceinline__ void a_ready(const Unit&) const {}
    __device__ __forceinline__ void done(const Unit&) const {}
};


__device__ __forceinline__ unsigned cvt_pk_bf16(float lo, float hi) { unsigned r; asm volatile("v_cvt_pk_bf16_f32 %0, %1, %2" : "=v"(r) : "v"(lo), "v"(hi)); return r; }

struct EpiBf16 {
    static constexpr bool PERM = true, AFTER_DRAIN = false;
    bf16_t* O; int ldc;
    __device__ __forceinline__ void operator()(const f32x4 (&acc)[2][2][4][2], const Unit& u, int wr, int wc, int fr, int fq) const {
        const int row0 = u.pm * BM + wr * 64 + fr; const int col0 = u.pn * BM + wc * 32 + 8 * fq;
#pragma unroll
        for (int ai = 0; ai < 2; ++ai)
#pragma unroll
            for (int m = 0; m < 4; ++m) { bf16_t* rowp = O + (size_t)(row0 + ai * HALF + m * 16) * ldc + col0;
#pragma unroll
                for (int bj = 0; bj < 2; ++bj) { const f32x4 v0 = acc[ai][bj][m][0], v1 = acc[ai][bj][m][1];
                    u32x4 w; w.x = cvt_pk_bf16(v0[0], v0[1]); w.y = cvt_pk_bf16(v0[2], v0[3]); w.z = cvt_pk_bf16(v1[0], v1[1]); w.w = cvt_pk_bf16(v1[2], v1[3]);
                    *(u32x4*)(rowp + bj * HALF) = w; } }
    }
};
__device__ __forceinline__ float silu_mul(float g, float u) { const float e = __builtin_amdgcn_exp2f(-1.4426950408889634f * g); return g * __builtin_amdgcn_rcpf(1.0f + e) * u; }
struct EpiSwiGLU {
    static constexpr bool PERM = true, AFTER_DRAIN = false;
    bf16_t* O; int ldc;
    __device__ __forceinline__ void operator()(const f32x4 (&acc)[2][2][4][2], const Unit& u, int wr, int wc, int fr, int fq) const {
        const int row0 = u.pm * BM + wr * 64 + fr; const int col0 = u.pn * HALF + wc * 32 + 8 * fq;
#pragma unroll
        for (int ai = 0; ai < 2; ++ai)
#pragma unroll
            for (int m = 0; m < 4; ++m) { bf16_t* rowp = O + (size_t)(row0 + ai * HALF + m * 16) * ldc + col0;
                const f32x4 g0 = acc[ai][0][m][0], g1 = acc[ai][0][m][1], u0 = acc[ai][1][m][0], u1 = acc[ai][1][m][1];
                u32x4 w; w.x = cvt_pk_bf16(silu_mul(g0[0], u0[0]), silu_mul(g0[1], u0[1])); w.y = cvt_pk_bf16(silu_mul(g0[2], u0[2]), silu_mul(g0[3], u0[3]));
                w.z = cvt_pk_bf16(silu_mul(g1[0], u1[0]), silu_mul(g1[1], u1[1])); w.w = cvt_pk_bf16(silu_mul(g1[2], u1[2]), silu_mul(g1[3], u1[3]));
                *(u32x4*)rowp = w; }
    }
};
struct EpiResAdd {
    static constexpr bool PERM = false, AFTER_DRAIN = false;
    const float* in; float* out; int ldc; const float* rowscale; int rs_stride;
    __device__ __forceinline__ void operator()(const f32x4 (&acc)[2][2][4][2], const Unit& u, int wr, int wc, int fr, int fq) const {
        const int col0 = u.pn * BM + wc * 32 + 4 * fq;
#pragma unroll
        for (int ai = 0; ai < 2; ++ai)
#pragma unroll
            for (int m = 0; m < 4; ++m) { const int r = u.pm * BM + ai * HALF + wr * 64 + m * 16 + fr; const size_t off = (size_t)r * ldc + col0;
                const float sc = rowscale ? rowscale[(size_t)r * rs_stride] : 1.0f;
#pragma unroll
                for (int bj = 0; bj < 2; ++bj)
#pragma unroll
                    for (int n = 0; n < 2; ++n) { const f32x4 bs = *(const f32x4*)(in + off + bj * HALF + n * 16); *(f32x4*)(out + off + bj * HALF + n * 16) = bs + acc[ai][bj][m][n] * sc; }
                if (m & 1) asm volatile("" ::: "memory"); }
    }
};

template <class Epi, class Sched, bool ALIGN_EPI = false, bool SP2 = false>
__device__ __forceinline__ void gemm_phase(PG8_LAS unsigned char* lds, const Gemm g, const Sched& S, const Epi& E) {
    int tid_ = threadIdx.x; asm volatile("" : "+v"(tid_));
    const int tid = tid_, wid = __builtin_amdgcn_readfirstlane(tid >> 6), lane = tid & 63, wr = wid >> 2, wc = wid & 3, fr = lane & 15, fq = lane >> 4;
    const int K = g.K, nt = K / BK;
    unsigned voffA[2], voffB[2];
#pragma unroll
    for (int i = 0; i < 2; ++i) { int R, C; stage_rc(tid * 16 + i * 8192, R, C); const int Rb = Epi::PERM ? ((R & ~31) + perm32(R & 31)) : R;
        voffA[i] = (unsigned)(R * K + C) * 2u; voffB[i] = (unsigned)(Rb * K + C) * 2u; }
    const size_t kstep = (size_t)(BK * 2);
    const size_t hstep = (size_t)HALF * K * 2;
    const size_t tstep = 2 * hstep;
    const unsigned ldsw = (unsigned)wid * 1024u;
    const int aoff = lds_byte(wr * 64 + fr, fq * 8), boff = lds_byte(wc * 32 + fr, fq * 8);
#define PG8_SA(b, h) (((b) * 2 + (h)) * HTB)
#define PG8_SB(b, h) ((4 + (b) * 2 + (h)) * HTB)
#define PG8_STAGE(bufoff, gbase, voff) do { _Pragma("unroll") for (int _i = 0; _i < 2; ++_i) \
        __builtin_amdgcn_global_load_lds((const unsigned*)((const char*)(gbase) + (voff)[_i]), (PG8_LAS unsigned*)(lds + (bufoff) + ldsw + _i * 8192), 16, 0, 0); } while (0)
#define PG8_LDA(dst, b, h) do { _Pragma("unroll") for (int m = 0; m < 4; ++m) _Pragma("unroll") for (int k = 0; k < 2; ++k) dst[m][k] = *(const PG8_LAS bf16x8*)(lds + PG8_SA(b, h) + aoff + m * 2048 + k * 1024); } while (0)
#define PG8_LDB(dst, b, h) do { _Pragma("unroll") for (int n = 0; n < 2; ++n) _Pragma("unroll") for (int k = 0; k < 2; ++k) dst[n][k] = *(const PG8_LAS bf16x8*)(lds + PG8_SB(b, h) + boff + n * 2048 + k * 1024); } while (0)
#define PG8_MMA(ai, bj, At, Bt) do { __builtin_amdgcn_s_setprio(1); _Pragma("unroll") for (int m = 0; m < 4; ++m) _Pragma("unroll") for (int n = 0; n < 2; ++n) _Pragma("unroll") for (int k = 0; k < 2; ++k) \
        acc[ai][bj][m][n] = __builtin_amdgcn_mfma_f32_16x16x32_bf16(Bt[n][k], At[m][k], acc[ai][bj][m][n], 0, 0, 0); __builtin_amdgcn_s_setprio(0); } while (0)
#define PG8_WAIT_V(n) asm volatile("s_waitcnt vmcnt(" #n ")" ::: "memory")
#define PG8_WAIT_L(n) asm volatile("s_waitcnt lgkmcnt(" #n ")" ::: "memory")
#define PG8_BAR __builtin_amdgcn_s_barrier()
#define PG8_SCHED __builtin_amdgcn_sched_barrier(0)
    Unit cur, nxt; int ui = 0;
    if (!S.next(0, cur)) return;
    f32x4 acc[2][2][4][2];
#pragma unroll
    for (int a = 0; a < 2; ++a)
#pragma unroll
        for (int b = 0; b < 2; ++b)
#pragma unroll
            for (int m = 0; m < 4; ++m)
#pragma unroll
                for (int n = 0; n < 2; ++n) acc[a][b][m][n] = (f32x4){0.f, 0.f, 0.f, 0.f};
    bf16x8 At[4][2], B0[2][2], B1[2][2];
    const char* cA = (const char*)g.A + (size_t)cur.pm * tstep; const char* cB = (const char*)g.Bt + (size_t)cur.pn * tstep;
    S.a_ready(cur);
    if constexpr (SP2) {
        PG8_STAGE(PG8_SB(0, 0), cB, voffB); PG8_STAGE(PG8_SB(0, 1), cB + hstep, voffB); PG8_STAGE(PG8_SA(0, 0), cA, voffA); PG8_STAGE(PG8_SA(0, 1), cA + hstep, voffA);
        if (wr == 1) PG8_BAR;
        PG8_WAIT_V(2); PG8_BAR;
        PG8_STAGE(PG8_SB(1, 0), cB + kstep, voffB); PG8_STAGE(PG8_SA(1, 0), cA + kstep, voffA); PG8_STAGE(PG8_SB(1, 1), cB + hstep + kstep, voffB);
        PG8_WAIT_V(6); PG8_BAR;
    } else {
        PG8_STAGE(PG8_SB(0, 0), cB, voffB); PG8_STAGE(PG8_SA(0, 0), cA, voffA); PG8_STAGE(PG8_SB(0, 1), cB + hstep, voffB); PG8_STAGE(PG8_SA(0, 1), cA + hstep, voffA);
        if (wr == 1) PG8_BAR;
        PG8_WAIT_V(4); PG8_BAR;
        PG8_STAGE(PG8_SB(1, 0), cB + kstep, voffB); PG8_STAGE(PG8_SA(1, 0), cA + kstep, voffA); PG8_STAGE(PG8_SB(1, 1), cB + hstep + kstep, voffB);
        PG8_WAIT_V(6); PG8_BAR;
    }
    for (;;) {
        const bool has_next = S.next(ui + 1, nxt);
        const char* nA = has_next ? (const char*)g.A + (size_t)nxt.pm * tstep : cA; const char* nB = has_next ? (const char*)g.Bt + (size_t)nxt.pn * tstep : cB;
        for (int t = 0; t < nt; t += 2) {
            const bool last = (t == nt - 2);
            const char* a1 = cA + (size_t)(t + 1) * kstep;
            const char* a2 = last ? nA : cA + (size_t)(t + 2) * kstep; const char* b2 = last ? nB : cB + (size_t)(t + 2) * kstep;
            const char* a3 = a2 + kstep; const char* b3 = b2 + kstep;
            if (last && has_next) S.a_ready(nxt);
            if constexpr (SP2) {
            PG8_LDB(B0, 0, 0); PG8_LDB(B1, 0, 1); PG8_SCHED; PG8_LDA(At, 0, 0); PG8_STAGE(PG8_SA(1, 1), a1 + hstep, voffA);
            PG8_WAIT_V(8); PG8_WAIT_L(0); PG8_BAR; PG8_MMA(0, 0, At, B0); PG8_MMA(0, 1, At, B1); PG8_BAR; PG8_SCHED;
            PG8_LDA(At, 0, 1); PG8_STAGE(PG8_SB(0, 0), b2, voffB); PG8_STAGE(PG8_SB(0, 1), b2 + hstep, voffB); PG8_STAGE(PG8_SA(0, 0), a2, voffA);
            PG8_WAIT_V(8); PG8_WAIT_L(0); PG8_BAR; PG8_MMA(1, 0, At, B0); PG8_MMA(1, 1, At, B1); PG8_BAR; PG8_SCHED;
            PG8_LDB(B0, 1, 0); PG8_LDB(B1, 1, 1); PG8_SCHED; PG8_LDA(At, 1, 0); PG8_STAGE(PG8_SA(0, 1), a2 + hstep, voffA);
            PG8_WAIT_V(8); PG8_WAIT_L(0); PG8_BAR; PG8_MMA(0, 0, At, B0); PG8_MMA(0, 1, At, B1); PG8_BAR; PG8_SCHED;
            PG8_LDA(At, 1, 1); PG8_STAGE(PG8_SB(1, 0), b3, voffB); PG8_STAGE(PG8_SB(1, 1), b3 + hstep, voffB); PG8_STAGE(PG8_SA(1, 0), a3, voffA);
            PG8_WAIT_V(8); PG8_WAIT_L(0); PG8_BAR; PG8_MMA(1, 0, At, B0); PG8_MMA(1, 1, At, B1); PG8_BAR; PG8_SCHED;
            } else {
            PG8_LDB(B0, 0, 0); PG8_SCHED; PG8_LDA(At, 0, 0); PG8_STAGE(PG8_SA(1, 1), a1 + hstep, voffA);
            PG8_WAIT_L(8); PG8_BAR; PG8_WAIT_L(0); PG8_MMA(0, 0, At, B0); PG8_BAR; PG8_SCHED;
            PG8_LDB(B1, 0, 1); PG8_STAGE(PG8_SB(0, 0), b2, voffB);
            PG8_BAR; PG8_WAIT_L(0); PG8_MMA(0, 1, At, B1); PG8_BAR;
            PG8_LDA(At, 0, 1); PG8_STAGE(PG8_SA(0, 0), a2, voffA);
            PG8_BAR; PG8_WAIT_L(0); PG8_MMA(1, 0, At, B0); PG8_BAR; PG8_SCHED;
            PG8_STAGE(PG8_SB(0, 1), b2 + hstep, voffB);
            PG8_WAIT_V(6); PG8_BAR; PG8_MMA(1, 1, At, B1); PG8_BAR;
            PG8_LDB(B0, 1, 0); PG8_SCHED; PG8_LDA(At, 1, 0); PG8_STAGE(PG8_SA(0, 1), a2 + hstep, voffA);
            PG8_WAIT_L(8); PG8_BAR; PG8_WAIT_L(0); PG8_MMA(0, 0, At, B0); PG8_BAR; PG8_SCHED;
            PG8_LDB(B1, 1, 1); PG8_STAGE(PG8_SB(1, 0), b3, voffB);
            PG8_BAR; PG8_WAIT_L(0); PG8_MMA(0, 1, At, B1); PG8_BAR;
            PG8_LDA(At, 1, 1); PG8_STAGE(PG8_SA(1, 0), a3, voffA);
            PG8_BAR; PG8_WAIT_L(0); PG8_MMA(1, 0, At, B0); PG8_BAR; PG8_SCHED;
            PG8_STAGE(PG8_SB(1, 1), b3 + hstep, voffB);
            PG8_WAIT_V(6); PG8_BAR; PG8_MMA(1, 1, At, B1); PG8_BAR;
            }
        }
        if constexpr (ALIGN_EPI) { if (wr == 0) PG8_BAR; }
        if constexpr (!Epi::AFTER_DRAIN) { E(acc, cur, wr, wc, fr, fq); S.done(cur); }
        if (!has_next) break;
#pragma unroll
        for (int a = 0; a < 2; ++a)
#pragma unroll
            for (int b = 0; b < 2; ++b)
#pragma unroll
                for (int m = 0; m < 4; ++m)
#pragma unroll
                    for (int n = 0; n < 2; ++n) acc[a][b][m][n] = (f32x4){0.f, 0.f, 0.f, 0.f};
        cur = nxt; cA = nA; cB = nB; ++ui;
        if constexpr (ALIGN_EPI) { if (wr == 1) PG8_BAR; }
    }
    PG8_WAIT_V(0);
    if constexpr (!ALIGN_EPI) { if (wr == 0) PG8_BAR; }
    PG8_BAR;
    if constexpr (Epi::AFTER_DRAIN) { E.fused(acc, cur, wr, wc, fr, fq, lds, wid, lane); S.done(cur); }
#undef PG8_SA
#undef PG8_SB
#undef PG8_STAGE
#undef PG8_LDA
#undef PG8_LDB
#undef PG8_MMA
#undef PG8_WAIT_V
#undef PG8_WAIT_L
#undef PG8_BAR
#undef PG8_SCHED
}
}

#ifndef PG8_SP2
#define PG8_SP2 true
#endif
#ifndef PG8_ALIGN
#define PG8_ALIGN true
#endif

constexpr int NB = 4, SEQ = 8192, DM = 2048, DEPTH = 4, HD = 128, DSB = 512, DMIX = 1024, DIN = 3072, DFF = 5632, DFE = 1408, NE = 8;
constexpr int M = NB * SEQ;
constexpr float EPS = 1e-6f;
constexpr int NWAVES = 8;
constexpr int C_QSB = 0, C_KSB = 512, C_VSB = 1024, C_QDIL = 1536, C_KDIL = 2048, C_VDIL = 2560;

constexpr size_t MiB = 1u << 20;
constexpr size_t WS_CTL = 0, CTL_ZERO_BYTES = 1 * MiB;
constexpr size_t WS_WIN = 1 * MiB;
constexpr size_t WS_WOUT = 49 * MiB;
constexpr size_t WS_WGU_D = 65 * MiB;
constexpr size_t WS_WDN_D = 153 * MiB;
constexpr size_t WS_WGU_M = 197 * MiB;
constexpr size_t WS_WDN_M = 373 * MiB;
constexpr size_t WS_ROPE = 461 * MiB;
constexpr size_t WS_XN = 477 * MiB;
constexpr size_t WS_ATT = 605 * MiB;
constexpr size_t WS_COMB = 669 * MiB;
constexpr size_t WS_LSE = 670 * MiB;
constexpr size_t WS_BIG = 672 * MiB;
constexpr size_t WS_H = WS_BIG, WS_OSB = WS_BIG + 192 * MiB, WS_ODIL = WS_BIG + 256 * MiB, WS_HMID = WS_BIG;
constexpr size_t WS_END = 1024 * MiB;
static_assert(WS_WIN + (size_t)4 * 3072 * 2048 * 2 <= WS_WOUT && WS_WOUT + (size_t)4 * 2048 * 1024 * 2 <= WS_WGU_D && WS_WGU_D + (size_t)2 * 11264 * 2048 * 2 <= WS_WDN_D &&
              WS_WDN_D + (size_t)2 * 2048 * 5632 * 2 <= WS_WGU_M && WS_WGU_M + (size_t)16 * 2816 * 2048 * 2 <= WS_WDN_M && WS_WDN_M + (size_t)16 * 2048 * 1408 * 2 <= WS_ROPE &&
              WS_ROPE + (size_t)2 * M * 64 * 4 <= WS_XN && WS_XN + (size_t)M * DM * 2 <= WS_ATT && WS_ATT + (size_t)M * DMIX * 2 <= WS_COMB && WS_COMB + (size_t)M * 8 * 4 <= WS_LSE &&
              WS_LSE + (size_t)3 * M * 4 * 4 <= WS_BIG && WS_BIG + (size_t)M * DFF * 2 <= WS_END && WS_ODIL + (size_t)3 * M * 512 * 2 <= WS_END, "d_ws map");
constexpr int CW_BAR = 4096;

constexpr int RING_OFF = 0, RING_BYTES = 131072;
constexpr int LDSCTL_OFF = RING_BYTES, MISC_OFF = LDSCTL_OFF + 320;
constexpr int LDS_BYTES = 147456;

#define GAS __attribute__((address_space(1)))
#define LAS __attribute__((address_space(3)))
typedef unsigned short bf16;
typedef unsigned v4u __attribute__((ext_vector_type(4)));
typedef unsigned v2u __attribute__((ext_vector_type(2)));
typedef float f32x4 __attribute__((ext_vector_type(4)));
typedef float f32x16 __attribute__((ext_vector_type(16)));
typedef short bf16x8 __attribute__((ext_vector_type(8)));
typedef short s16x4 __attribute__((ext_vector_type(4)));
#define LDS_WAIT() asm volatile("s_waitcnt lgkmcnt(0)" ::: "memory")
#define VM_WAIT() asm volatile("s_waitcnt vmcnt(0)" ::: "memory")
__device__ __forceinline__ unsigned f2bf(float f) { unsigned u = __builtin_bit_cast(unsigned, f); return (u + 0x7fffu + ((u >> 16) & 1u)) >> 16; }
__device__ __forceinline__ unsigned pk2(float lo, float hi) { return f2bf(lo) | (f2bf(hi) << 16); }
__device__ __forceinline__ float bf_lo(unsigned w) { return __builtin_bit_cast(float, w << 16); }
__device__ __forceinline__ float bf_hi(unsigned w) { return __builtin_bit_cast(float, w & 0xffff0000u); }

#define XB_TMO      128
#define XB_XCNT(j)  (256  + 64 * (j))
#define XB_XSUB(j)  (1280 + 64 * (j))
#define XB_XGEN(j)  (2304 + 64 * (j))
#define XB_TOP      3328
#define XB_TOPGEN   3392
#define XCD_BAR_WORDS 3456
#define XB_SPIN_CAP (1u << 18)

__device__ __forceinline__ unsigned xb_ld(unsigned* p)              { return __hip_atomic_load(p, __ATOMIC_RELAXED, __HIP_MEMORY_SCOPE_AGENT); }
__device__ __forceinline__ unsigned xb_add(unsigned* p, unsigned v) { return __hip_atomic_fetch_add(p, v, __ATOMIC_RELAXED, __HIP_MEMORY_SCOPE_AGENT); }
__device__ __forceinline__ unsigned xb_xcc_id() { return (unsigned)__builtin_amdgcn_s_getreg((3 << 11) | 20) & 0xFu; }
#define XB_SPIN(cond, bar) do { unsigned _sp = 0; while (cond) { __builtin_amdgcn_s_sleep(1); \
    if ((++_sp & 255u) == 0u) { if (xb_ld(&(bar)[XB_TMO])) break; if (_sp > XB_SPIN_CAP) { atomicAdd(&(bar)[XB_TMO], 1u); break; } } } } while (0)

struct XcdBarrier {
    unsigned* bar; unsigned x;
    volatile LAS unsigned* st;
};
__device__ __forceinline__ XcdBarrier xcd_barrier_post(unsigned* bar, volatile LAS unsigned* st) {
    XcdBarrier b; b.bar = bar; b.x = xb_xcc_id(); b.st = st;
    if (threadIdx.x == 0) (void)xb_add(&bar[XB_XCNT(b.x)], 1u);
    return b;
}
__device__ __forceinline__ void xcd_barrier_complete(unsigned* bar, unsigned x, unsigned& nloc, unsigned& nx) {
    const unsigned G = gridDim.x * gridDim.y * gridDim.z;
    unsigned sum, cnt, mine, sp = 0u;
    for (;;) {
        sum = 0u; cnt = 0u; mine = 0u;
#pragma unroll
        for (unsigned j = 0; j < 16; ++j) { const unsigned c = xb_ld(&bar[XB_XCNT(j)]); sum += c; cnt += (c > 0u) ? 1u : 0u; mine = (j == x) ? c : mine; }
        if (sum == G) break;
        __builtin_amdgcn_s_sleep(1);
        if ((++sp & 255u) == 0u) { if (xb_ld(&bar[XB_TMO])) break; if (sp > XB_SPIN_CAP) { atomicAdd(&bar[XB_TMO], 1u); break; } }
    }
    nloc = mine > 0u ? mine : 1u; nx = cnt > 0u ? cnt : 1u;
}
__device__ __forceinline__ void xcd_barrier(const XcdBarrier& b) {
    asm volatile("s_waitcnt vmcnt(0)" ::: "memory");
    __syncthreads();
    if (threadIdx.x == 0) {
        unsigned* bar = b.bar;
        __builtin_amdgcn_s_waitcnt(0);
        unsigned nloc = b.st[0], nx = b.st[1];
        if (nloc == 0u) { xcd_barrier_complete(bar, b.x, nloc, nx); b.st[0] = nloc; b.st[1] = nx; }
        const unsigned old = xb_add(&bar[XB_XSUB(b.x)], 1u);
        const unsigned gen = old / nloc;
        if (old + 1u == (gen + 1u) * nloc) {
            __builtin_amdgcn_fence(__ATOMIC_RELEASE, "agent");
            asm volatile("s_waitcnt vmcnt(0)" ::: "memory");
            const unsigned og = xb_add(&bar[XB_TOP], 1u);
            const unsigned tg = og / nx;
            if (og + 1u == (tg + 1u) * nx) xb_add(&bar[XB_TOPGEN], 1u);
            else XB_SPIN(xb_ld(&bar[XB_TOPGEN]) == tg, bar);
            __builtin_amdgcn_fence(__ATOMIC_ACQUIRE, "agent");
            xb_add(&bar[XB_XGEN(b.x)], 1u);
            asm volatile("s_waitcnt vmcnt(0)" ::: "memory");
        } else {
            XB_SPIN(xb_ld(&bar[XB_XGEN(b.x)]) == gen, bar);
            __builtin_amdgcn_fence(__ATOMIC_ACQUIRE, "agent");
            asm volatile("s_waitcnt vmcnt(0)" ::: "memory");
        }
    }
    __syncthreads();
}

__device__ __forceinline__ float wave_sum(float v) {
#pragma unroll
    for (int o = 1; o < 64; o <<= 1) v += __shfl_xor(v, o);
    return v;
}
__device__ const float ROPE_INV[64] = {
    1.0f, 0.8659643233600653f, 0.7498942093324559f, 0.6493816315762113f, 0.5623413251903491f, 0.4869675251658631f, 0.4216965034285822f, 0.3651741272548377f,
    0.31622776601683794f, 0.27384196342643613f, 0.23713737056616552f, 0.2053525026457146f, 0.1778279410038923f, 0.1539926526059492f, 0.1333521432163324f, 0.11547819846894582f,
    0.1f, 0.08659643233600653f, 0.07498942093324558f, 0.06493816315762113f, 0.05623413251903491f, 0.04869675251658631f, 0.042169650342858224f, 0.03651741272548377f,
    0.03162277660168379f, 0.027384196342643614f, 0.023713737056616554f, 0.02053525026457146f, 0.01778279410038923f, 0.01539926526059492f, 0.01333521432163324f, 0.011547819846894581f,
    0.01f, 0.008659643233600654f, 0.007498942093324558f, 0.006493816315762113f, 0.005623413251903491f, 0.004869675251658631f, 0.004216965034285823f, 0.003651741272548377f,
    0.0031622776601683794f, 0.0027384196342643613f, 0.0023713737056616554f, 0.002053525026457146f, 0.0017782794100389228f, 0.001539926526059492f, 0.001333521432163324f, 0.0011547819846894581f,
    0.001f, 0.0008659643233600654f, 0.0007498942093324559f, 0.0006493816315762113f, 0.0005623413251903491f, 0.0004869675251658631f, 0.00042169650342858224f, 0.0003651741272548377f,
    0.00031622776601683794f, 0.0002738419634264361f, 0.00023713737056616554f, 0.0002053525026457146f, 0.00017782794100389227f, 0.0001539926526059492f, 0.0001333521432163324f, 0.00011547819846894582f };
__device__ __forceinline__ void sincos_d(double a, float& sn, float& cs) {
    const double k = __builtin_rint(a * 0.15915494309189535);
    double r = __builtin_fma(-k, 6.283185307179586, a); r = __builtin_fma(-k, 2.4492935982947064e-16, r);
    const double r2 = r * r;
    double s = -9.18368986379554601e-29;
    s = s * r2 + 6.44695028438447359e-26; s = s * r2 + -3.86817017063068413e-23; s = s * r2 + 1.95729410633912626e-20; s = s * r2 + -8.22063524662432950e-18;
    s = s * r2 + 2.81145725434552060e-15; s = s * r2 + -7.64716373181981641e-13; s = s * r2 + 1.60590438368216133e-10; s = s * r2 + -2.50521083854417202e-08;
    s = s * r2 + 2.75573192239858925e-06; s = s * r2 + -1.98412698412698413e-04; s = s * r2 + 8.33333333333333322e-03; s = s * r2 + -1.66666666666666657e-01; s = s * r2 + 1.0;
    double c = 3.27988923706983776e-30;
    c = c * r2 + -2.47959626322479759e-27; c = c * r2 + 1.61173757109611839e-24; c = c * r2 + -8.89679139245057408e-22; c = c * r2 + 4.11031762331216484e-19;
    c = c * r2 + -1.56192069685862253e-16; c = c * r2 + 4.77947733238738525e-14; c = c * r2 + -1.14707455977297245e-11; c = c * r2 + 2.08767569878681002e-09;
    c = c * r2 + -2.75573192239858883e-07; c = c * r2 + 2.48015873015873016e-05; c = c * r2 + -1.38888888888888894e-03; c = c * r2 + 4.16666666666666644e-02; c = c * r2 + -0.5; c = c * r2 + 1.0;
    sn = (float)(s * r); cs = (float)c;
}

__device__ __forceinline__ void transpose_item(const float* W, int K, int N, bf16* WT, int mode, LAS float* scr, int item, int lane) {
    const int nblk = N / 32, kb = item / nblk, nb = item % nblk, k0 = 64 * kb, n0 = 32 * nb;
#pragma unroll 8
    for (int i = 0; i < 32; ++i) { const int kk = 2 * i + (lane >> 5); scr[kk * 33 + (lane & 31)] = W[(size_t)(k0 + kk) * N + n0 + (lane & 31)]; }
    LDS_WAIT(); asm volatile("" ::: "memory");
    const int c = lane & 7;
#pragma unroll
    for (int j = 0; j < 4; ++j) { const int n = (lane >> 3) + 8 * j; const LAS float* s = scr + (8 * c) * 33 + n;
        const int nn = n0 + n; const int drow = (mode == 0) ? nn : ((nn >> 7) * 256 + (mode == 2 ? 128 : 0) + (nn & 127));
        v4u o; o.x = pk2(s[0 * 33], s[1 * 33]); o.y = pk2(s[2 * 33], s[3 * 33]); o.z = pk2(s[4 * 33], s[5 * 33]); o.w = pk2(s[6 * 33], s[7 * 33]);
        *(v4u*)(WT + (size_t)drow * K + k0 + 8 * c) = o; }
    LDS_WAIT(); asm volatile("" ::: "memory");
}
__device__ __forceinline__ void transpose_group(const float* src, bf16* dst, int K, int N, int mode, size_t dstride, int r, LAS float* scr, int lane) {
    const int per = (K / 64) * (N / 32); const int l = r / per, it = r % per;
    transpose_item(src + (size_t)l * K * N, K, N, dst + (size_t)l * dstride, mode, scr, it, lane);
}

template <bool ROUTER>
__device__ __forceinline__ void norm_phase(const float* x, const float* gain, bf16* xn, const float* wr, float* comb, int gw, int NGW, int lane) {
    f32x4 g[4][2];
#pragma unroll
    for (int j = 0; j < 4; ++j)
#pragma unroll
        for (int e = 0; e < 2; ++e) g[j][e] = *(const f32x4*)(gain + 512 * j + 8 * lane + 4 * e);
    for (int row = gw; row < M; row += NGW) {
        const float* xr = x + (size_t)row * DM + 8 * lane;
        f32x4 v[4][2]; float ss = 0.f;
#pragma unroll
        for (int j = 0; j < 4; ++j)
#pragma unroll
            for (int e = 0; e < 2; ++e) { v[j][e] = *(const f32x4*)(xr + 512 * j + 4 * e); ss += (v[j][e].x * v[j][e].x + v[j][e].y * v[j][e].y) + (v[j][e].z * v[j][e].z + v[j][e].w * v[j][e].w); }
        ss = wave_sum(ss);
        const float rstd = __builtin_amdgcn_rsqf(ss * (1.0f / DM) + EPS);
        bf16* orow = xn + (size_t)row * DM + 8 * lane;
#pragma unroll
        for (int j = 0; j < 4; ++j) {
            v[j][0] = v[j][0] * rstd * g[j][0]; v[j][1] = v[j][1] * rstd * g[j][1];
            v4u o; o.x = pk2(v[j][0].x, v[j][0].y); o.y = pk2(v[j][0].z, v[j][0].w); o.z = pk2(v[j][1].x, v[j][1].y); o.w = pk2(v[j][1].z, v[j][1].w);
            *(v4u*)(orow + 512 * j) = o;
        }
        if constexpr (ROUTER) {
            float lg[8];
#pragma unroll
            for (int e = 0; e < 8; ++e) lg[e] = 0.f;
#pragma unroll
            for (int j = 0; j < 4; ++j)
#pragma unroll
                for (int e = 0; e < 2; ++e)
#pragma unroll
                    for (int t = 0; t < 4; ++t) {
                        const int col = 512 * j + 8 * lane + 4 * e + t; const f32x4* w = (const f32x4*)(wr + (size_t)col * 8); const f32x4 w0 = w[0], w1 = w[1]; const float yv = v[j][e][t];
                        lg[0] += yv * w0.x; lg[1] += yv * w0.y; lg[2] += yv * w0.z; lg[3] += yv * w0.w; lg[4] += yv * w1.x; lg[5] += yv * w1.y; lg[6] += yv * w1.z; lg[7] += yv * w1.w; }
#pragma unroll
            for (int e = 0; e < 8; ++e) lg[e] = wave_sum(lg[e]);
            int i0 = 0; float l0 = lg[0];
#pragma unroll
            for (int e = 1; e < 8; ++e) if (lg[e] > l0) { l0 = lg[e]; i0 = e; }
            int i1 = -1; float l1 = -3.0e38f;
#pragma unroll
            for (int e = 0; e < 8; ++e) if (e != i0 && lg[e] > l1) { l1 = lg[e]; i1 = e; }
            const float e1 = __expf(l1 - l0); const float g0 = 1.0f / (1.0f + e1), g1 = e1 * g0;
            if (lane < 8) comb[(size_t)row * 8 + lane] = (lane == i0) ? g0 : ((lane == i1) ? g1 : 0.0f);
        }
    }
}

__device__ __forceinline__ void qkprep_phase(bf16* H, const float* qn_sb, const float* kn_sb, const float* qn_dil, const float* kn_dil, const float* rope_c, const float* rope_s, int gw, int NGW, int lane) {
    const int d0 = 8 * (lane & 15);
    f32x4 gq[4][2];
    { const float* gp[4] = {qn_sb, kn_sb, qn_dil, kn_dil};
#pragma unroll
      for (int p = 0; p < 4; ++p) { gq[p][0] = *(const f32x4*)(gp[p] + d0); gq[p][1] = *(const f32x4*)(gp[p] + d0 + 4); } }
    const int ri = d0 & 63;
    for (int tok = gw; tok < M; tok += NGW) {
        bf16* hrow = H + (size_t)tok * DIN;
        const f32x4 c0 = *(const f32x4*)(rope_c + (size_t)tok * 64 + ri), c1 = *(const f32x4*)(rope_c + (size_t)tok * 64 + ri + 4);
        const f32x4 s0 = *(const f32x4*)(rope_s + (size_t)tok * 64 + ri), s1 = *(const f32x4*)(rope_s + (size_t)tok * 64 + ri + 4);
#pragma unroll
        for (int p = 0; p < 4; ++p) {
            const int colbase = (p == 0) ? C_QSB : (p == 1) ? C_KSB : (p == 2) ? C_QDIL : C_KDIL;
            v4u* ptr = (v4u*)(hrow + colbase + 8 * lane);
            const v4u raw = *ptr;
            float y[8]; y[0] = bf_lo(raw.x); y[1] = bf_hi(raw.x); y[2] = bf_lo(raw.y); y[3] = bf_hi(raw.y); y[4] = bf_lo(raw.z); y[5] = bf_hi(raw.z); y[6] = bf_lo(raw.w); y[7] = bf_hi(raw.w);
            float ss = 0.f;
#pragma unroll
            for (int e = 0; e < 8; ++e) ss += y[e] * y[e];
            ss += __shfl_xor(ss, 1); ss += __shfl_xor(ss, 2); ss += __shfl_xor(ss, 4); ss += __shfl_xor(ss, 8);
            const float rstd = __builtin_amdgcn_rsqf(ss * (1.0f / HD) + EPS);
#pragma unroll
            for (int e = 0; e < 8; ++e) y[e] = y[e] * rstd * gq[p][e >> 2][e & 3];
            if (p >= 2) {
                const bool lowhalf = (lane & 8) == 0;
#pragma unroll
                for (int e = 0; e < 8; ++e) { const float partner = __shfl_xor(y[e], 8); const float cc = (e < 4) ? c0[e & 3] : c1[e & 3], sn = (e < 4) ? s0[e & 3] : s1[e & 3];
                    y[e] = lowhalf ? (y[e] * cc - partner * sn) : (y[e] * cc + partner * sn); }
            }
            v4u o; o.x = pk2(y[0], y[1]); o.y = pk2(y[2], y[3]); o.z = pk2(y[4], y[5]); o.w = pk2(y[6], y[7]);
            *ptr = o;
        }
    }
}

#define MFMA32(a, b, c) __builtin_amdgcn_mfma_f32_32x32x16_bf16((a), (b), (c), 0, 0, 0)
__device__ __forceinline__ int crow16(int i, int hh) { return (i & 3) + 8 * (i >> 2) + 4 * hh; }
__device__ __forceinline__ int voff(int row, int ch) { return 256 * row + 16 * (ch ^ (((row & 3) << 2) | ((row >> 2) & 3))); }
__device__ __forceinline__ void load_frag8(bf16x8 (&f)[8], const bf16* rowptr, int hh) {
    const v4u* p = (const v4u*)rowptr + 2 * hh;
#pragma unroll
    for (int c = 0; c < 4; ++c) { f[2 * c] = __builtin_bit_cast(bf16x8, p[4 * c]); f[2 * c + 1] = __builtin_bit_cast(bf16x8, p[4 * c + 1]); }
}
__device__ __forceinline__ void stage_v(LAS unsigned char* vimg, const bf16* vbase, size_t rstride, int lane) {
    v4u t[8];
#pragma unroll
    for (int i = 0; i < 8; ++i) { const int row = 4 * i + (lane >> 4); t[i] = *(const v4u*)(vbase + (size_t)row * rstride + 8 * (lane & 15)); }
#pragma unroll
    for (int i = 0; i < 8; ++i) { const int row = 4 * i + (lane >> 4); *(LAS v4u*)(vimg + voff(row, lane & 15)) = t[i]; }
}
__device__ __forceinline__ bf16x8 pack8(const float* p) {
    v4u w; w.x = pk2(p[0], p[1]); w.y = pk2(p[2], p[3]); w.z = pk2(p[4], p[5]); w.w = pk2(p[6], p[7]);
    return __builtin_bit_cast(bf16x8, w);
}
__device__ __forceinline__ void pv_tile(f32x16 (&O)[4], const float (&P)[16], LAS unsigned char* vimg, int lane) {
    const int hh = lane >> 5, i16 = lane & 15, q = i16 >> 2, p = i16 & 3, blk = (lane >> 4) & 1;
    const bf16x8 pf0 = pack8(&P[0]), pf1 = pack8(&P[8]);
    asm volatile("" ::: "memory");
#pragma unroll
    for (int dt = 0; dt < 4; ++dt) {
#pragma unroll
        for (int s = 0; s < 2; ++s) {
            const int ch = 4 * dt + 2 * blk + (p >> 1);
            const int rlo = 16 * s + 4 * hh + q, rhi = rlo + 8;
            const s16x4 lo = __builtin_amdgcn_ds_read_tr16_b64_v4i16((LAS s16x4*)(vimg + voff(rlo, ch) + 8 * (p & 1)));
            const s16x4 hi = __builtin_amdgcn_ds_read_tr16_b64_v4i16((LAS s16x4*)(vimg + voff(rhi, ch) + 8 * (p & 1)));
            const bf16x8 va = __builtin_shufflevector(lo, hi, 0, 1, 2, 3, 4, 5, 6, 7);
            O[dt] = MFMA32(va, s == 0 ? pf0 : pf1, O[dt]);
        }
    }
    asm volatile("" ::: "memory");
}
constexpr float ATT_C = 0.08838834764831845f * 1.4426950408889634f;
constexpr float SB_STOP = 160.0f;

__device__ __forceinline__ void sb_unit(const bf16* H, float* OSB, LAS unsigned char* vimg, int b, int hd, int qt, int lane) {
    const int r = lane & 31, hh = lane >> 5;
    const size_t tokq = (size_t)b * SEQ + 32 * qt + r;
    bf16x8 Q[8]; load_frag8(Q, H + tokq * DIN + C_QSB + hd * HD, hh);
    f32x16 O[4];
#pragma unroll
    for (int dt = 0; dt < 4; ++dt)
#pragma unroll
        for (int i = 0; i < 16; ++i) O[dt][i] = 0.f;
    float later = 0.f;
    for (int kt = qt; kt >= 0; --kt) {
        const size_t tok0 = (size_t)b * SEQ + 32 * kt;
        bf16x8 K[8]; load_frag8(K, H + (tok0 + r) * DIN + C_KSB + hd * HD, hh);
        stage_v(vimg, H + tok0 * DIN + C_VSB + hd * HD, DIN, lane);
        f32x16 S;
#pragma unroll
        for (int i = 0; i < 16; ++i) S[i] = 0.f;
#pragma unroll
        for (int c = 0; c < 8; ++c) S = MFMA32(K[c], Q[c], S);
        const bool diag = (kt == qt);
        float u[16], a[16]; bool valid[16];
#pragma unroll
        for (int i = 0; i < 16; ++i) {
            u[i] = S[i] * ATT_C; valid[i] = !diag || (crow16(i, hh) < r);
            const float e = __builtin_amdgcn_exp2f(-__builtin_fabsf(u[i]));
            const float sp = __builtin_fmaxf(u[i], 0.f) + __builtin_amdgcn_logf(1.0f + e);
            a[i] = valid[i] ? sp : 0.f;
        }
        float T[4], To[4];
#pragma unroll
        for (int G = 0; G < 4; ++G) { a[4 * G + 2] += a[4 * G + 3]; a[4 * G + 1] += a[4 * G + 2]; a[4 * G] += a[4 * G + 1]; T[G] = a[4 * G]; }
#pragma unroll
        for (int G = 0; G < 4; ++G) To[G] = __shfl_xor(T[G], 32);
        const float P3 = T[3] + To[3], P2 = T[2] + To[2], P1 = T[1] + To[1], P0 = T[0] + To[0];
        float Qs[4]; Qs[3] = 0.f; Qs[2] = P3; Qs[1] = P3 + P2; Qs[0] = Qs[1] + P1;
        const float total = Qs[0] + P0;
        float P[16];
#pragma unroll
        for (int i = 0; i < 16; ++i) { const int G = i >> 2; const float off = Qs[G] + (hh == 0 ? To[G] : 0.f);
            const float l2a = u[i] - (a[i] + off) - later; P[i] = valid[i] ? __builtin_amdgcn_exp2f(l2a) : 0.f; }
        pv_tile(O, P, vimg, lane);
        later += total;
        if (__all(later > SB_STOP)) break;
    }
    float* orow = OSB + tokq * DSB + hd * HD;
#pragma unroll
    for (int dt = 0; dt < 4; ++dt)
#pragma unroll
        for (int G = 0; G < 4; ++G) { f32x4 o; o.x = O[dt][4 * G]; o.y = O[dt][4 * G + 1]; o.z = O[dt][4 * G + 2]; o.w = O[dt][4 * G + 3];
            *(f32x4*)(orow + 32 * dt + 8 * G + 4 * hh) = o; }
}

__device__ __forceinline__ void dil_unit(const bf16* H, bf16* ODIL, float* LSE, LAS unsigned char* vimg, int b, int hd, int g, int rc, int mt, int lane) {
    const int r = lane & 31, hh = lane >> 5;
    const int delta = (g == 0) ? 1 : (g == 1 ? 4 : 16);
    const size_t tokq = (size_t)b * SEQ + (size_t)(32 * mt + r) * delta + rc;
    bf16x8 Q[8]; load_frag8(Q, H + tokq * DIN + C_QDIL + hd * HD, hh);
    f32x16 O[4];
#pragma unroll
    for (int dt = 0; dt < 4; ++dt)
#pragma unroll
        for (int i = 0; i < 16; ++i) O[dt][i] = 0.f;
    float mrun = -1.0e30f, lsum = 0.f;
    const int ktlo = (mt - 4 > 0) ? (mt - 4) : 0;
    for (int kt = mt; kt >= ktlo; --kt) {
        const size_t tok0 = (size_t)b * SEQ + (size_t)(32 * kt) * delta + rc;
        bf16x8 K[8]; load_frag8(K, H + (tok0 + (size_t)r * delta) * DIN + C_KDIL + hd * HD, hh);
        stage_v(vimg, H + tok0 * DIN + C_VDIL + hd * HD, (size_t)DIN * delta, lane);
        f32x16 S;
#pragma unroll
        for (int i = 0; i < 16; ++i) S[i] = 0.f;
#pragma unroll
        for (int c = 0; c < 8; ++c) S = MFMA32(K[c], Q[c], S);
        const int dq = 32 * (mt - kt) + r;
        float u[16]; float tmax = -1.0e30f;
#pragma unroll
        for (int i = 0; i < 16; ++i) { const int dist = dq - crow16(i, hh); const bool ok = (dist >= 0) && (dist <= 128);
            u[i] = ok ? S[i] * ATT_C : -1.0e30f; tmax = __builtin_fmaxf(tmax, u[i]); }
        tmax = __builtin_fmaxf(tmax, __shfl_xor(tmax, 32));
        const float mnew = __builtin_fmaxf(mrun, tmax);
        const float alpha = __builtin_amdgcn_exp2f(mrun - mnew);
        float P[16]; float ps = 0.f;
#pragma unroll
        for (int i = 0; i < 16; ++i) { P[i] = __builtin_amdgcn_exp2f(u[i] - mnew); ps += P[i]; }
        lsum = lsum * alpha + ps;
#pragma unroll
        for (int dt = 0; dt < 4; ++dt)
#pragma unroll
            for (int i = 0; i < 16; ++i) O[dt][i] *= alpha;
        pv_tile(O, P, vimg, lane);
        mrun = mnew;
    }
    const float ltot = lsum + __shfl_xor(lsum, 32);
    const float inv = 1.0f / ltot;
    bf16* orow = ODIL + ((size_t)g * M + tokq) * 512 + hd * HD;
#pragma unroll
    for (int dt = 0; dt < 4; ++dt)
#pragma unroll
        for (int G = 0; G < 4; ++G) { v2u o; o.x = pk2(O[dt][4 * G] * inv, O[dt][4 * G + 1] * inv); o.y = pk2(O[dt][4 * G + 2] * inv, O[dt][4 * G + 3] * inv);
            *(v2u*)(orow + 32 * dt + 8 * G + 4 * hh) = o; }
    if (hh == 0) LSE[((size_t)g * M + tokq) * 4 + hd] = (mrun + __builtin_amdgcn_logf(ltot)) * 0.6931471805599453f;
}

__device__ __forceinline__ void attn_phase(const bf16* H, float* OSB, bf16* ODIL, float* LSE, LAS unsigned char* lds, int gw, int NGW, int wave, int lane) {
    LAS unsigned char* vimg = lds + wave * 8192;
    constexpr int NSB = NB * 4 * 256, NDIL = 3 * NSB;
    for (int uidx = gw; uidx < NSB + NDIL; uidx += NGW) {
        if (uidx < NSB) { const int qt = uidx & 255, hd = (uidx >> 8) & 3, b = uidx >> 10; sb_unit(H, OSB, vimg, b, hd, qt, lane); }
        else { const int did = uidx - NSB; const int g = did / NSB, rem = did % NSB; const int b = rem >> 10, hd = (rem >> 8) & 3, sub = rem & 255;
            const int delta = (g == 0) ? 1 : (g == 1 ? 4 : 16); const int rc = sub % delta, mt = sub / delta;
            dil_unit(H, ODIL, LSE, vimg, b, hd, g, rc, mt, lane); }
    }
}

__device__ __forceinline__ void combine_phase(const float* OSB, const bf16* ODIL, const float* LSE, const float* g_sb, const float* g_dil, bf16* ATT, int gw, int NGW, int lane) {
    const f32x4 gs0 = *(const f32x4*)(g_sb + 8 * lane), gs1 = *(const f32x4*)(g_sb + 8 * lane + 4);
    const f32x4 gd0 = *(const f32x4*)(g_dil + 8 * lane), gd1 = *(const f32x4*)(g_dil + 8 * lane + 4);
    const int hd = lane >> 4;
    for (int tok = gw; tok < M; tok += NGW) {
        { const float* p = OSB + (size_t)tok * DSB + 8 * lane; f32x4 v0 = *(const f32x4*)p, v1 = *(const f32x4*)(p + 4);
          float ss = (v0.x * v0.x + v0.y * v0.y) + (v0.z * v0.z + v0.w * v0.w) + (v1.x * v1.x + v1.y * v1.y) + (v1.z * v1.z + v1.w * v1.w);
          ss = wave_sum(ss); const float rstd = __builtin_amdgcn_rsqf(ss * (1.0f / DSB) + EPS);
          v0 = v0 * rstd * gs0; v1 = v1 * rstd * gs1;
          v4u o; o.x = pk2(v0.x, v0.y); o.y = pk2(v0.z, v0.w); o.z = pk2(v1.x, v1.y); o.w = pk2(v1.z, v1.w);
          *(v4u*)(ATT + (size_t)tok * DMIX + 8 * lane) = o; }
        { float l0 = LSE[((size_t)0 * M + tok) * 4 + hd], l1 = LSE[((size_t)1 * M + tok) * 4 + hd], l2 = LSE[((size_t)2 * M + tok) * 4 + hd];
          const float mx = __builtin_fmaxf(l0, __builtin_fmaxf(l1, l2));
          float w0 = __expf(l0 - mx), w1 = __expf(l1 - mx), w2 = __expf(l2 - mx); const float iw = 1.0f / (w0 + w1 + w2); w0 *= iw; w1 *= iw; w2 *= iw;
          const v4u a = *(const v4u*)(ODIL + ((size_t)0 * M + tok) * 512 + 8 * lane), bq = *(const v4u*)(ODIL + ((size_t)1 * M + tok) * 512 + 8 * lane), c = *(const v4u*)(ODIL + ((size_t)2 * M + tok) * 512 + 8 * lane);
          float y[8];
          y[0] = w0 * bf_lo(a.x) + w1 * bf_lo(bq.x) + w2 * bf_lo(c.x); y[1] = w0 * bf_hi(a.x) + w1 * bf_hi(bq.x) + w2 * bf_hi(c.x);
          y[2] = w0 * bf_lo(a.y) + w1 * bf_lo(bq.y) + w2 * bf_lo(c.y); y[3] = w0 * bf_hi(a.y) + w1 * bf_hi(bq.y) + w2 * bf_hi(c.y);
          y[4] = w0 * bf_lo(a.z) + w1 * bf_lo(bq.z) + w2 * bf_lo(c.z); y[5] = w0 * bf_hi(a.z) + w1 * bf_hi(bq.z) + w2 * bf_hi(c.z);
          y[6] = w0 * bf_lo(a.w) + w1 * bf_lo(bq.w) + w2 * bf_lo(c.w); y[7] = w0 * bf_hi(a.w) + w1 * bf_hi(bq.w) + w2 * bf_hi(c.w);
          float ss = 0.f;
#pragma unroll
          for (int e = 0; e < 8; ++e) ss += y[e] * y[e];
          ss = wave_sum(ss); const float rstd = __builtin_amdgcn_rsqf(ss * (1.0f / 512.0f) + EPS);
#pragma unroll
          for (int e = 0; e < 8; ++e) y[e] = y[e] * rstd * ((e < 4) ? gd0[e & 3] : gd1[e & 3]);
          v4u o; o.x = pk2(y[0], y[1]); o.y = pk2(y[2], y[3]); o.z = pk2(y[4], y[5]); o.w = pk2(y[6], y[7]);
          *(v4u*)(ATT + (size_t)tok * DMIX + 512 + 8 * lane) = o; }
    }
}

struct Args { const void* in[19]; float* out; unsigned char* ws; int ph_lo, ph_hi, li, pad; };
__global__ void __launch_bounds__(NWAVES * 64, 2) mega_fwd(Args args) {
    extern __shared__ __attribute__((aligned(16))) unsigned char lds_raw[];
    LAS unsigned char* lds = (LAS unsigned char*)lds_raw;
    const int G = gridDim.x;
    const int NGW = G * NWAVES;
    unsigned char* ws = args.ws;
    unsigned* ctl = (unsigned*)(ws + WS_CTL);
    for (int u = threadIdx.x; u < (LDS_BYTES - LDSCTL_OFF) / 4; u += NWAVES * 64) ((LAS unsigned*)(lds + LDSCTL_OFF))[u] = 0u;
    __syncthreads();
    volatile LAS unsigned* MISC = (volatile LAS unsigned*)(lds + MISC_OFF);
    const int lo = args.ph_lo, hi = args.ph_hi;
    XcdBarrier bar; bar.bar = ctl + CW_BAR + args.li * XCD_BAR_WORDS; bar.x = 0; bar.st = nullptr;
    if (hi - lo > 1) bar = xcd_barrier_post(ctl + CW_BAR + args.li * XCD_BAR_WORDS, MISC + 8);
    int ph = 0;
#define PH_BEGIN if (ph >= lo && ph < hi) { int tid = threadIdx.x; asm volatile("" : "+v"(tid)); const int lane = tid & 63, wave = __builtin_amdgcn_readfirstlane(tid >> 6); const int gw = blockIdx.x * NWAVES + wave; (void)lane; (void)gw;
#define PH_END   if (ph + 1 < hi) xcd_barrier(bar); } ++ph;

    const float* x_in = (const float*)args.in[0];
    const int* positions = (const int*)args.in[1];
    float* xres = args.out;
    bf16* Wt_in = (bf16*)(ws + WS_WIN); bf16* Wt_out = (bf16*)(ws + WS_WOUT); bf16* Wt_gud = (bf16*)(ws + WS_WGU_D); bf16* Wt_dnd = (bf16*)(ws + WS_WDN_D);
    bf16* Wt_gum = (bf16*)(ws + WS_WGU_M); bf16* Wt_dnm = (bf16*)(ws + WS_WDN_M);
    float* rope_c = (float*)(ws + WS_ROPE); float* rope_s = rope_c + (size_t)M * 64;
    bf16* XN = (bf16*)(ws + WS_XN); bf16* ATT = (bf16*)(ws + WS_ATT); float* COMB = (float*)(ws + WS_COMB); float* LSE = (float*)(ws + WS_LSE);
    bf16* Hb = (bf16*)(ws + WS_H); float* OSB = (float*)(ws + WS_OSB); bf16* ODIL = (bf16*)(ws + WS_ODIL); bf16* HMID = (bf16*)(ws + WS_HMID);

    PH_BEGIN
    {
        LAS float* scr = (LAS float*)(lds + RING_OFF + wave * 16384);
        constexpr int I_IN = 4 * (DM / 64) * (DIN / 32), I_OUT = 4 * (DMIX / 64) * (DM / 32), I_GD = 2 * (DM / 64) * (DFF / 32), I_DD = 2 * (DFF / 64) * (DM / 32);
        constexpr int I_GM = 16 * (DM / 64) * (DFE / 32), I_DM = 16 * (DFE / 64) * (DM / 32);
        constexpr int NITEMS = I_IN + I_OUT + 2 * I_GD + I_DD + 2 * I_GM + I_DM;
        for (int it = gw; it < NITEMS; it += NGW) {
            int r = it;
            if (r < I_IN) { transpose_group((const float*)args.in[3], Wt_in, DM, DIN, 0, (size_t)DIN * DM, r, scr, lane); continue; } r -= I_IN;
            if (r < I_OUT) { transpose_group((const float*)args.in[10], Wt_out, DMIX, DM, 0, (size_t)DM * DMIX, r, scr, lane); continue; } r -= I_OUT;
            if (r < I_GD) { transpose_group((const float*)args.in[12], Wt_gud, DM, DFF, 1, (size_t)2 * DFF * DM, r, scr, lane); continue; } r -= I_GD;
            if (r < I_GD) { transpose_group((const float*)args.in[13], Wt_gud, DM, DFF, 2, (size_t)2 * DFF * DM, r, scr, lane); continue; } r -= I_GD;
            if (r < I_DD) { transpose_group((const float*)args.in[14], Wt_dnd, DFF, DM, 0, (size_t)DM * DFF, r, scr, lane); continue; } r -= I_DD;
            if (r < I_GM) { transpose_group((const float*)args.in[16], Wt_gum, DM, DFE, 1, (size_t)2 * DFE * DM, r, scr, lane); continue; } r -= I_GM;
            if (r < I_GM) { transpose_group((const float*)args.in[17], Wt_gum, DM, DFE, 2, (size_t)2 * DFE * DM, r, scr, lane); continue; } r -= I_GM;
            transpose_group((const float*)args.in[18], Wt_dnm, DFE, DM, 0, (size_t)DM * DFE, r, scr, lane);
        }
        for (int idx = blockIdx.x * (NWAVES * 64) + tid; idx < M * 64; idx += G * NWAVES * 64) {
            const int tok = idx >> 6, i = idx & 63; const float ang = (float)positions[tok] * ROPE_INV[i];
            float sn, cs; sincos_d((double)ang, sn, cs); rope_c[idx] = cs; rope_s[idx] = sn; }
    }
    PH_END

    for (int layer = 0; layer < DEPTH; ++layer) {
        const int j2 = layer >> 1; const bool dense = (layer & 1) == 0;
        const float* xsrc = (layer == 0) ? x_in : xres;
        PH_BEGIN
        norm_phase<false>(xsrc, (const float*)args.in[2] + (size_t)layer * DM, XN, nullptr, nullptr, gw, NGW, lane);
        PH_END
        PH_BEGIN
        { pg8::Gemm g{XN, Wt_in + (size_t)layer * DIN * DM, M, DIN, DM}; pg8::StaticOrder S; S.init(M, DIN, G, (int)blockIdx.x);
          pg8::EpiBf16 E{Hb, DIN};
          pg8::gemm_phase<pg8::EpiBf16, pg8::StaticOrder, PG8_ALIGN, PG8_SP2>(lds + RING_OFF, g, S, E); }
        PH_END
        PH_BEGIN
        qkprep_phase(Hb, (const float*)args.in[4] + layer * HD, (const float*)args.in[5] + layer * HD, (const float*)args.in[6] + layer * HD, (const float*)args.in[7] + layer * HD, rope_c, rope_s, gw, NGW, lane);
        PH_END
        PH_BEGIN
        attn_phase(Hb, OSB, ODIL, LSE, lds + RING_OFF, gw, NGW, wave, lane);
        PH_END
        PH_BEGIN
        combine_phase(OSB, ODIL, LSE, (const float*)args.in[8] + layer * DSB, (const float*)args.in[9] + layer * 512, ATT, gw, NGW, lane);
        PH_END
        PH_BEGIN
        { pg8::Gemm g{ATT, Wt_out + (size_t)layer * DM * DMIX, M, DM, DMIX}; pg8::StaticOrder S; S.init(M, DM, G, (int)blockIdx.x);
          pg8::EpiResAdd E{xsrc, xres, DM, nullptr, 0};
          pg8::gemm_phase<pg8::EpiResAdd, pg8::StaticOrder, PG8_ALIGN, PG8_SP2>(lds + RING_OFF, g, S, E); }
        PH_END
        PH_BEGIN
        if (dense) norm_phase<false>(xres, (const float*)args.in[11] + (size_t)layer * DM, XN, nullptr, nullptr, gw, NGW, lane);
        else norm_phase<true>(xres, (const float*)args.in[11] + (size_t)layer * DM, XN, (const float*)args.in[15] + (size_t)j2 * DM * NE, COMB, gw, NGW, lane);
        PH_END
        if (dense) {
            PH_BEGIN
            { pg8::Gemm g{XN, Wt_gud + (size_t)j2 * 2 * DFF * DM, M, 2 * DFF, DM}; pg8::StaticOrder S; S.init(M, 2 * DFF, G, (int)blockIdx.x);
              pg8::EpiSwiGLU E{HMID, DFF};
              pg8::gemm_phase<pg8::EpiSwiGLU, pg8::StaticOrder, PG8_ALIGN, PG8_SP2>(lds + RING_OFF, g, S, E); }
            PH_END
            PH_BEGIN
            { pg8::Gemm g{HMID, Wt_dnd + (size_t)j2 * DM * DFF, M, DM, DFF}; pg8::StaticOrder S; S.init(M, DM, G, (int)blockIdx.x);
              pg8::EpiResAdd E{xres, xres, DM, nullptr, 0};
              pg8::gemm_phase<pg8::EpiResAdd, pg8::StaticOrder, PG8_ALIGN, PG8_SP2>(lds + RING_OFF, g, S, E); }
            PH_END
        } else {
            for (int e = 0; e < NE; ++e) {
                PH_BEGIN
                { pg8::Gemm g{XN, Wt_gum + (size_t)(j2 * NE + e) * 2 * DFE * DM, M, 2 * DFE, DM}; pg8::StaticOrder S; S.init(M, 2 * DFE, G, (int)blockIdx.x);
                  pg8::EpiSwiGLU E{HMID, DFE};
                  pg8::gemm_phase<pg8::EpiSwiGLU, pg8::StaticOrder, PG8_ALIGN, PG8_SP2>(lds + RING_OFF, g, S, E); }
                PH_END
                PH_BEGIN
                { pg8::Gemm g{HMID, Wt_dnm + (size_t)(j2 * NE + e) * DM * DFE, M, DM, DFE}; pg8::StaticOrder S; S.init(M, DM, G, (int)blockIdx.x);
                  pg8::EpiResAdd E{xres, xres, DM, COMB + e, NE};
                  pg8::gemm_phase<pg8::EpiResAdd, pg8::StaticOrder, PG8_ALIGN, PG8_SP2>(lds + RING_OFF, g, S, E); }
                PH_END
            }
        }
    }
#undef PH_BEGIN
#undef PH_END
}

constexpr int N_PHASES = 1 + 2 * (7 + 2) + 2 * (7 + 16);
#ifndef MK_PHASES_PER_LAUNCH
#define MK_PHASES_PER_LAUNCH 1
#endif
extern "C" void kernel_launch(void* const* d_in, const int* in_sizes, int n_in, void* d_out, int out_size, void* d_ws, size_t ws_size, hipStream_t stream) {
    static int grid = 0;
    if (grid == 0) {
        if (n_in != 19 || in_sizes[0] != M * DM || out_size != M * DM || ws_size < WS_END) { fprintf(stderr, "kernel_launch: unexpected problem (n_in %d, in0 %d, out %d, ws %zu)\n", n_in, n_in > 0 ? in_sizes[0] : -1, out_size, ws_size); grid = -1; return; }
        int dev = 0, cus = 0, per_cu = 0;
        if (hipGetDevice(&dev) != hipSuccess || hipDeviceGetAttribute(&cus, hipDeviceAttributeMultiprocessorCount, dev) != hipSuccess) { grid = -1; return; }
        if (hipFuncSetAttribute((const void*)mega_fwd, hipFuncAttributeMaxDynamicSharedMemorySize, LDS_BYTES) != hipSuccess) { fprintf(stderr, "kernel_launch: hipFuncSetAttribute failed\n"); grid = -1; return; }
        if (hipOccupancyMaxActiveBlocksPerMultiprocessor(&per_cu, (const void*)mega_fwd, NWAVES * 64, LDS_BYTES) != hipSuccess || per_cu < 1) { fprintf(stderr, "kernel_launch: occupancy query says %d\n", per_cu); }
        (void)hipGetLastError();
        grid = cus;
    }
    if (grid < 0) return;
    if (hipMemsetAsync((char*)d_ws + WS_CTL, 0, CTL_ZERO_BYTES, stream) != hipSuccess) return;
    Args a{};
    for (int i = 0; i < 19; ++i) a.in[i] = d_in[i];
    a.out = (float*)d_out; a.ws = (unsigned char*)d_ws;
    int li = 0;
    for (int p = 0; p < N_PHASES; p += MK_PHASES_PER_LAUNCH, ++li) {
        a.li = li; a.ph_lo = p; a.ph_hi = (p + MK_PHASES_PER_LAUNCH < N_PHASES) ? p + MK_PHASES_PER_LAUNCH : N_PHASES;
        hipLaunchKernelGGL(mega_fwd, dim3(grid), dim3(NWAVES * 64), LDS_BYTES, stream, a);
        if (hipPeekAtLastError() != hipSuccess) { fprintf(stderr, "kernel_launch: launch failed at phase %d\n", p); break; }
    }
}
```

```cpp
#include <hip/hip_runtime.h>
#include <cstdio>
#include <cstdint>
namespace pg8 {
#define PG8_LAS __attribute__((address_space(3)))
typedef unsigned short bf16_t;
typedef short bf16x8 __attribute__((ext_vector_type(8)));
typedef float f32x4 __attribute__((ext_vector_type(4)));
typedef unsigned u32x4 __attribute__((ext_vector_type(4)));
constexpr int BM = 256, BK = 64, HALF = 128, HTB = HALF * BK * 2  , STAGE_BYTES = 8 * HTB, NXCD = 8, WGM = 8;

__host__ __device__ __forceinline__ int lds_byte(int r, int c) { const int st = (r >> 4) * 2 + (c >> 5), rr = r & 15, cc = c & 31, ob = rr * 64 + cc * 2; return st * 1024 + (ob ^ (((ob >> 9) & 1) << 5)); }
__host__ __device__ __forceinline__ void stage_rc(int b, int& R, int& C) { const int st = b / 1024, sb = b % 1024, swz = sb ^ (((sb >> 9) & 1) << 5); R = (st >> 1) * 16 + swz / 64; C = (st & 1) * 32 + (swz % 64) / 2; }
__host__ __device__ __forceinline__ int perm32(int rho) { const int n = rho >> 4, i = rho & 15; return 8 * (i >> 2) + 4 * n + (i & 3); }

struct Unit { int pm, pn; };
struct Gemm { const bf16_t* A; const bf16_t* Bt; int M, N, K; };

struct StaticOrder {
    int nM, nN, nwg, G, c;
    __host__ __device__ void init(int M, int N, int G_, int c_) { nM = M / BM; nN = N / BM; nwg = nM * nN; G = G_; c = c_; }
    __host__ __device__ bool next(int i, Unit& u) const {
        const long L = (long)i * G + c; if (L >= nwg) return false;
        int wgid = (int)L; { const int q = nwg / NXCD, r = nwg % NXCD, xcd = wgid % NXCD, off = wgid / NXCD; wgid = (xcd < r ? xcd * (q + 1) : r * (q + 1) + (xcd - r) * q) + off; }
        const int nig = WGM * nN, gid = wgid / nig, fm = gid * WGM, gsz = (nM - fm) < WGM ? (nM - fm) : WGM;
        u.pm = fm + ((wgid % nig) % gsz); u.pn = (wgid % nig) / gsz; return true;
    }
    __device__ __forceinline__ void a_ready(const Unit&) const {}
    __device__ __forceinline__ void done(const Unit&) const {}
};


__device__ __forceinline__ unsigned cvt_pk_bf16(float lo, float hi) { unsigned r; asm volatile("v_cvt_pk_bf16_f32 %0, %1, %2" : "=v"(r) : "v"(lo), "v"(hi)); return r; }

struct EpiBf16 {
    static constexpr bool PERM = true, AFTER_DRAIN = false;
    bf16_t* O; int ldc;
    __device__ __forceinline__ void operator()(const f32x4 (&acc)[2][2][4][2], const Unit& u, int wr, int wc, int fr, int fq) const {
        const int row0 = u.pm * BM + wr * 64 + fr; const int col0 = u.pn * BM + wc * 32 + 8 * fq;
#pragma unroll
        for (int ai = 0; ai < 2; ++ai)
#pragma unroll
            for (int m = 0; m < 4; ++m) { bf16_t* rowp = O + (size_t)(row0 + ai * HALF + m * 16) * ldc + col0;
#pragma unroll
                for (int bj = 0; bj < 2; ++bj) { const f32x4 v0 = acc[ai][bj][m][0], v1 = acc[ai][bj][m][1];
                    u32x4 w; w.x = cvt_pk_bf16(v0[0], v0[1]); w.y = cvt_pk_bf16(v0[2], v0[3]); w.z = cvt_pk_bf16(v1[0], v1[1]); w.w = cvt_pk_bf16(v1[2], v1[3]);
                    *(u32x4*)(rowp + bj * HALF) = w; } }
    }
};
__device__ __forceinline__ float silu_mul(float g, float u) { const float e = __builtin_amdgcn_exp2f(-1.4426950408889634f * g); return g * __builtin_amdgcn_rcpf(1.0f + e) * u; }
struct EpiSwiGLU {
    static constexpr bool PERM = true, AFTER_DRAIN = false;
    bf16_t* O; int ldc;
    __device__ __forceinline__ void operator()(const f32x4 (&acc)[2][2][4][2], const Unit& u, int wr, int wc, int fr, int fq) const {
        const int row0 = u.pm * BM + wr * 64 + fr; const int col0 = u.pn * HALF + wc * 32 + 8 * fq;
#pragma unroll
        for (int ai = 0; ai < 2; ++ai)
#pragma unroll
            for (int m = 0; m < 4; ++m) { bf16_t* rowp = O + (size_t)(row0 + ai * HALF + m * 16) * ldc + col0;
                const f32x4 g0 = acc[ai][0][m][0], g1 = acc[ai][0][m][1], u0 = acc[ai][1][m][0], u1 = acc[ai][1][m][1];
                u32x4 w; w.x = cvt_pk_bf16(silu_mul(g0[0], u0[0]), silu_mul(g0[1], u0[1])); w.y = cvt_pk_bf16(silu_mul(g0[2], u0[2]), silu_mul(g0[3], u0[3]));
                w.z = cvt_pk_bf16(silu_mul(g1[0], u1[0]), silu_mul(g1[1], u1[1])); w.w = cvt_pk_bf16(silu_mul(g1[2], u1[2]), silu_mul(g1[3], u1[3]));
                *(u32x4*)rowp = w; }
    }
};
struct EpiResAdd {
    static constexpr bool PERM = false, AFTER_DRAIN = false;
    const float* in; float* out; int ldc; const float* rowscale; int rs_stride;
    __device__ __forceinline__ void operator()(const f32x4 (&acc)[2][2][4][2], const Unit& u, int wr, int wc, int fr, int fq) const {
        const int col0 = u.pn * BM + wc * 32 + 4 * fq;
#pragma unroll
        for (int ai = 0; ai < 2; ++ai)
#pragma unroll
            for (int m = 0; m < 4; ++m) { const int r = u.pm * BM + ai * HALF + wr * 64 + m * 16 + fr; const size_t off = (size_t)r * ldc + col0;
                const float sc = rowscale ? rowscale[(size_t)r * rs_stride] : 1.0f;
#pragma unroll
                for (int bj = 0; bj < 2; ++bj)
#pragma unroll
                    for (int n = 0; n < 2; ++n) { const f32x4 bs = *(const f32x4*)(in + off + bj * HALF + n * 16); *(f32x4*)(out + off + bj * HALF + n * 16) = bs + acc[ai][bj][m][n] * sc; }
                if (m & 1) asm volatile("" ::: "memory"); }
    }
};

template <class Epi, class Sched, bool ALIGN_EPI = false, bool SP2 = false>
__device__ __forceinline__ void gemm_phase(PG8_LAS unsigned char* lds, const Gemm g, const Sched& S, const Epi& E) {
    int tid_ = threadIdx.x; asm volatile("" : "+v"(tid_));
    const int tid = tid_, wid = __builtin_amdgcn_readfirstlane(tid >> 6), lane = tid & 63, wr = wid >> 2, wc = wid & 3, fr = lane & 15, fq = lane >> 4;
    const int K = g.K, nt = K / BK;
    unsigned voffA[2], voffB[2];
#pragma unroll
    for (int i = 0; i < 2; ++i) { int R, C; stage_rc(tid * 16 + i * 8192, R, C); const int Rb = Epi::PERM ? ((R & ~31) + perm32(R & 31)) : R;
        voffA[i] = (unsigned)(R * K + C) * 2u; voffB[i] = (unsigned)(Rb * K + C) * 2u; }
    const size_t kstep = (size_t)(BK * 2);
    const size_t hstep = (size_t)HALF * K * 2;
    const size_t tstep = 2 * hstep;
    const unsigned ldsw = (unsigned)wid * 1024u;
    const int aoff = lds_byte(wr * 64 + fr, fq * 8), boff = lds_byte(wc * 32 + fr, fq * 8);
#define PG8_SA(b, h) (((b) * 2 + (h)) * HTB)
#define PG8_SB(b, h) ((4 + (b) * 2 + (h)) * HTB)
#define PG8_STAGE(bufoff, gbase, voff) do { _Pragma("unroll") for (int _i = 0; _i < 2; ++_i) \
        __builtin_amdgcn_global_load_lds((const unsigned*)((const char*)(gbase) + (voff)[_i]), (PG8_LAS unsigned*)(lds + (bufoff) + ldsw + _i * 8192), 16, 0, 0); } while (0)
#define PG8_LDA(dst, b, h) do { _Pragma("unroll") for (int m = 0; m < 4; ++m) _Pragma("unroll") for (int k = 0; k < 2; ++k) dst[m][k] = *(const PG8_LAS bf16x8*)(lds + PG8_SA(b, h) + aoff + m * 2048 + k * 1024); } while (0)
#define PG8_LDB(dst, b, h) do { _Pragma("unroll") for (int n = 0; n < 2; ++n) _Pragma("unroll") for (int k = 0; k < 2; ++k) dst[n][k] = *(const PG8_LAS bf16x8*)(lds + PG8_SB(b, h) + boff + n * 2048 + k * 1024); } while (0)
#define PG8_MMA(ai, bj, At, Bt) do { __builtin_amdgcn_s_setprio(1); _Pragma("unroll") for (int m = 0; m < 4; ++m) _Pragma("unroll") for (int n = 0; n < 2; ++n) _Pragma("unroll") for (int k = 0; k < 2; ++k) \
        acc[ai][bj][m][n] = __builtin_amdgcn_mfma_f32_16x16x32_bf16(Bt[n][k], At[m][k], acc[ai][bj][m][n], 0, 0, 0); __builtin_amdgcn_s_setprio(0); } while (0)
#define PG8_WAIT_V(n) asm volatile("s_waitcnt vmcnt(" #n ")" ::: "memory")
#define PG8_WAIT_L(n) asm volatile("s_waitcnt lgkmcnt(" #n ")" ::: "memory")
#define PG8_BAR __builtin_amdgcn_s_barrier()
#define PG8_SCHED __builtin_amdgcn_sched_barrier(0)
    Unit cur, nxt; int ui = 0;
    if (!S.next(0, cur)) return;
    f32x4 acc[2][2][4][2];
#pragma unroll
    for (int a = 0; a < 2; ++a)
#pragma unroll
        for (int b = 0; b < 2; ++b)
#pragma unroll
            for (int m = 0; m < 4; ++m)
#pragma unroll
                for (int n = 0; n < 2; ++n) acc[a][b][m][n] = (f32x4){0.f, 0.f, 0.f, 0.f};
    bf16x8 At[4][2], B0[2][2], B1[2][2];
    const char* cA = (const char*)g.A + (size_t)cur.pm * tstep; const char* cB = (const char*)g.Bt + (size_t)cur.pn * tstep;
    S.a_ready(cur);
    if constexpr (SP2) {
        PG8_STAGE(PG8_SB(0, 0), cB, voffB); PG8_STAGE(PG8_SB(0, 1), cB + hstep, voffB); PG8_STAGE(PG8_SA(0, 0), cA, voffA); PG8_STAGE(PG8_SA(0, 1), cA + hstep, voffA);
        if (wr == 1) PG8_BAR;
        PG8_WAIT_V(2); PG8_BAR;
        PG8_STAGE(PG8_SB(1, 0), cB + kstep, voffB); PG8_STAGE(PG8_SA(1, 0), cA + kstep, voffA); PG8_STAGE(PG8_SB(1, 1), cB + hstep + kstep, voffB);
        PG8_WAIT_V(6); PG8_BAR;
    } else {
        PG8_STAGE(PG8_SB(0, 0), cB, voffB); PG8_STAGE(PG8_SA(0, 0), cA, voffA); PG8_STAGE(PG8_SB(0, 1), cB + hstep, voffB); PG8_STAGE(PG8_SA(0, 1), cA + hstep, voffA);
        if (wr == 1) PG8_BAR;
        PG8_WAIT_V(4); PG8_BAR;
        PG8_STAGE(PG8_SB(1, 0), cB + kstep, voffB); PG8_STAGE(PG8_SA(1, 0), cA + kstep, voffA); PG8_STAGE(PG8_SB(1, 1), cB + hstep + kstep, voffB);
        PG8_WAIT_V(6); PG8_BAR;
    }
    for (;;) {
        const bool has_next = S.next(ui + 1, nxt);
        const char* nA = has_next ? (const char*)g.A + (size_t)nxt.pm * tstep : cA; const char* nB = has_next ? (const char*)g.Bt + (size_t)nxt.pn * tstep : cB;
        for (int t = 0; t < nt; t += 2) {
            const bool last = (t == nt - 2);
            const char* a1 = cA + (size_t)(t + 1) * kstep;
            const char* a2 = last ? nA : cA + (size_t)(t + 2) * kstep; const char* b2 = last ? nB : cB + (size_t)(t + 2) * kstep;
            const char* a3 = a2 + kstep; const char* b3 = b2 + kstep;
            if (last && has_next) S.a_ready(nxt);
            if constexpr (SP2) {
            PG8_LDB(B0, 0, 0); PG8_LDB(B1, 0, 1); PG8_SCHED; PG8_LDA(At, 0, 0); PG8_STAGE(PG8_SA(1, 1), a1 + hstep, voffA);
            PG8_WAIT_V(8); PG8_WAIT_L(0); PG8_BAR; PG8_MMA(0, 0, At, B0); PG8_MMA(0, 1, At, B1); PG8_BAR; PG8_SCHED;
            PG8_LDA(At, 0, 1); PG8_STAGE(PG8_SB(0, 0), b2, voffB); PG8_STAGE(PG8_SB(0, 1), b2 + hstep, voffB); PG8_STAGE(PG8_SA(0, 0), a2, voffA);
            PG8_WAIT_V(8); PG8_WAIT_L(0); PG8_BAR; PG8_MMA(1, 0, At, B0); PG8_MMA(1, 1, At, B1); PG8_BAR; PG8_SCHED;
            PG8_LDB(B0, 1, 0); PG8_LDB(B1, 1, 1); PG8_SCHED; PG8_LDA(At, 1, 0); PG8_STAGE(PG8_SA(0, 1), a2 + hstep, voffA);
            PG8_WAIT_V(8); PG8_WAIT_L(0); PG8_BAR; PG8_MMA(0, 0, At, B0); PG8_MMA(0, 1, At, B1); PG8_BAR; PG8_SCHED;
            PG8_LDA(At, 1, 1); PG8_STAGE(PG8_SB(1, 0), b3, voffB); PG8_STAGE(PG8_SB(1, 1), b3 + hstep, voffB); PG8_STAGE(PG8_SA(1, 0), a3, voffA);
            PG8_WAIT_V(8); PG8_WAIT_L(0); PG8_BAR; PG8_MMA(1, 0, At, B0); PG8_MMA(1, 1, At, B1); PG8_BAR; PG8_SCHED;
            } else {
            PG8_LDB(B0, 0, 0); PG8_SCHED; PG8_LDA(At, 0, 0); PG8_STAGE(PG8_SA(1, 1), a1 + hstep, voffA);
            PG8_WAIT_L(8); PG8_BAR; PG8_WAIT_L(0); PG8_MMA(0, 0, At, B0); PG8_BAR; PG8_SCHED;
            PG8_LDB(B1, 0, 1); PG8_STAGE(PG8_SB(0, 0), b2, voffB);
            PG8_BAR; PG8_WAIT_L(0); PG8_MMA(0, 1, At, B1); PG8_BAR;
            PG8_LDA(At, 0, 1); PG8_STAGE(PG8_SA(0, 0), a2, voffA);
            PG8_BAR; PG8_WAIT_L(0); PG8_MMA(1, 0, At, B0); PG8_BAR; PG8_SCHED;
            PG8_STAGE(PG8_SB(0, 1), b2 + hstep, voffB);
            PG8_WAIT_V(6); PG8_BAR; PG8_MMA(1, 1, At, B1); PG8_BAR;
            PG8_LDB(B0, 1, 0); PG8_SCHED; PG8_LDA(At, 1, 0); PG8_STAGE(PG8_SA(0, 1), a2 + hstep, voffA);
            PG8_WAIT_L(8); PG8_BAR; PG8_WAIT_L(0); PG8_MMA(0, 0, At, B0); PG8_BAR; PG8_SCHED;
            PG8_LDB(B1, 1, 1); PG8_STAGE(PG8_SB(1, 0), b3, voffB);
            PG8_BAR; PG8_WAIT_L(0); PG8_MMA(0, 1, At, B1); PG8_BAR;
            PG8_LDA(At, 1, 1); PG8_STAGE(PG8_SA(1, 0), a3, voffA);
            PG8_BAR; PG8_WAIT_L(0); PG8_MMA(1, 0, At, B0); PG8_BAR; PG8_SCHED;
            PG8_STAGE(PG8_SB(1, 1), b3 + hstep, voffB);
            PG8_WAIT_V(6); PG8_BAR; PG8_MMA(1, 1, At, B1); PG8_BAR;
            }
        }
        if constexpr (ALIGN_EPI) { if (wr == 0) PG8_BAR; }
        if constexpr (!Epi::AFTER_DRAIN) { E(acc, cur, wr, wc, fr, fq); S.done(cur); }
        if (!has_next) break;
#pragma unroll
        for (int a = 0; a < 2; ++a)
#pragma unroll
            for (int b = 0; b < 2; ++b)
#pragma unroll
                for (int m = 0; m < 4; ++m)
#pragma unroll
                    for (int n = 0; n < 2; ++n) acc[a][b][m][n] = (f32x4){0.f, 0.f, 0.f, 0.f};
        cur = nxt; cA = nA; cB = nB; ++ui;
        if constexpr (ALIGN_EPI) { if (wr == 1) PG8_BAR; }
    }
    PG8_WAIT_V(0);
    if constexpr (!ALIGN_EPI) { if (wr == 0) PG8_BAR; }
    PG8_BAR;
    if constexpr (Epi::AFTER_DRAIN) { E.fused(acc, cur, wr, wc, fr, fq, lds, wid, lane); S.done(cur); }
#undef PG8_SA
#undef PG8_SB
#undef PG8_STAGE
#undef PG8_LDA
#undef PG8_LDB
#undef PG8_MMA
#undef PG8_WAIT_V
#undef PG8_WAIT_L
#undef PG8_BAR
#undef PG8_SCHED
}
}

#ifndef PG8_SP2
#define PG8_SP2 true
#endif
#ifndef PG8_ALIGN
#define PG8_ALIGN true
#endif

constexpr int NB = 4, SEQ = 8192, DM = 2048, DEPTH = 4, HD = 128, DSB = 512, DMIX = 1024, DIN = 3072, DFF = 5632, DFE = 1408, NE = 8;
constexpr int M = NB * SEQ;
constexpr float EPS = 1e-6f;
constexpr int NWAVES = 8;
constexpr int C_QSB = 0, C_KSB = 512, C_VSB = 1024, C_QDIL = 1536, C_KDIL = 2048, C_VDIL = 2560;

constexpr size_t MiB = 1u << 20;
constexpr size_t WS_CTL = 0, CTL_ZERO_BYTES = 1 * MiB;
constexpr size_t WS_WIN = 1 * MiB;
constexpr size_t WS_WOUT = 49 * MiB;
constexpr size_t WS_WGU_D = 65 * MiB;
constexpr size_t WS_WDN_D = 153 * MiB;
constexpr size_t WS_WGU_M = 197 * MiB;
constexpr size_t WS_WDN_M = 373 * MiB;
constexpr size_t WS_ROPE = 461 * MiB;
constexpr size_t WS_XN = 477 * MiB;
constexpr size_t WS_ATT = 605 * MiB;
constexpr size_t WS_COMB = 669 * MiB;
constexpr size_t WS_LSE = 670 * MiB;
constexpr size_t WS_BIG = 672 * MiB;
constexpr size_t WS_H = WS_BIG, WS_OSB = WS_BIG + 192 * MiB, WS_ODIL = WS_BIG + 256 * MiB, WS_HMID = WS_BIG;
constexpr size_t WS_END = 1024 * MiB;
static_assert(WS_WIN + (size_t)4 * 3072 * 2048 * 2 <= WS_WOUT && WS_WOUT + (size_t)4 * 2048 * 1024 * 2 <= WS_WGU_D && WS_WGU_D + (size_t)2 * 11264 * 2048 * 2 <= WS_WDN_D &&
              WS_WDN_D + (size_t)2 * 2048 * 5632 * 2 <= WS_WGU_M && WS_WGU_M + (size_t)16 * 2816 * 2048 * 2 <= WS_WDN_M && WS_WDN_M + (size_t)16 * 2048 * 1408 * 2 <= WS_ROPE &&
              WS_ROPE + (size_t)2 * M * 64 * 4 <= WS_XN && WS_XN + (size_t)M * DM * 2 <= WS_ATT && WS_ATT + (size_t)M * DMIX * 2 <= WS_COMB && WS_COMB + (size_t)M * 8 * 4 <= WS_LSE &&
              WS_LSE + (size_t)3 * M * 4 * 4 <= WS_BIG && WS_BIG + (size_t)M * DFF * 2 <= WS_END && WS_ODIL + (size_t)3 * M * 512 * 2 <= WS_END, "d_ws map");
constexpr int CW_BAR = 4096;

constexpr int RING_OFF = 0, RING_BYTES = 131072;
constexpr int LDSCTL_OFF = RING_BYTES, MISC_OFF = LDSCTL_OFF + 320;
constexpr int LDS_BYTES = 147456;

#define GAS __attribute__((address_space(1)))
#define LAS __attribute__((address_space(3)))
typedef unsigned short bf16;
typedef unsigned v4u __attribute__((ext_vector_type(4)));
typedef unsigned v2u __attribute__((ext_vector_type(2)));
typedef float f32x4 __attribute__((ext_vector_type(4)));
typedef float f32x16 __attribute__((ext_vector_type(16)));
typedef short bf16x8 __attribute__((ext_vector_type(8)));
typedef short s16x4 __attribute__((ext_vector_type(4)));
#define LDS_WAIT() asm volatile("s_waitcnt lgkmcnt(0)" ::: "memory")
#define VM_WAIT() asm volatile("s_waitcnt vmcnt(0)" ::: "memory")
__device__ __forceinline__ unsigned f2bf(float f) { unsigned u = __builtin_bit_cast(unsigned, f); return (u + 0x7fffu + ((u >> 16) & 1u)) >> 16; }
__device__ __forceinline__ unsigned pk2(float lo, float hi) { return f2bf(lo) | (f2bf(hi) << 16); }
__device__ __forceinline__ float bf_lo(unsigned w) { return __builtin_bit_cast(float, w << 16); }
__device__ __forceinline__ float bf_hi(unsigned w) { return __builtin_bit_cast(float, w & 0xffff0000u); }

#define XB_TMO      128
#define XB_XCNT(j)  (256  + 64 * (j))
#define XB_XSUB(j)  (1280 + 64 * (j))
#define XB_XGEN(j)  (2304 + 64 * (j))
#define XB_TOP      3328
#define XB_TOPGEN   3392
#define XCD_BAR_WORDS 3456
#define XB_SPIN_CAP (1u << 18)

__device__ __forceinline__ unsigned xb_ld(unsigned* p)              { return __hip_atomic_load(p, __ATOMIC_RELAXED, __HIP_MEMORY_SCOPE_AGENT); }
__device__ __forceinline__ unsigned xb_add(unsigned* p, unsigned v) { return __hip_atomic_fetch_add(p, v, __ATOMIC_RELAXED, __HIP_MEMORY_SCOPE_AGENT); }
__device__ __forceinline__ unsigned xb_xcc_id() { return (unsigned)__builtin_amdgcn_s_getreg((3 << 11) | 20) & 0xFu; }
#define XB_SPIN(cond, bar) do { unsigned _sp = 0; while (cond) { __builtin_amdgcn_s_sleep(1); \
    if ((++_sp & 255u) == 0u) { if (xb_ld(&(bar)[XB_TMO])) break; if (_sp > XB_SPIN_CAP) { atomicAdd(&(bar)[XB_TMO], 1u); break; } } } } while (0)

struct XcdBarrier {
    unsigned* bar; unsigned x;
    volatile LAS unsigned* st;
};
__device__ __forceinline__ XcdBarrier xcd_barrier_post(unsigned* bar, volatile LAS unsigned* st) {
    XcdBarrier b; b.bar = bar; b.x = xb_xcc_id(); b.st = st;
    if (threadIdx.x == 0) (void)xb_add(&bar[XB_XCNT(b.x)], 1u);
    return b;
}
__device__ __forceinline__ void xcd_barrier_complete(unsigned* bar, unsigned x, unsigned& nloc, unsigned& nx) {
    const unsigned G = gridDim.x * gridDim.y * gridDim.z;
    unsigned sum, cnt, mine, sp = 0u;
    for (;;) {
        sum = 0u; cnt = 0u; mine = 0u;
#pragma unroll
        for (unsigned j = 0; j < 16; ++j) { const unsigned c = xb_ld(&bar[XB_XCNT(j)]); sum += c; cnt += (c > 0u) ? 1u : 0u; mine = (j == x) ? c : mine; }
        if (sum == G) break;
        __builtin_amdgcn_s_sleep(1);
        if ((++sp & 255u) == 0u) { if (xb_ld(&bar[XB_TMO])) break; if (sp > XB_SPIN_CAP) { atomicAdd(&bar[XB_TMO], 1u); break; } }
    }
    nloc = mine > 0u ? mine : 1u; nx = cnt > 0u ? cnt : 1u;
}
__device__ __forceinline__ void xcd_barrier(const XcdBarrier& b) {
    asm volatile("s_waitcnt vmcnt(0)" ::: "memory");
    __syncthreads();
    if (threadIdx.x == 0) {
        unsigned* bar = b.bar;
        __builtin_amdgcn_s_waitcnt(0);
        unsigned nloc = b.st[0], nx = b.st[1];
        if (nloc == 0u) { xcd_barrier_complete(bar, b.x, nloc, nx); b.st[0] = nloc; b.st[1] = nx; }
        const unsigned old = xb_add(&bar[XB_XSUB(b.x)], 1u);
        const unsigned gen = old / nloc;
        if (old + 1u == (gen + 1u) * nloc) {
            __builtin_amdgcn_fence(__ATOMIC_RELEASE, "agent");
            asm volatile("s_waitcnt vmcnt(0)" ::: "memory");
            const unsigned og = xb_add(&bar[XB_TOP], 1u);
            const unsigned tg = og / nx;
            if (og + 1u == (tg + 1u) * nx) xb_add(&bar[XB_TOPGEN], 1u);
            else XB_SPIN(xb_ld(&bar[XB_TOPGEN]) == tg, bar);
            __builtin_amdgcn_fence(__ATOMIC_ACQUIRE, "agent");
            xb_add(&bar[XB_XGEN(b.x)], 1u);
            asm volatile("s_waitcnt vmcnt(0)" ::: "memory");
        } else {
            XB_SPIN(xb_ld(&bar[XB_XGEN(b.x)]) == gen, bar);
            __builtin_amdgcn_fence(__ATOMIC_ACQUIRE, "agent");
            asm volatile("s_waitcnt vmcnt(0)" ::: "memory");
        }
    }
    __syncthreads();
}

__device__ __forceinline__ float wave_sum(float v) {
#pragma unroll
    for (int o = 1; o < 64; o <<= 1) v += __shfl_xor(v, o);
    return v;
}
__device__ const float ROPE_INV[64] = {
    1.0f, 0.8659643233600653f, 0.7498942093324559f, 0.6493816315762113f, 0.5623413251903491f, 0.4869675251658631f, 0.4216965034285822f, 0.3651741272548377f,
    0.31622776601683794f, 0.27384196342643613f, 0.23713737056616552f, 0.2053525026457146f, 0.1778279410038923f, 0.1539926526059492f, 0.1333521432163324f, 0.11547819846894582f,
    0.1f, 0.08659643233600653f, 0.07498942093324558f, 0.06493816315762113f, 0.05623413251903491f, 0.04869675251658631f, 0.042169650342858224f, 0.03651741272548377f,
    0.03162277660168379f, 0.027384196342643614f, 0.023713737056616554f, 0.02053525026457146f, 0.01778279410038923f, 0.01539926526059492f, 0.01333521432163324f, 0.011547819846894581f,
    0.01f, 0.008659643233600654f, 0.007498942093324558f, 0.006493816315762113f, 0.005623413251903491f, 0.004869675251658631f, 0.004216965034285823f, 0.003651741272548377f,
    0.0031622776601683794f, 0.0027384196342643613f, 0.0023713737056616554f, 0.002053525026457146f, 0.0017782794100389228f, 0.001539926526059492f, 0.001333521432163324f, 0.0011547819846894581f,
    0.001f, 0.0008659643233600654f, 0.0007498942093324559f, 0.0006493816315762113f, 0.0005623413251903491f, 0.0004869675251658631f, 0.00042169650342858224f, 0.0003651741272548377f,
    0.00031622776601683794f, 0.0002738419634264361f, 0.00023713737056616554f, 0.0002053525026457146f, 0.00017782794100389227f, 0.0001539926526059492f, 0.0001333521432163324f, 0.00011547819846894582f };
__device__ __forceinline__ void sincos_d(double a, float& sn, float& cs) {
    const double k = __builtin_rint(a * 0.15915494309189535);
    double r = __builtin_fma(-k, 6.283185307179586, a); r = __builtin_fma(-k, 2.4492935982947064e-16, r);
    const double r2 = r * r;
    double s = -9.18368986379554601e-29;
    s = s * r2 + 6.44695028438447359e-26; s = s * r2 + -3.86817017063068413e-23; s = s * r2 + 1.95729410633912626e-20; s = s * r2 + -8.22063524662432950e-18;
    s = s * r2 + 2.81145725434552060e-15; s = s * r2 + -7.64716373181981641e-13; s = s * r2 + 1.60590438368216133e-10; s = s * r2 + -2.50521083854417202e-08;
    s = s * r2 + 2.75573192239858925e-06; s = s * r2 + -1.98412698412698413e-04; s = s * r2 + 8.33333333333333322e-03; s = s * r2 + -1.66666666666666657e-01; s = s * r2 + 1.0;
    double c = 3.27988923706983776e-30;
    c = c * r2 + -2.47959626322479759e-27; c = c * r2 + 1.61173757109611839e-24; c = c * r2 + -8.89679139245057408e-22; c = c * r2 + 4.11031762331216484e-19;
    c = c * r2 + -1.56192069685862253e-16; c = c * r2 + 4.77947733238738525e-14; c = c * r2 + -1.14707455977297245e-11; c = c * r2 + 2.08767569878681002e-09;
    c = c * r2 + -2.75573192239858883e-07; c = c * r2 + 2.48015873015873016e-05; c = c * r2 + -1.38888888888888894e-03; c = c * r2 + 4.16666666666666644e-02; c = c * r2 + -0.5; c = c * r2 + 1.0;
    sn = (float)(s * r); cs = (float)c;
}

__device__ __forceinline__ void transpose_item(const float* W, int K, int N, bf16* WT, int mode, LAS float* scr, int item, int lane) {
    const int nblk = N / 32, kb = item / nblk, nb = item % nblk, k0 = 64 * kb, n0 = 32 * nb;
#pragma unroll 8
    for (int i = 0; i < 32; ++i) { const int kk = 2 * i + (lane >> 5); scr[kk * 33 + (lane & 31)] = W[(size_t)(k0 + kk) * N + n0 + (lane & 31)]; }
    LDS_WAIT(); asm volatile("" ::: "memory");
    const int c = lane & 7;
#pragma unroll
    for (int j = 0; j < 4; ++j) { const int n = (lane >> 3) + 8 * j; const LAS float* s = scr + (8 * c) * 33 + n;
        const int nn = n0 + n; const int drow = (mode == 0) ? nn : ((nn >> 7) * 256 + (mode == 2 ? 128 : 0) + (nn & 127));
        v4u o; o.x = pk2(s[0 * 33], s[1 * 33]); o.y = pk2(s[2 * 33], s[3 * 33]); o.z = pk2(s[4 * 33], s[5 * 33]); o.w = pk2(s[6 * 33], s[7 * 33]);
        *(v4u*)(WT + (size_t)drow * K + k0 + 8 * c) = o; }
    LDS_WAIT(); asm volatile("" ::: "memory");
}
__device__ __forceinline__ void transpose_group(const float* src, bf16* dst, int K, int N, int mode, size_t dstride, int r, LAS float* scr, int lane) {
    const int per = (K / 64) * (N / 32); const int l = r / per, it = r % per;
    transpose_item(src + (size_t)l * K * N, K, N, dst + (size_t)l * dstride, mode, scr, it, lane);
}

template <bool ROUTER>
__device__ __forceinline__ void norm_phase(const float* x, const float* gain, bf16* xn, const float* wr, float* comb, int gw, int NGW, int lane) {
    f32x4 g[4][2];
#pragma unroll
    for (int j = 0; j < 4; ++j)
#pragma unroll
        for (int e = 0; e < 2; ++e) g[j][e] = *(const f32x4*)(gain + 512 * j + 8 * lane + 4 * e);
    for (int row = gw; row < M; row += NGW) {
        const float* xr = x + (size_t)row * DM + 8 * lane;
        f32x4 v[4][2]; float ss = 0.f;
#pragma unroll
        for (int j = 0; j < 4; ++j)
#pragma unroll
            for (int e = 0; e < 2; ++e) { v[j][e] = *(const f32x4*)(xr + 512 * j + 4 * e); ss += (v[j][e].x * v[j][e].x + v[j][e].y * v[j][e].y) + (v[j][e].z * v[j][e].z + v[j][e].w * v[j][e].w); }
        ss = wave_sum(ss);
        const float rstd = __builtin_amdgcn_rsqf(ss * (1.0f / DM) + EPS);
        bf16* orow = xn + (size_t)row * DM + 8 * lane;
#pragma unroll
        for (int j = 0; j < 4; ++j) {
            v[j][0] = v[j][0] * rstd * g[j][0]; v[j][1] = v[j][1] * rstd * g[j][1];
            v4u o; o.x = pk2(v[j][0].x, v[j][0].y); o.y = pk2(v[j][0].z, v[j][0].w); o.z = pk2(v[j][1].x, v[j][1].y); o.w = pk2(v[j][1].z, v[j][1].w);
            *(v4u*)(orow + 512 * j) = o;
        }
        if constexpr (ROUTER) {
            float lg[8];
#pragma unroll
            for (int e = 0; e < 8; ++e) lg[e] = 0.f;
#pragma unroll
            for (int j = 0; j < 4; ++j)
#pragma unroll
                for (int e = 0; e < 2; ++e)
#pragma unroll
                    for (int t = 0; t < 4; ++t) {
                        const int col = 512 * j + 8 * lane + 4 * e + t; const f32x4* w = (const f32x4*)(wr + (size_t)col * 8); const f32x4 w0 = w[0], w1 = w[1]; const float yv = v[j][e][t];
                        lg[0] += yv * w0.x; lg[1] += yv * w0.y; lg[2] += yv * w0.z; lg[3] += yv * w0.w; lg[4] += yv * w1.x; lg[5] += yv * w1.y; lg[6] += yv * w1.z; lg[7] += yv * w1.w; }
#pragma unroll
            for (int e = 0; e < 8; ++e) lg[e] = wave_sum(lg[e]);
            int i0 = 0; float l0 = lg[0];
#pragma unroll
            for (int e = 1; e < 8; ++e) if (lg[e] > l0) { l0 = lg[e]; i0 = e; }
            int i1 = -1; float l1 = -3.0e38f;
#pragma unroll
            for (int e = 0; e < 8; ++e) if (e != i0 && lg[e] > l1) { l1 = lg[e]; i1 = e; }
            const float e1 = __expf(l1 - l0); const float g0 = 1.0f / (1.0f + e1), g1 = e1 * g0;
            if (lane < 8) comb[(size_t)row * 8 + lane] = (lane == i0) ? g0 : ((lane == i1) ? g1 : 0.0f);
        }
    }
}

__device__ __forceinline__ void qkprep_phase(bf16* H, const float* qn_sb, const float* kn_sb, const float* qn_dil, const float* kn_dil, const float* rope_c, const float* rope_s, int gw, int NGW, int lane) {
    const int d0 = 8 * (lane & 15);
    f32x4 gq[4][2];
    { const float* gp[4] = {qn_sb, kn_sb, qn_dil, kn_dil};
#pragma unroll
      for (int p = 0; p < 4; ++p) { gq[p][0] = *(const f32x4*)(gp[p] + d0); gq[p][1] = *(const f32x4*)(gp[p] + d0 + 4); } }
    const int ri = d0 & 63;
    for (int tok = gw; tok < M; tok += NGW) {
        bf16* hrow = H + (size_t)tok * DIN;
        const f32x4 c0 = *(const f32x4*)(rope_c + (size_t)tok * 64 + ri), c1 = *(const f32x4*)(rope_c + (size_t)tok * 64 + ri + 4);
        const f32x4 s0 = *(const f32x4*)(rope_s + (size_t)tok * 64 + ri), s1 = *(const f32x4*)(rope_s + (size_t)tok * 64 + ri + 4);
#pragma unroll
        for (int p = 0; p < 4; ++p) {
            const int colbase = (p == 0) ? C_QSB : (p == 1) ? C_KSB : (p == 2) ? C_QDIL : C_KDIL;
            v4u* ptr = (v4u*)(hrow + colbase + 8 * lane);
            const v4u raw = *ptr;
            float y[8]; y[0] = bf_lo(raw.x); y[1] = bf_hi(raw.x); y[2] = bf_lo(raw.y); y[3] = bf_hi(raw.y); y[4] = bf_lo(raw.z); y[5] = bf_hi(raw.z); y[6] = bf_lo(raw.w); y[7] = bf_hi(raw.w);
            float ss = 0.f;
#pragma unroll
            for (int e = 0; e < 8; ++e) ss += y[e] * y[e];
            ss += __shfl_xor(ss, 1); ss += __shfl_xor(ss, 2); ss += __shfl_xor(ss, 4); ss += __shfl_xor(ss, 8);
            const float rstd = __builtin_amdgcn_rsqf(ss * (1.0f / HD) + EPS);
#pragma unroll
            for (int e = 0; e < 8; ++e) y[e] = y[e] * rstd * gq[p][e >> 2][e & 3];
            if (p >= 2) {
                const bool lowhalf = (lane & 8) == 0;
#pragma unroll
                for (int e = 0; e < 8; ++e) { const float partner = __shfl_xor(y[e], 8); const float cc = (e < 4) ? c0[e & 3] : c1[e & 3], sn = (e < 4) ? s0[e & 3] : s1[e & 3];
                    y[e] = lowhalf ? (y[e] * cc - partner * sn) : (y[e] * cc + partner * sn); }
            }
            v4u o; o.x = pk2(y[0], y[1]); o.y = pk2(y[2], y[3]); o.z = pk2(y[4], y[5]); o.w = pk2(y[6], y[7]);
            *ptr = o;
        }
    }
}

#define MFMA32(a, b, c) __builtin_amdgcn_mfma_f32_32x32x16_bf16((a), (b), (c), 0, 0, 0)
__device__ __forceinline__ int crow16(int i, int hh) { return (i & 3) + 8 * (i >> 2) + 4 * hh; }
__device__ __forceinline__ int voff(int row, int ch) { return 256 * row + 16 * (ch ^ (((row & 3) << 2) | ((row >> 2) & 3))); }
__device__ __forceinline__ void load_frag8(bf16x8 (&f)[8], const bf16* rowptr, int hh) {
    const v4u* p = (const v4u*)rowptr + 2 * hh;
#pragma unroll
    for (int c = 0; c < 4; ++c) { f[2 * c] = __builtin_bit_cast(bf16x8, p[4 * c]); f[2 * c + 1] = __builtin_bit_cast(bf16x8, p[4 * c + 1]); }
}
__device__ __forceinline__ void stage_v(LAS unsigned char* vimg, const bf16* vbase, size_t rstride, int lane) {
    v4u t[8];
#pragma unroll
    for (int i = 0; i < 8; ++i) { const int row = 4 * i + (lane >> 4); t[i] = *(const v4u*)(vbase + (size_t)row * rstride + 8 * (lane & 15)); }
#pragma unroll
    for (int i = 0; i < 8; ++i) { const int row = 4 * i + (lane >> 4); *(LAS v4u*)(vimg + voff(row, lane & 15)) = t[i]; }
}
__device__ __forceinline__ bf16x8 pack8(const float* p) {
    v4u w; w.x = pk2(p[0], p[1]); w.y = pk2(p[2], p[3]); w.z = pk2(p[4], p[5]); w.w = pk2(p[6], p[7]);
    return __builtin_bit_cast(bf16x8, w);
}
__device__ __forceinline__ void pv_tile(f32x16 (&O)[4], const float (&P)[16], LAS unsigned char* vimg, int lane) {
    const int hh = lane >> 5, i16 = lane & 15, q = i16 >> 2, p = i16 & 3, blk = (lane >> 4) & 1;
    const bf16x8 pf0 = pack8(&P[0]), pf1 = pack8(&P[8]);
    asm volatile("" ::: "memory");
#pragma unroll
    for (int dt = 0; dt < 4; ++dt) {
#pragma unroll
        for (int s = 0; s < 2; ++s) {
            const int ch = 4 * dt + 2 * blk + (p >> 1);
            const int rlo = 16 * s + 4 * hh + q, rhi = rlo + 8;
            const s16x4 lo = __builtin_amdgcn_ds_read_tr16_b64_v4i16((LAS s16x4*)(vimg + voff(rlo, ch) + 8 * (p & 1)));
            const s16x4 hi = __builtin_amdgcn_ds_read_tr16_b64_v4i16((LAS s16x4*)(vimg + voff(rhi, ch) + 8 * (p & 1)));
            const bf16x8 va = __builtin_shufflevector(lo, hi, 0, 1, 2, 3, 4, 5, 6, 7);
            O[dt] = MFMA32(va, s == 0 ? pf0 : pf1, O[dt]);
        }
    }
    asm volatile("" ::: "memory");
}
constexpr float ATT_C = 0.08838834764831845f * 1.4426950408889634f;
constexpr float SB_STOP = 160.0f;

__device__ __forceinline__ void sb_unit(const bf16* H, float* OSB, LAS unsigned char* vimg, int b, int hd, int qt, int lane) {
    const int r = lane & 31, hh = lane >> 5;
    const size_t tokq = (size_t)b * SEQ + 32 * qt + r;
    bf16x8 Q[8]; load_frag8(Q, H + tokq * DIN + C_QSB + hd * HD, hh);
    f32x16 O[4];
#pragma unroll
    for (int dt = 0; dt < 4; ++dt)
#pragma unroll
        for (int i = 0; i < 16; ++i) O[dt][i] = 0.f;
    float later = 0.f;
    for (int kt = qt; kt >= 0; --kt) {
        const size_t tok0 = (size_t)b * SEQ + 32 * kt;
        bf16x8 K[8]; load_frag8(K, H + (tok0 + r) * DIN + C_KSB + hd * HD, hh);
        stage_v(vimg, H + tok0 * DIN + C_VSB + hd * HD, DIN, lane);
        f32x16 S;
#pragma unroll
        for (int i = 0; i < 16; ++i) S[i] = 0.f;
#pragma unroll
        for (int c = 0; c < 8; ++c) S = MFMA32(K[c], Q[c], S);
        const bool diag = (kt == qt);
        float u[16], a[16]; bool valid[16];
#pragma unroll
        for (int i = 0; i < 16; ++i) {
            u[i] = S[i] * ATT_C; valid[i] = !diag || (crow16(i, hh) < r);
            const float e = __builtin_amdgcn_exp2f(-__builtin_fabsf(u[i]));
            const float sp = __builtin_fmaxf(u[i], 0.f) + __builtin_amdgcn_logf(1.0f + e);
            a[i] = valid[i] ? sp : 0.f;
        }
        float T[4], To[4];
#pragma unroll
        for (int G = 0; G < 4; ++G) { a[4 * G + 2] += a[4 * G + 3]; a[4 * G + 1] += a[4 * G + 2]; a[4 * G] += a[4 * G + 1]; T[G] = a[4 * G]; }
#pragma unroll
        for (int G = 0; G < 4; ++G) To[G] = __shfl_xor(T[G], 32);
        const float P3 = T[3] + To[3], P2 = T[2] + To[2], P1 = T[1] + To[1], P0 = T[0] + To[0];
        float Qs[4]; Qs[3] = 0.f; Qs[2] = P3; Qs[1] = P3 + P2; Qs[0] = Qs[1] + P1;
        const float total = Qs[0] + P0;
        float P[16];
#pragma unroll
        for (int i = 0; i < 16; ++i) { const int G = i >> 2; const float off = Qs[G] + (hh == 0 ? To[G] : 0.f);
            const float l2a = u[i] - (a[i] + off) - later; P[i] = valid[i] ? __builtin_amdgcn_exp2f(l2a) : 0.f; }
        pv_tile(O, P, vimg, lane);
        later += total;
        if (__all(later > SB_STOP)) break;
    }
    float* orow = OSB + tokq * DSB + hd * HD;
#pragma unroll
    for (int dt = 0; dt < 4; ++dt)
#pragma unroll
        for (int G = 0; G < 4; ++G) { f32x4 o; o.x = O[dt][4 * G]; o.y = O[dt][4 * G + 1]; o.z = O[dt][4 * G + 2]; o.w = O[dt][4 * G + 3];
            *(f32x4*)(orow + 32 * dt + 8 * G + 4 * hh) = o; }
}

__device__ __forceinline__ void dil_unit(const bf16* H, bf16* ODIL, float* LSE, LAS unsigned char* vimg, int b, int hd, int g, int rc, int mt, int lane) {
    const int r = lane & 31, hh = lane >> 5;
    const int delta = (g == 0) ? 1 : (g == 1 ? 4 : 16);
    const size_t tokq = (size_t)b * SEQ + (size_t)(32 * mt + r) * delta + rc;
    bf16x8 Q[8]; load_frag8(Q, H + tokq * DIN + C_QDIL + hd * HD, hh);
    f32x16 O[4];
#pragma unroll
    for (int dt = 0; dt < 4; ++dt)
#pragma unroll
        for (int i = 0; i < 16; ++i) O[dt][i] = 0.f;
    float mrun = -1.0e30f, lsum = 0.f;
    const int ktlo = (mt - 4 > 0) ? (mt - 4) : 0;
    for (int kt = mt; kt >= ktlo; --kt) {
        const size_t tok0 = (size_t)b * SEQ + (size_t)(32 * kt) * delta + rc;
        bf16x8 K[8]; load_frag8(K, H + (tok0 + (size_t)r * delta) * DIN + C_KDIL + hd * HD, hh);
        stage_v(vimg, H + tok0 * DIN + C_VDIL + hd * HD, (size_t)DIN * delta, lane);
        f32x16 S;
#pragma unroll
        for (int i = 0; i < 16; ++i) S[i] = 0.f;
#pragma unroll
        for (int c = 0; c < 8; ++c) S = MFMA32(K[c], Q[c], S);
        const int dq = 32 * (mt - kt) + r;
        float u[16]; float tmax = -1.0e30f;
#pragma unroll
        for (int i = 0; i < 16; ++i) { const int dist = dq - crow16(i, hh); const bool ok = (dist >= 0) && (dist <= 128);
            u[i] = ok ? S[i] * ATT_C : -1.0e30f; tmax = __builtin_fmaxf(tmax, u[i]); }
        tmax = __builtin_fmaxf(tmax, __shfl_xor(tmax, 32));
        const float mnew = __builtin_fmaxf(mrun, tmax);
        const float alpha = __builtin_amdgcn_exp2f(mrun - mnew);
        float P[16]; float ps = 0.f;
#pragma unroll
        for (int i = 0; i < 16; ++i) { P[i] = __builtin_amdgcn_exp2f(u[i] - mnew); ps += P[i]; }
        lsum = lsum * alpha + ps;
#pragma unroll
        for (int dt = 0; dt < 4; ++dt)
#pragma unroll
            for (int i = 0; i < 16; ++i) O[dt][i] *= alpha;
        pv_tile(O, P, vimg, lane);
        mrun = mnew;
    }
    const float ltot = lsum + __shfl_xor(lsum, 32);
    const float inv = 1.0f / ltot;
    bf16* orow = ODIL + ((size_t)g * M + tokq) * 512 + hd * HD;
#pragma unroll
    for (int dt = 0; dt < 4; ++dt)
#pragma unroll
        for (int G = 0; G < 4; ++G) { v2u o; o.x = pk2(O[dt][4 * G] * inv, O[dt][4 * G + 1] * inv); o.y = pk2(O[dt][4 * G + 2] * inv, O[dt][4 * G + 3] * inv);
            *(v2u*)(orow + 32 * dt + 8 * G + 4 * hh) = o; }
    if (hh == 0) LSE[((size_t)g * M + tokq) * 4 + hd] = (mrun + __builtin_amdgcn_logf(ltot)) * 0.6931471805599453f;
}

__device__ __forceinline__ void attn_phase(const bf16* H, float* OSB, bf16* ODIL, float* LSE, LAS unsigned char* lds, int gw, int NGW, int wave, int lane) {
    LAS unsigned char* vimg = lds + wave * 8192;
    constexpr int NSB = NB * 4 * 256, NDIL = 3 * NSB;
    for (int uidx = gw; uidx < NSB + NDIL; uidx += NGW) {
        if (uidx < NSB) { const int qt = uidx & 255, hd = (uidx >> 8) & 3, b = uidx >> 10; sb_unit(H, OSB, vimg, b, hd, qt, lane); }
        else { const int did = uidx - NSB; const int g = did / NSB, rem = did % NSB; const int b = rem >> 10, hd = (rem >> 8) & 3, sub = rem & 255;
            const int delta = (g == 0) ? 1 : (g == 1 ? 4 : 16); const int rc = sub % delta, mt = sub / delta;
            dil_unit(H, ODIL, LSE, vimg, b, hd, g, rc, mt, lane); }
    }
}

__device__ __forceinline__ void combine_phase(const float* OSB, const bf16* ODIL, const float* LSE, const float* g_sb, const float* g_dil, bf16* ATT, int gw, int NGW, int lane) {
    const f32x4 gs0 = *(const f32x4*)(g_sb + 8 * lane), gs1 = *(const f32x4*)(g_sb + 8 * lane + 4);
    const f32x4 gd0 = *(const f32x4*)(g_dil + 8 * lane), gd1 = *(const f32x4*)(g_dil + 8 * lane + 4);
    const int hd = lane >> 4;
    for (int tok = gw; tok < M; tok += NGW) {
        { const float* p = OSB + (size_t)tok * DSB + 8 * lane; f32x4 v0 = *(const f32x4*)p, v1 = *(const f32x4*)(p + 4);
          float ss = (v0.x * v0.x + v0.y * v0.y) + (v0.z * v0.z + v0.w * v0.w) + (v1.x * v1.x + v1.y * v1.y) + (v1.z * v1.z + v1.w * v1.w);
          ss = wave_sum(ss); const float rstd = __builtin_amdgcn_rsqf(ss * (1.0f / DSB) + EPS);
          v0 = v0 * rstd * gs0; v1 = v1 * rstd * gs1;
          v4u o; o.x = pk2(v0.x, v0.y); o.y = pk2(v0.z, v0.w); o.z = pk2(v1.x, v1.y); o.w = pk2(v1.z, v1.w);
          *(v4u*)(ATT + (size_t)tok * DMIX + 8 * lane) = o; }
        { float l0 = LSE[((size_t)0 * M + tok) * 4 + hd], l1 = LSE[((size_t)1 * M + tok) * 4 + hd], l2 = LSE[((size_t)2 * M + tok) * 4 + hd];
          const float mx = __builtin_fmaxf(l0, __builtin_fmaxf(l1, l2));
          float w0 = __expf(l0 - mx), w1 = __expf(l1 - mx), w2 = __expf(l2 - mx); const float iw = 1.0f / (w0 + w1 + w2); w0 *= iw; w1 *= iw; w2 *= iw;
          const v4u a = *(const v4u*)(ODIL + ((size_t)0 * M + tok) * 512 + 8 * lane), bq = *(const v4u*)(ODIL + ((size_t)1 * M + tok) * 512 + 8 * lane), c = *(const v4u*)(ODIL + ((size_t)2 * M + tok) * 512 + 8 * lane);
          float y[8];
          y[0] = w0 * bf_lo(a.x) + w1 * bf_lo(bq.x) + w2 * bf_lo(c.x); y[1] = w0 * bf_hi(a.x) + w1 * bf_hi(bq.x) + w2 * bf_hi(c.x);
          y[2] = w0 * bf_lo(a.y) + w1 * bf_lo(bq.y) + w2 * bf_lo(c.y); y[3] = w0 * bf_hi(a.y) + w1 * bf_hi(bq.y) + w2 * bf_hi(c.y);
          y[4] = w0 * bf_lo(a.z) + w1 * bf_lo(bq.z) + w2 * bf_lo(c.z); y[5] = w0 * bf_hi(a.z) + w1 * bf_hi(bq.z) + w2 * bf_hi(c.z);
          y[6] = w0 * bf_lo(a.w) + w1 * bf_lo(bq.w) + w2 * bf_lo(c.w); y[7] = w0 * bf_hi(a.w) + w1 * bf_hi(bq.w) + w2 * bf_hi(c.w);
          float ss = 0.f;
#pragma unroll
          for (int e = 0; e < 8; ++e) ss += y[e] * y[e];
          ss = wave_sum(ss); const float rstd = __builtin_amdgcn_rsqf(ss * (1.0f / 512.0f) + EPS);
#pragma unroll
          for (int e = 0; e < 8; ++e) y[e] = y[e] * rstd * ((e < 4) ? gd0[e & 3] : gd1[e & 3]);
          v4u o; o.x = pk2(y[0], y[1]); o.y = pk2(y[2], y[3]); o.z = pk2(y[4], y[5]); o.w = pk2(y[6], y[7]);
          *(v4u*)(ATT + (size_t)tok * DMIX + 512 + 8 * lane) = o; }
    }
}

struct Args { const void* in[19]; float* out; unsigned char* ws; int ph_lo, ph_hi, li, pad; };
__global__ void __launch_bounds__(NWAVES * 64, 2) mega_fwd(Args args) {
    extern __shared__ __attribute__((aligned(16))) unsigned char lds_raw[];
    LAS unsigned char* lds = (LAS unsigned char*)lds_raw;
    const int G = gridDim.x;
    const int NGW = G * NWAVES;
    unsigned char* ws = args.ws;
    unsigned* ctl = (unsigned*)(ws + WS_CTL);
    for (int u = threadIdx.x; u < (LDS_BYTES - LDSCTL_OFF) / 4; u += NWAVES * 64) ((LAS unsigned*)(lds + LDSCTL_OFF))[u] = 0u;
    __syncthreads();
    volatile LAS unsigned* MISC = (volatile LAS unsigned*)(lds + MISC_OFF);
    const int lo = args.ph_lo, hi = args.ph_hi;
    XcdBarrier bar; bar.bar = ctl + CW_BAR + args.li * XCD_BAR_WORDS; bar.x = 0; bar.st = nullptr;
    if (hi - lo > 1) bar = xcd_barrier_post(ctl + CW_BAR + args.li * XCD_BAR_WORDS, MISC + 8);
    int ph = 0;
#define PH_BEGIN if (ph >= lo && ph < hi) { int tid = threadIdx.x; asm volatile("" : "+v"(tid)); const int lane = tid & 63, wave = __builtin_amdgcn_readfirstlane(tid >> 6); const int gw = blockIdx.x * NWAVES + wave; (void)lane; (void)gw;
#define PH_END   if (ph + 1 < hi) xcd_barrier(bar); } ++ph;

    const float* x_in = (const float*)args.in[0];
    const int* positions = (const int*)args.in[1];
    float* xres = args.out;
    bf16* Wt_in = (bf16*)(ws + WS_WIN); bf16* Wt_out = (bf16*)(ws + WS_WOUT); bf16* Wt_gud = (bf16*)(ws + WS_WGU_D); bf16* Wt_dnd = (bf16*)(ws + WS_WDN_D);
    bf16* Wt_gum = (bf16*)(ws + WS_WGU_M); bf16* Wt_dnm = (bf16*)(ws + WS_WDN_M);
    float* rope_c = (float*)(ws + WS_ROPE); float* rope_s = rope_c + (size_t)M * 64;
    bf16* XN = (bf16*)(ws + WS_XN); bf16* ATT = (bf16*)(ws + WS_ATT); float* COMB = (float*)(ws + WS_COMB); float* LSE = (float*)(ws + WS_LSE);
    bf16* Hb = (bf16*)(ws + WS_H); float* OSB = (float*)(ws + WS_OSB); bf16* ODIL = (bf16*)(ws + WS_ODIL); bf16* HMID = (bf16*)(ws + WS_HMID);

    PH_BEGIN
    {
        LAS float* scr = (LAS float*)(lds + RING_OFF + wave * 16384);
        constexpr int I_IN = 4 * (DM / 64) * (DIN / 32), I_OUT = 4 * (DMIX / 64) * (DM / 32), I_GD = 2 * (DM / 64) * (DFF / 32), I_DD = 2 * (DFF / 64) * (DM / 32);
        constexpr int I_GM = 16 * (DM / 64) * (DFE / 32), I_DM = 16 * (DFE / 64) * (DM / 32);
        constexpr int NITEMS = I_IN + I_OUT + 2 * I_GD + I_DD + 2 * I_GM + I_DM;
        for (int it = gw; it < NITEMS; it += NGW) {
            int r = it;
            if (r < I_IN) { transpose_group((const float*)args.in[3], Wt_in, DM, DIN, 0, (size_t)DIN * DM, r, scr, lane); continue; } r -= I_IN;
            if (r < I_OUT) { transpose_group((const float*)args.in[10], Wt_out, DMIX, DM, 0, (size_t)DM * DMIX, r, scr, lane); continue; } r -= I_OUT;
            if (r < I_GD) { transpose_group((const float*)args.in[12], Wt_gud, DM, DFF, 1, (size_t)2 * DFF * DM, r, scr, lane); continue; } r -= I_GD;
            if (r < I_GD) { transpose_group((const float*)args.in[13], Wt_gud, DM, DFF, 2, (size_t)2 * DFF * DM, r, scr, lane); continue; } r -= I_GD;
            if (r < I_DD) { transpose_group((const float*)args.in[14], Wt_dnd, DFF, DM, 0, (size_t)DM * DFF, r, scr, lane); continue; } r -= I_DD;
            if (r < I_GM) { transpose_group((const float*)args.in[16], Wt_gum, DM, DFE, 1, (size_t)2 * DFE * DM, r, scr, lane); continue; } r -= I_GM;
            if (r < I_GM) { transpose_group((const float*)args.in[17], Wt_gum, DM, DFE, 2, (size_t)2 * DFE * DM, r, scr, lane); continue; } r -= I_GM;
            transpose_group((const float*)args.in[18], Wt_dnm, DFE, DM, 0, (size_t)DM * DFE, r, scr, lane);
        }
        for (int idx = blockIdx.x * (NWAVES * 64) + tid; idx < M * 64; idx += G * NWAVES * 64) {
            const int tok = idx >> 6, i = idx & 63; const float ang = (float)positions[tok] * ROPE_INV[i];
            float sn, cs; sincos_d((double)ang, sn, cs); rope_c[idx] = cs; rope_s[idx] = sn; }
    }
    PH_END

    for (int layer = 0; layer < DEPTH; ++layer) {
        const int j2 = layer >> 1; const bool dense = (layer & 1) == 0;
        const float* xsrc = (layer == 0) ? x_in : xres;
        PH_BEGIN
        norm_phase<false>(xsrc, (const float*)args.in[2] + (size_t)layer * DM, XN, nullptr, nullptr, gw, NGW, lane);
        PH_END
        PH_BEGIN
        { pg8::Gemm g{XN, Wt_in + (size_t)layer * DIN * DM, M, DIN, DM}; pg8::StaticOrder S; S.init(M, DIN, G, (int)blockIdx.x);
          pg8::EpiBf16 E{Hb, DIN};
          pg8::gemm_phase<pg8::EpiBf16, pg8::StaticOrder, PG8_ALIGN, PG8_SP2>(lds + RING_OFF, g, S, E); }
        PH_END
        PH_BEGIN
        qkprep_phase(Hb, (const float*)args.in[4] + layer * HD, (const float*)args.in[5] + layer * HD, (const float*)args.in[6] + layer * HD, (const float*)args.in[7] + layer * HD, rope_c, rope_s, gw, NGW, lane);
        PH_END
        PH_BEGIN
        attn_phase(Hb, OSB, ODIL, LSE, lds + RING_OFF, gw, NGW, wave, lane);
        PH_END
        PH_BEGIN
        combine_phase(OSB, ODIL, LSE, (const float*)args.in[8] + layer * DSB, (const float*)args.in[9] + layer * 512, ATT, gw, NGW, lane);
        PH_END
        PH_BEGIN
        { pg8::Gemm g{ATT, Wt_out + (size_t)layer * DM * DMIX, M, DM, DMIX}; pg8::StaticOrder S; S.init(M, DM, G, (int)blockIdx.x);
          pg8::EpiResAdd E{xsrc, xres, DM, nullptr, 0};
          pg8::gemm_phase<pg8::EpiResAdd, pg8::StaticOrder, PG8_ALIGN, PG8_SP2>(lds + RING_OFF, g, S, E); }
        PH_END
        PH_BEGIN
        if (dense) norm_phase<false>(xres, (const float*)args.in[11] + (size_t)layer * DM, XN, nullptr, nullptr, gw, NGW, lane);
        else norm_phase<true>(xres, (const float*)args.in[11] + (size_t)layer * DM, XN, (const float*)args.in[15] + (size_t)j2 * DM * NE, COMB, gw, NGW, lane);
        PH_END
        if (dense) {
            PH_BEGIN
            { pg8::Gemm g{XN, Wt_gud + (size_t)j2 * 2 * DFF * DM, M, 2 * DFF, DM}; pg8::StaticOrder S; S.init(M, 2 * DFF, G, (int)blockIdx.x);
              pg8::EpiSwiGLU E{HMID, DFF};
              pg8::gemm_phase<pg8::EpiSwiGLU, pg8::StaticOrder, PG8_ALIGN, PG8_SP2>(lds + RING_OFF, g, S, E); }
            PH_END
            PH_BEGIN
            { pg8::Gemm g{HMID, Wt_dnd + (size_t)j2 * DM * DFF, M, DM, DFF}; pg8::StaticOrder S; S.init(M, DM, G, (int)blockIdx.x);
              pg8::EpiResAdd E{xres, xres, DM, nullptr, 0};
              pg8::gemm_phase<pg8::EpiResAdd, pg8::StaticOrder, PG8_ALIGN, PG8_SP2>(lds + RING_OFF, g, S, E); }
            PH_END
        } else {
            for (int e = 0; e < NE; ++e) {
                PH_BEGIN
                { pg8::Gemm g{XN, Wt_gum + (size_t)(j2 * NE + e) * 2 * DFE * DM, M, 2 * DFE, DM}; pg8::StaticOrder S; S.init(M, 2 * DFE, G, (int)blockIdx.x);
                  pg8::EpiSwiGLU E{HMID, DFE};
                  pg8::gemm_phase<pg8::EpiSwiGLU, pg8::StaticOrder, PG8_ALIGN, PG8_SP2>(lds + RING_OFF, g, S, E); }
                PH_END
                PH_BEGIN
                { pg8::Gemm g{HMID, Wt_dnm + (size_t)(j2 * NE + e) * DM * DFE, M, DM, DFE}; pg8::StaticOrder S; S.init(M, DM, G, (int)blockIdx.x);
                  pg8::EpiResAdd E{xres, xres, DM, COMB + e, NE};
                  pg8::gemm_phase<pg8::EpiResAdd, pg8::StaticOrder, PG8_ALIGN, PG8_SP2>(lds + RING_OFF, g, S, E); }
                PH_END
            }
        }
    }
#undef PH_BEGIN
#undef PH_END
}

constexpr int N_PHASES = 1 + 2 * (7 + 2) + 2 * (7 + 16);
#ifndef MK_PHASES_PER_LAUNCH
#define MK_PHASES_PER_LAUNCH N_PHASES
#endif
extern "C" void kernel_launch(void* const* d_in, const int* in_sizes, int n_in, void* d_out, int out_size, void* d_ws, size_t ws_size, hipStream_t stream) {
    static int grid = 0;
    if (grid == 0) {
        if (n_in != 19 || in_sizes[0] != M * DM || out_size != M * DM || ws_size < WS_END) { fprintf(stderr, "kernel_launch: unexpected problem (n_in %d, in0 %d, out %d, ws %zu)\n", n_in, n_in > 0 ? in_sizes[0] : -1, out_size, ws_size); grid = -1; return; }
        int dev = 0, cus = 0, per_cu = 0;
        if (hipGetDevice(&dev) != hipSuccess || hipDeviceGetAttribute(&cus, hipDeviceAttributeMultiprocessorCount, dev) != hipSuccess) { grid = -1; return; }
        if (hipFuncSetAttribute((const void*)mega_fwd, hipFuncAttributeMaxDynamicSharedMemorySize, LDS_BYTES) != hipSuccess) { fprintf(stderr, "kernel_launch: hipFuncSetAttribute failed\n"); grid = -1; return; }
        if (hipOccupancyMaxActiveBlocksPerMultiprocessor(&per_cu, (const void*)mega_fwd, NWAVES * 64, LDS_BYTES) != hipSuccess || per_cu < 1) { fprintf(stderr, "kernel_launch: occupancy query says %d\n", per_cu); }
        (void)hipGetLastError();
        grid = cus;
    }
    if (grid < 0) return;
    if (hipMemsetAsync((char*)d_ws + WS_CTL, 0, CTL_ZERO_BYTES, stream) != hipSuccess) return;
    Args a{};
    for (int i = 0; i < 19; ++i) a.in[i] = d_in[i];
    a.out = (float*)d_out; a.ws = (unsigned char*)d_ws;
    int li = 0;
    for (int p = 0; p < N_PHASES; p += MK_PHASES_PER_LAUNCH, ++li) {
        a.li = li; a.ph_lo = p; a.ph_hi = (p + MK_PHASES_PER_LAUNCH < N_PHASES) ? p + MK_PHASES_PER_LAUNCH : N_PHASES;
        hipLaunchKernelGGL(mega_fwd, dim3(grid), dim3(NWAVES * 64), LDS_BYTES, stream, a);
        if (hipPeekAtLastError() != hipSuccess) { fprintf(stderr, "kernel_launch: launch failed at phase %d\n", p); break; }
    }
}
```

```cpp
#include <hip/hip_runtime.h>
#include <cstdio>
#include <cstdint>
namespace pg8 {
#define PG8_LAS __attribute__((address_space(3)))
typedef unsigned short bf16_t;
typedef short bf16x8 __attribute__((ext_vector_type(8)));
typedef float f32x4 __attribute__((ext_vector_type(4)));
typedef unsigned u32x4 __attribute__((ext_vector_type(4)));
constexpr int BM = 256, BK = 64, HALF = 128, HTB = HALF * BK * 2  , STAGE_BYTES = 8 * HTB, NXCD = 8, WGM = 8;

__host__ __device__ __forceinline__ int lds_byte(int r, int c) { const int st = (r >> 4) * 2 + (c >> 5), rr = r & 15, cc = c & 31, ob = rr * 64 + cc * 2; return st * 1024 + (ob ^ (((ob >> 9) & 1) << 5)); }
__host__ __device__ __forceinline__ void stage_rc(int b, int& R, int& C) { const int st = b / 1024, sb = b % 1024, swz = sb ^ (((sb >> 9) & 1) << 5); R = (st >> 1) * 16 + swz / 64; C = (st & 1) * 32 + (swz % 64) / 2; }
__host__ __device__ __forceinline__ int perm32(int rho) { const int n = rho >> 4, i = rho & 15; return 8 * (i >> 2) + 4 * n + (i & 3); }

struct Unit { int pm, pn; };
struct Gemm { const bf16_t* A; const bf16_t* Bt; int M, N, K; };

struct StaticOrder {
    int nM, nN, nwg, G, c;
    __host__ __device__ void init(int M, int N, int G_, int c_) { nM = M / BM; nN = N / BM; nwg = nM * nN; G = G_; c = c_; }
    __host__ __device__ bool next(int i, Unit& u) const {
        const long L = (long)i * G + c; if (L >= nwg) return false;
        int wgid = (int)L; { const int q = nwg / NXCD, r = nwg % NXCD, xcd = wgid % NXCD, off = wgid / NXCD; wgid = (xcd < r ? xcd * (q + 1) : r * (q + 1) + (xcd - r) * q) + off; }
        const int nig = WGM * nN, gid = wgid / nig, fm = gid * WGM, gsz = (nM - fm) < WGM ? (nM - fm) : WGM;
        u.pm = fm + ((wgid % nig) % gsz); u.pn = (wgid % nig) / gsz; return true;
    }
    __device__ __forceinline__ void a_ready(const Unit&) const {}
    __device__ __forceinline__ void done(const Unit&) const {}
    __device__ __forceinline__ const bf16_t* bt(const Gemm& g, const Unit&) const { return g.Bt; }
};
struct MoeOrder : StaticOrder {
    int pm_off; const bf16_t* wbase; size_t wstride; const PG8_LAS int* tbi;
    __device__ void init_tiles(int nM_, int nN_, int G_, int c_) { nM = nM_; nN = nN_; nwg = nM * nN; G = G_; c = c_; }
    __device__ bool next(int i, Unit& u) const { if (!StaticOrder::next(i, u)) return false; u.pm += pm_off; return true; }
    __device__ __forceinline__ const bf16_t* bt(const Gemm&, const Unit& u) const { int grp = 0;
#pragma unroll
        for (int j = 0; j < 16; ++j) grp += (tbi[j] <= u.pm) ? 1 : 0;
        return wbase + (size_t)(grp & 7) * wstride; }
};


__device__ __forceinline__ unsigned cvt_pk_bf16(float lo, float hi) { unsigned r; asm volatile("v_cvt_pk_bf16_f32 %0, %1, %2" : "=v"(r) : "v"(lo), "v"(hi)); return r; }

struct EpiBf16 {
    static constexpr bool PERM = true, AFTER_DRAIN = false;
    bf16_t* O; int ldc;
    __device__ __forceinline__ void operator()(const f32x4 (&acc)[2][2][4][2], const Unit& u, int wr, int wc, int fr, int fq) const {
        const int row0 = u.pm * BM + wr * 64 + fr; const int col0 = u.pn * BM + wc * 32 + 8 * fq;
#pragma unroll
        for (int ai = 0; ai < 2; ++ai)
#pragma unroll
            for (int m = 0; m < 4; ++m) { bf16_t* rowp = O + (size_t)(row0 + ai * HALF + m * 16) * ldc + col0;
#pragma unroll
                for (int bj = 0; bj < 2; ++bj) { const f32x4 v0 = acc[ai][bj][m][0], v1 = acc[ai][bj][m][1];
                    u32x4 w; w.x = cvt_pk_bf16(v0[0], v0[1]); w.y = cvt_pk_bf16(v0[2], v0[3]); w.z = cvt_pk_bf16(v1[0], v1[1]); w.w = cvt_pk_bf16(v1[2], v1[3]);
                    *(u32x4*)(rowp + bj * HALF) = w; } }
    }
};
__device__ __forceinline__ float silu_mul(float g, float u) { const float e = __builtin_amdgcn_exp2f(-1.4426950408889634f * g); return g * __builtin_amdgcn_rcpf(1.0f + e) * u; }
struct EpiSwiGLU {
    static constexpr bool PERM = true, AFTER_DRAIN = false;
    bf16_t* O; int ldc;
    __device__ __forceinline__ void operator()(const f32x4 (&acc)[2][2][4][2], const Unit& u, int wr, int wc, int fr, int fq) const {
        const int row0 = u.pm * BM + wr * 64 + fr; const int col0 = u.pn * HALF + wc * 32 + 8 * fq;
#pragma unroll
        for (int ai = 0; ai < 2; ++ai)
#pragma unroll
            for (int m = 0; m < 4; ++m) { bf16_t* rowp = O + (size_t)(row0 + ai * HALF + m * 16) * ldc + col0;
                const f32x4 g0 = acc[ai][0][m][0], g1 = acc[ai][0][m][1], u0 = acc[ai][1][m][0], u1 = acc[ai][1][m][1];
                u32x4 w; w.x = cvt_pk_bf16(silu_mul(g0[0], u0[0]), silu_mul(g0[1], u0[1])); w.y = cvt_pk_bf16(silu_mul(g0[2], u0[2]), silu_mul(g0[3], u0[3]));
                w.z = cvt_pk_bf16(silu_mul(g1[0], u1[0]), silu_mul(g1[1], u1[1])); w.w = cvt_pk_bf16(silu_mul(g1[2], u1[2]), silu_mul(g1[3], u1[3]));
                *(u32x4*)rowp = w; }
    }
};
struct EpiResAdd {
    static constexpr bool PERM = false, AFTER_DRAIN = false;
    const float* in; float* out; int ldc; const float* rowscale; int rs_stride;
    __device__ __forceinline__ void operator()(const f32x4 (&acc)[2][2][4][2], const Unit& u, int wr, int wc, int fr, int fq) const {
        const int col0 = u.pn * BM + wc * 32 + 4 * fq;
#pragma unroll
        for (int ai = 0; ai < 2; ++ai)
#pragma unroll
            for (int m = 0; m < 4; ++m) { const int r = u.pm * BM + ai * HALF + wr * 64 + m * 16 + fr; const size_t off = (size_t)r * ldc + col0;
                const float sc = rowscale ? rowscale[(size_t)r * rs_stride] : 1.0f;
#pragma unroll
                for (int bj = 0; bj < 2; ++bj)
#pragma unroll
                    for (int n = 0; n < 2; ++n) { const f32x4 bs = *(const f32x4*)(in + off + bj * HALF + n * 16); *(f32x4*)(out + off + bj * HALF + n * 16) = bs + acc[ai][bj][m][n] * sc; }
                if (m & 1) asm volatile("" ::: "memory"); }
    }
};

struct EpiMoeDown {
    static constexpr bool PERM = false, AFTER_DRAIN = false;
    float* x; const int* rowtok; const float* rowgate; int ldc;
    __device__ __forceinline__ void operator()(const f32x4 (&acc)[2][2][4][2], const Unit& u, int wr, int wc, int fr, int fq) const {
        const int col0 = u.pn * BM + wc * 32 + 4 * fq;
#pragma unroll
        for (int ai = 0; ai < 2; ++ai)
#pragma unroll
            for (int m = 0; m < 4; ++m) { const int r = u.pm * BM + ai * HALF + wr * 64 + m * 16 + fr; const int tok = rowtok[r]; const float gt = rowgate[r];
                if (tok >= 0) { float* p = x + (size_t)tok * ldc + col0;
#pragma unroll
                    for (int bj = 0; bj < 2; ++bj)
#pragma unroll
                        for (int n = 0; n < 2; ++n) { const f32x4 bs = *(const f32x4*)(p + bj * HALF + n * 16); *(f32x4*)(p + bj * HALF + n * 16) = bs + acc[ai][bj][m][n] * gt; } }
                if (m & 1) asm volatile("" ::: "memory"); }
    }
};

template <class Epi, class Sched, bool ALIGN_EPI = false, bool SP2 = false>
__device__ __forceinline__ void gemm_phase(PG8_LAS unsigned char* lds, const Gemm g, const Sched& S, const Epi& E) {
    int tid_ = threadIdx.x; asm volatile("" : "+v"(tid_));
    const int tid = tid_, wid = __builtin_amdgcn_readfirstlane(tid >> 6), lane = tid & 63, wr = wid >> 2, wc = wid & 3, fr = lane & 15, fq = lane >> 4;
    const int K = g.K, nt = K / BK;
    unsigned voffA[2], voffB[2];
#pragma unroll
    for (int i = 0; i < 2; ++i) { int R, C; stage_rc(tid * 16 + i * 8192, R, C); const int Rb = Epi::PERM ? ((R & ~31) + perm32(R & 31)) : R;
        voffA[i] = (unsigned)(R * K + C) * 2u; voffB[i] = (unsigned)(Rb * K + C) * 2u; }
    const size_t kstep = (size_t)(BK * 2);
    const size_t hstep = (size_t)HALF * K * 2;
    const size_t tstep = 2 * hstep;
    const unsigned ldsw = (unsigned)wid * 1024u;
    const int aoff = lds_byte(wr * 64 + fr, fq * 8), boff = lds_byte(wc * 32 + fr, fq * 8);
#define PG8_SA(b, h) (((b) * 2 + (h)) * HTB)
#define PG8_SB(b, h) ((4 + (b) * 2 + (h)) * HTB)
#define PG8_STAGE(bufoff, gbase, voff) do { _Pragma("unroll") for (int _i = 0; _i < 2; ++_i) \
        __builtin_amdgcn_global_load_lds((const unsigned*)((const char*)(gbase) + (voff)[_i]), (PG8_LAS unsigned*)(lds + (bufoff) + ldsw + _i * 8192), 16, 0, 0); } while (0)
#define PG8_LDA(dst, b, h) do { _Pragma("unroll") for (int m = 0; m < 4; ++m) _Pragma("unroll") for (int k = 0; k < 2; ++k) dst[m][k] = *(const PG8_LAS bf16x8*)(lds + PG8_SA(b, h) + aoff + m * 2048 + k * 1024); } while (0)
#define PG8_LDB(dst, b, h) do { _Pragma("unroll") for (int n = 0; n < 2; ++n) _Pragma("unroll") for (int k = 0; k < 2; ++k) dst[n][k] = *(const PG8_LAS bf16x8*)(lds + PG8_SB(b, h) + boff + n * 2048 + k * 1024); } while (0)
#define PG8_MMA(ai, bj, At, Bt) do { __builtin_amdgcn_s_setprio(1); _Pragma("unroll") for (int m = 0; m < 4; ++m) _Pragma("unroll") for (int n = 0; n < 2; ++n) _Pragma("unroll") for (int k = 0; k < 2; ++k) \
        acc[ai][bj][m][n] = __builtin_amdgcn_mfma_f32_16x16x32_bf16(Bt[n][k], At[m][k], acc[ai][bj][m][n], 0, 0, 0); __builtin_amdgcn_s_setprio(0); } while (0)
#define PG8_WAIT_V(n) asm volatile("s_waitcnt vmcnt(" #n ")" ::: "memory")
#define PG8_WAIT_L(n) asm volatile("s_waitcnt lgkmcnt(" #n ")" ::: "memory")
#define PG8_BAR __builtin_amdgcn_s_barrier()
#define PG8_SCHED __builtin_amdgcn_sched_barrier(0)
    Unit cur, nxt; int ui = 0;
    if (!S.next(0, cur)) return;
    f32x4 acc[2][2][4][2];
#pragma unroll
    for (int a = 0; a < 2; ++a)
#pragma unroll
        for (int b = 0; b < 2; ++b)
#pragma unroll
            for (int m = 0; m < 4; ++m)
#pragma unroll
                for (int n = 0; n < 2; ++n) acc[a][b][m][n] = (f32x4){0.f, 0.f, 0.f, 0.f};
    bf16x8 At[4][2], B0[2][2], B1[2][2];
    const char* cA = (const char*)g.A + (size_t)cur.pm * tstep; const char* cB = (const char*)S.bt(g, cur) + (size_t)cur.pn * tstep;
    S.a_ready(cur);
    if constexpr (SP2) {
        PG8_STAGE(PG8_SB(0, 0), cB, voffB); PG8_STAGE(PG8_SB(0, 1), cB + hstep, voffB); PG8_STAGE(PG8_SA(0, 0), cA, voffA); PG8_STAGE(PG8_SA(0, 1), cA + hstep, voffA);
        if (wr == 1) PG8_BAR;
        PG8_WAIT_V(2); PG8_BAR;
        PG8_STAGE(PG8_SB(1, 0), cB + kstep, voffB); PG8_STAGE(PG8_SA(1, 0), cA + kstep, voffA); PG8_STAGE(PG8_SB(1, 1), cB + hstep + kstep, voffB);
        PG8_WAIT_V(6); PG8_BAR;
    } else {
        PG8_STAGE(PG8_SB(0, 0), cB, voffB); PG8_STAGE(PG8_SA(0, 0), cA, voffA); PG8_STAGE(PG8_SB(0, 1), cB + hstep, voffB); PG8_STAGE(PG8_SA(0, 1), cA + hstep, voffA);
        if (wr == 1) PG8_BAR;
        PG8_WAIT_V(4); PG8_BAR;
        PG8_STAGE(PG8_SB(1, 0), cB + kstep, voffB); PG8_STAGE(PG8_SA(1, 0), cA + kstep, voffA); PG8_STAGE(PG8_SB(1, 1), cB + hstep + kstep, voffB);
        PG8_WAIT_V(6); PG8_BAR;
    }
    for (;;) {
        const bool has_next = S.next(ui + 1, nxt);
        const char* nA = has_next ? (const char*)g.A + (size_t)nxt.pm * tstep : cA; const char* nB = has_next ? (const char*)S.bt(g, nxt) + (size_t)nxt.pn * tstep : cB;
        for (int t = 0; t < nt; t += 2) {
            const bool last = (t == nt - 2);
            const char* a1 = cA + (size_t)(t + 1) * kstep;
            const char* a2 = last ? nA : cA + (size_t)(t + 2) * kstep; const char* b2 = last ? nB : cB + (size_t)(t + 2) * kstep;
            const char* a3 = a2 + kstep; const char* b3 = b2 + kstep;
            if (last && has_next) S.a_ready(nxt);
            if constexpr (SP2) {
            PG8_LDB(B0, 0, 0); PG8_LDB(B1, 0, 1); PG8_SCHED; PG8_LDA(At, 0, 0); PG8_STAGE(PG8_SA(1, 1), a1 + hstep, voffA);
            PG8_WAIT_V(8); PG8_WAIT_L(0); PG8_BAR; PG8_MMA(0, 0, At, B0); PG8_MMA(0, 1, At, B1); PG8_BAR; PG8_SCHED;
            PG8_LDA(At, 0, 1); PG8_STAGE(PG8_SB(0, 0), b2, voffB); PG8_STAGE(PG8_SB(0, 1), b2 + hstep, voffB); PG8_STAGE(PG8_SA(0, 0), a2, voffA);
            PG8_WAIT_V(8); PG8_WAIT_L(0); PG8_BAR; PG8_MMA(1, 0, At, B0); PG8_MMA(1, 1, At, B1); PG8_BAR; PG8_SCHED;
            PG8_LDB(B0, 1, 0); PG8_LDB(B1, 1, 1); PG8_SCHED; PG8_LDA(At, 1, 0); PG8_STAGE(PG8_SA(0, 1), a2 + hstep, voffA);
            PG8_WAIT_V(8); PG8_WAIT_L(0); PG8_BAR; PG8_MMA(0, 0, At, B0); PG8_MMA(0, 1, At, B1); PG8_BAR; PG8_SCHED;
            PG8_LDA(At, 1, 1); PG8_STAGE(PG8_SB(1, 0), b3, voffB); PG8_STAGE(PG8_SB(1, 1), b3 + hstep, voffB); PG8_STAGE(PG8_SA(1, 0), a3, voffA);
            PG8_WAIT_V(8); PG8_WAIT_L(0); PG8_BAR; PG8_MMA(1, 0, At, B0); PG8_MMA(1, 1, At, B1); PG8_BAR; PG8_SCHED;
            } else {
            PG8_LDB(B0, 0, 0); PG8_SCHED; PG8_LDA(At, 0, 0); PG8_STAGE(PG8_SA(1, 1), a1 + hstep, voffA);
            PG8_WAIT_L(8); PG8_BAR; PG8_WAIT_L(0); PG8_MMA(0, 0, At, B0); PG8_BAR; PG8_SCHED;
            PG8_LDB(B1, 0, 1); PG8_STAGE(PG8_SB(0, 0), b2, voffB);
            PG8_BAR; PG8_WAIT_L(0); PG8_MMA(0, 1, At, B1); PG8_BAR;
            PG8_LDA(At, 0, 1); PG8_STAGE(PG8_SA(0, 0), a2, voffA);
            PG8_BAR; PG8_WAIT_L(0); PG8_MMA(1, 0, At, B0); PG8_BAR; PG8_SCHED;
            PG8_STAGE(PG8_SB(0, 1), b2 + hstep, voffB);
            PG8_WAIT_V(6); PG8_BAR; PG8_MMA(1, 1, At, B1); PG8_BAR;
            PG8_LDB(B0, 1, 0); PG8_SCHED; PG8_LDA(At, 1, 0); PG8_STAGE(PG8_SA(0, 1), a2 + hstep, voffA);
            PG8_WAIT_L(8); PG8_BAR; PG8_WAIT_L(0); PG8_MMA(0, 0, At, B0); PG8_BAR; PG8_SCHED;
            PG8_LDB(B1, 1, 1); PG8_STAGE(PG8_SB(1, 0), b3, voffB);
            PG8_BAR; PG8_WAIT_L(0); PG8_MMA(0, 1, At, B1); PG8_BAR;
            PG8_LDA(At, 1, 1); PG8_STAGE(PG8_SA(1, 0), a3, voffA);
            PG8_BAR; PG8_WAIT_L(0); PG8_MMA(1, 0, At, B0); PG8_BAR; PG8_SCHED;
            PG8_STAGE(PG8_SB(1, 1), b3 + hstep, voffB);
            PG8_WAIT_V(6); PG8_BAR; PG8_MMA(1, 1, At, B1); PG8_BAR;
            }
        }
        if constexpr (ALIGN_EPI) { if (wr == 0) PG8_BAR; }
        if constexpr (!Epi::AFTER_DRAIN) { E(acc, cur, wr, wc, fr, fq); S.done(cur); }
        if (!has_next) break;
#pragma unroll
        for (int a = 0; a < 2; ++a)
#pragma unroll
            for (int b = 0; b < 2; ++b)
#pragma unroll
                for (int m = 0; m < 4; ++m)
#pragma unroll
                    for (int n = 0; n < 2; ++n) acc[a][b][m][n] = (f32x4){0.f, 0.f, 0.f, 0.f};
        cur = nxt; cA = nA; cB = nB; ++ui;
        if constexpr (ALIGN_EPI) { if (wr == 1) PG8_BAR; }
    }
    PG8_WAIT_V(0);
    if constexpr (!ALIGN_EPI) { if (wr == 0) PG8_BAR; }
    PG8_BAR;
    if constexpr (Epi::AFTER_DRAIN) { E.fused(acc, cur, wr, wc, fr, fq, lds, wid, lane); S.done(cur); }
#undef PG8_SA
#undef PG8_SB
#undef PG8_STAGE
#undef PG8_LDA
#undef PG8_LDB
#undef PG8_MMA
#undef PG8_WAIT_V
#undef PG8_WAIT_L
#undef PG8_BAR
#undef PG8_SCHED
}
}

#ifndef PG8_SP2
#define PG8_SP2 true
#endif
#ifndef PG8_ALIGN
#define PG8_ALIGN true
#endif

constexpr int NB = 4, SEQ = 8192, DM = 2048, DEPTH = 4, HD = 128, DSB = 512, DMIX = 1024, DIN = 3072, DFF = 5632, DFE = 1408, NE = 8;
constexpr int M = NB * SEQ;
constexpr float EPS = 1e-6f;
constexpr int NWAVES = 8;
constexpr int C_QSB = 0, C_KSB = 512, C_VSB = 1024, C_QDIL = 1536, C_KDIL = 2048, C_VDIL = 2560;

constexpr size_t MiB = 1u << 20;
constexpr size_t WS_CTL = 0, CTL_ZERO_BYTES = 1 * MiB;
constexpr size_t WS_WIN = 1 * MiB;
constexpr size_t WS_WOUT = 49 * MiB;
constexpr size_t WS_WGU_D = 65 * MiB;
constexpr size_t WS_WDN_D = 153 * MiB;
constexpr size_t WS_WGU_M = 197 * MiB;
constexpr size_t WS_WDN_M = 373 * MiB;
constexpr size_t WS_ROPE = 461 * MiB;
constexpr size_t WS_XN = 477 * MiB;
constexpr size_t WS_ATT = 605 * MiB;
constexpr size_t WS_MAP = 669 * MiB;
constexpr size_t WS_LSE = 670 * MiB;
constexpr size_t WS_ROWTOK = 672 * MiB;
constexpr size_t WS_BIG = 673 * MiB;
constexpr size_t WS_H = WS_BIG, WS_OSB = WS_BIG + 192 * MiB, WS_ODIL = WS_BIG + 256 * MiB, WS_HMID = WS_BIG;
constexpr size_t WS_XG = WS_BIG;
constexpr size_t WS_HMID_M = WS_XN;
constexpr int MOE_ROWS = 65536 + 16 * 256;
constexpr size_t WS_END = 1025 * MiB;
static_assert(WS_WIN + (size_t)4 * 3072 * 2048 * 2 <= WS_WOUT && WS_WOUT + (size_t)4 * 2048 * 1024 * 2 <= WS_WGU_D && WS_WGU_D + (size_t)2 * 11264 * 2048 * 2 <= WS_WDN_D &&
              WS_WDN_D + (size_t)2 * 2048 * 5632 * 2 <= WS_WGU_M && WS_WGU_M + (size_t)16 * 2816 * 2048 * 2 <= WS_WDN_M && WS_WDN_M + (size_t)16 * 2048 * 1408 * 2 <= WS_ROPE &&
              WS_ROPE + (size_t)2 * M * 64 * 4 <= WS_XN && WS_XN + (size_t)M * DM * 2 <= WS_ATT && WS_ATT + (size_t)M * DMIX * 2 <= WS_MAP && WS_MAP + (size_t)M * 2 * 16 <= WS_LSE &&
              WS_LSE + (size_t)3 * M * 4 * 4 <= WS_ROWTOK && WS_ROWTOK + (size_t)MOE_ROWS * 8 <= WS_BIG && WS_XG + (size_t)MOE_ROWS * DM * 2 <= WS_END && WS_HMID_M + (size_t)MOE_ROWS * DFE * 2 <= WS_MAP && WS_BIG + (size_t)M * DFF * 2 <= WS_END && WS_ODIL + (size_t)3 * M * 512 * 2 <= WS_END, "d_ws map");
constexpr int CW_MOE = 1024;
constexpr int CW_BAR = 4096;

constexpr int RING_OFF = 0, RING_BYTES = 131072;
constexpr int LDSCTL_OFF = RING_BYTES, MISC_OFF = LDSCTL_OFF + 320;
constexpr int LDS_BYTES = 147456;

#define GAS __attribute__((address_space(1)))
#define LAS __attribute__((address_space(3)))
typedef unsigned short bf16;
typedef unsigned v4u __attribute__((ext_vector_type(4)));
typedef unsigned v2u __attribute__((ext_vector_type(2)));
typedef float f32x4 __attribute__((ext_vector_type(4)));
typedef float f32x16 __attribute__((ext_vector_type(16)));
typedef short bf16x8 __attribute__((ext_vector_type(8)));
typedef short s16x4 __attribute__((ext_vector_type(4)));
#define LDS_WAIT() asm volatile("s_waitcnt lgkmcnt(0)" ::: "memory")
#define VM_WAIT() asm volatile("s_waitcnt vmcnt(0)" ::: "memory")
__device__ __forceinline__ unsigned f2bf(float f) { unsigned u = __builtin_bit_cast(unsigned, f); return (u + 0x7fffu + ((u >> 16) & 1u)) >> 16; }
__device__ __forceinline__ unsigned pk2(float lo, float hi) { return f2bf(lo) | (f2bf(hi) << 16); }
__device__ __forceinline__ float bf_lo(unsigned w) { return __builtin_bit_cast(float, w << 16); }
__device__ __forceinline__ float bf_hi(unsigned w) { return __builtin_bit_cast(float, w & 0xffff0000u); }

#define XB_TMO      128
#define XB_XCNT(j)  (256  + 64 * (j))
#define XB_XSUB(j)  (1280 + 64 * (j))
#define XB_XGEN(j)  (2304 + 64 * (j))
#define XB_TOP      3328
#define XB_TOPGEN   3392
#define XCD_BAR_WORDS 3456
#define XB_SPIN_CAP (1u << 18)

__device__ __forceinline__ unsigned xb_ld(unsigned* p)              { return __hip_atomic_load(p, __ATOMIC_RELAXED, __HIP_MEMORY_SCOPE_AGENT); }
__device__ __forceinline__ unsigned xb_add(unsigned* p, unsigned v) { return __hip_atomic_fetch_add(p, v, __ATOMIC_RELAXED, __HIP_MEMORY_SCOPE_AGENT); }
__device__ __forceinline__ unsigned xb_xcc_id() { return (unsigned)__builtin_amdgcn_s_getreg((3 << 11) | 20) & 0xFu; }
#define XB_SPIN(cond, bar) do { unsigned _sp = 0; while (cond) { __builtin_amdgcn_s_sleep(1); \
    if ((++_sp & 255u) == 0u) { if (xb_ld(&(bar)[XB_TMO])) break; if (_sp > XB_SPIN_CAP) { atomicAdd(&(bar)[XB_TMO], 1u); break; } } } } while (0)

struct XcdBarrier {
    unsigned* bar; unsigned x;
    volatile LAS unsigned* st;
};
__device__ __forceinline__ XcdBarrier xcd_barrier_post(unsigned* bar, volatile LAS unsigned* st) {
    XcdBarrier b; b.bar = bar; b.x = xb_xcc_id(); b.st = st;
    if (threadIdx.x == 0) (void)xb_add(&bar[XB_XCNT(b.x)], 1u);
    return b;
}
__device__ __forceinline__ void xcd_barrier_complete(unsigned* bar, unsigned x, unsigned& nloc, unsigned& nx) {
    const unsigned G = gridDim.x * gridDim.y * gridDim.z;
    unsigned sum, cnt, mine, sp = 0u;
    for (;;) {
        sum = 0u; cnt = 0u; mine = 0u;
#pragma unroll
        for (unsigned j = 0; j < 16; ++j) { const unsigned c = xb_ld(&bar[XB_XCNT(j)]); sum += c; cnt += (c > 0u) ? 1u : 0u; mine = (j == x) ? c : mine; }
        if (sum == G) break;
        __builtin_amdgcn_s_sleep(1);
        if ((++sp & 255u) == 0u) { if (xb_ld(&bar[XB_TMO])) break; if (sp > XB_SPIN_CAP) { atomicAdd(&bar[XB_TMO], 1u); break; } }
    }
    nloc = mine > 0u ? mine : 1u; nx = cnt > 0u ? cnt : 1u;
}
__device__ __forceinline__ void xcd_barrier(const XcdBarrier& b) {
    asm volatile("s_waitcnt vmcnt(0)" ::: "memory");
    __syncthreads();
    if (threadIdx.x == 0) {
        unsigned* bar = b.bar;
        __builtin_amdgcn_s_waitcnt(0);
        unsigned nloc = b.st[0], nx = b.st[1];
        if (nloc == 0u) { xcd_barrier_complete(bar, b.x, nloc, nx); b.st[0] = nloc; b.st[1] = nx; }
        const unsigned old = xb_add(&bar[XB_XSUB(b.x)], 1u);
        const unsigned gen = old / nloc;
        if (old + 1u == (gen + 1u) * nloc) {
            __builtin_amdgcn_fence(__ATOMIC_RELEASE, "agent");
            asm volatile("s_waitcnt vmcnt(0)" ::: "memory");
            const unsigned og = xb_add(&bar[XB_TOP], 1u);
            const unsigned tg = og / nx;
            if (og + 1u == (tg + 1u) * nx) xb_add(&bar[XB_TOPGEN], 1u);
            else XB_SPIN(xb_ld(&bar[XB_TOPGEN]) == tg, bar);
            __builtin_amdgcn_fence(__ATOMIC_ACQUIRE, "agent");
            xb_add(&bar[XB_XGEN(b.x)], 1u);
            asm volatile("s_waitcnt vmcnt(0)" ::: "memory");
        } else {
            XB_SPIN(xb_ld(&bar[XB_XGEN(b.x)]) == gen, bar);
            __builtin_amdgcn_fence(__ATOMIC_ACQUIRE, "agent");
            asm volatile("s_waitcnt vmcnt(0)" ::: "memory");
        }
    }
    __syncthreads();
}

__device__ __forceinline__ float wave_sum(float v) {
#pragma unroll
    for (int o = 1; o < 64; o <<= 1) v += __shfl_xor(v, o);
    return v;
}
__device__ const float ROPE_INV[64] = {
    1.0f, 0.8659643233600653f, 0.7498942093324559f, 0.6493816315762113f, 0.5623413251903491f, 0.4869675251658631f, 0.4216965034285822f, 0.3651741272548377f,
    0.31622776601683794f, 0.27384196342643613f, 0.23713737056616552f, 0.2053525026457146f, 0.1778279410038923f, 0.1539926526059492f, 0.1333521432163324f, 0.11547819846894582f,
    0.1f, 0.08659643233600653f, 0.07498942093324558f, 0.06493816315762113f, 0.05623413251903491f, 0.04869675251658631f, 0.042169650342858224f, 0.03651741272548377f,
    0.03162277660168379f, 0.027384196342643614f, 0.023713737056616554f, 0.02053525026457146f, 0.01778279410038923f, 0.01539926526059492f, 0.01333521432163324f, 0.011547819846894581f,
    0.01f, 0.008659643233600654f, 0.007498942093324558f, 0.006493816315762113f, 0.005623413251903491f, 0.004869675251658631f, 0.004216965034285823f, 0.003651741272548377f,
    0.0031622776601683794f, 0.0027384196342643613f, 0.0023713737056616554f, 0.002053525026457146f, 0.0017782794100389228f, 0.001539926526059492f, 0.001333521432163324f, 0.0011547819846894581f,
    0.001f, 0.0008659643233600654f, 0.0007498942093324559f, 0.0006493816315762113f, 0.0005623413251903491f, 0.0004869675251658631f, 0.00042169650342858224f, 0.0003651741272548377f,
    0.00031622776601683794f, 0.0002738419634264361f, 0.00023713737056616554f, 0.0002053525026457146f, 0.00017782794100389227f, 0.0001539926526059492f, 0.0001333521432163324f, 0.00011547819846894582f };
__device__ __forceinline__ void sincos_d(double a, float& sn, float& cs) {
    const double k = __builtin_rint(a * 0.15915494309189535);
    double r = __builtin_fma(-k, 6.283185307179586, a); r = __builtin_fma(-k, 2.4492935982947064e-16, r);
    const double r2 = r * r;
    double s = -9.18368986379554601e-29;
    s = s * r2 + 6.44695028438447359e-26; s = s * r2 + -3.86817017063068413e-23; s = s * r2 + 1.95729410633912626e-20; s = s * r2 + -8.22063524662432950e-18;
    s = s * r2 + 2.81145725434552060e-15; s = s * r2 + -7.64716373181981641e-13; s = s * r2 + 1.60590438368216133e-10; s = s * r2 + -2.50521083854417202e-08;
    s = s * r2 + 2.75573192239858925e-06; s = s * r2 + -1.98412698412698413e-04; s = s * r2 + 8.33333333333333322e-03; s = s * r2 + -1.66666666666666657e-01; s = s * r2 + 1.0;
    double c = 3.27988923706983776e-30;
    c = c * r2 + -2.47959626322479759e-27; c = c * r2 + 1.61173757109611839e-24; c = c * r2 + -8.89679139245057408e-22; c = c * r2 + 4.11031762331216484e-19;
    c = c * r2 + -1.56192069685862253e-16; c = c * r2 + 4.77947733238738525e-14; c = c * r2 + -1.14707455977297245e-11; c = c * r2 + 2.08767569878681002e-09;
    c = c * r2 + -2.75573192239858883e-07; c = c * r2 + 2.48015873015873016e-05; c = c * r2 + -1.38888888888888894e-03; c = c * r2 + 4.16666666666666644e-02; c = c * r2 + -0.5; c = c * r2 + 1.0;
    sn = (float)(s * r); cs = (float)c;
}

__device__ __forceinline__ void transpose_item(const float* W, int K, int N, bf16* WT, int mode, LAS float* scr, int item, int lane) {
    const int nblk = N / 32, kb = item / nblk, nb = item % nblk, k0 = 64 * kb, n0 = 32 * nb;
#pragma unroll 8
    for (int i = 0; i < 32; ++i) { const int kk = 2 * i + (lane >> 5); scr[kk * 33 + (lane & 31)] = W[(size_t)(k0 + kk) * N + n0 + (lane & 31)]; }
    LDS_WAIT(); asm volatile("" ::: "memory");
    const int c = lane & 7;
#pragma unroll
    for (int j = 0; j < 4; ++j) { const int n = (lane >> 3) + 8 * j; const LAS float* s = scr + (8 * c) * 33 + n;
        const int nn = n0 + n; const int drow = (mode == 0) ? nn : ((nn >> 7) * 256 + (mode == 2 ? 128 : 0) + (nn & 127));
        v4u o; o.x = pk2(s[0 * 33], s[1 * 33]); o.y = pk2(s[2 * 33], s[3 * 33]); o.z = pk2(s[4 * 33], s[5 * 33]); o.w = pk2(s[6 * 33], s[7 * 33]);
        *(v4u*)(WT + (size_t)drow * K + k0 + 8 * c) = o; }
    LDS_WAIT(); asm volatile("" ::: "memory");
}
__device__ __forceinline__ void transpose_group(const float* src, bf16* dst, int K, int N, int mode, size_t dstride, int r, LAS float* scr, int lane) {
    const int per = (K / 64) * (N / 32); const int l = r / per, it = r % per;
    transpose_item(src + (size_t)l * K * N, K, N, dst + (size_t)l * dstride, mode, scr, it, lane);
}

template <bool ROUTER>
__device__ __forceinline__ void norm_phase(const float* x, const float* gain, bf16* xn, const float* wr, v4u* map, unsigned* cnt, int gw, int NGW, int lane) {
    f32x4 g[4][2];
#pragma unroll
    for (int j = 0; j < 4; ++j)
#pragma unroll
        for (int e = 0; e < 2; ++e) g[j][e] = *(const f32x4*)(gain + 512 * j + 8 * lane + 4 * e);
    int my_e0 = -1, my_e1 = -1, my_row = -1, it = 0; float my_g0 = 0.f, my_g1 = 0.f;
    for (int row = gw; row < M; row += NGW) {
        const float* xr = x + (size_t)row * DM + 8 * lane;
        f32x4 v[4][2]; float ss = 0.f;
#pragma unroll
        for (int j = 0; j < 4; ++j)
#pragma unroll
            for (int e = 0; e < 2; ++e) { v[j][e] = *(const f32x4*)(xr + 512 * j + 4 * e); ss += (v[j][e].x * v[j][e].x + v[j][e].y * v[j][e].y) + (v[j][e].z * v[j][e].z + v[j][e].w * v[j][e].w); }
        ss = wave_sum(ss);
        const float rstd = __builtin_amdgcn_rsqf(ss * (1.0f / DM) + EPS);
        bf16* orow = xn + (size_t)row * DM + 8 * lane;
#pragma unroll
        for (int j = 0; j < 4; ++j) {
            v[j][0] = v[j][0] * rstd * g[j][0]; v[j][1] = v[j][1] * rstd * g[j][1];
            v4u o; o.x = pk2(v[j][0].x, v[j][0].y); o.y = pk2(v[j][0].z, v[j][0].w); o.z = pk2(v[j][1].x, v[j][1].y); o.w = pk2(v[j][1].z, v[j][1].w);
            *(v4u*)(orow + 512 * j) = o;
        }
        if constexpr (ROUTER) {
            float lg[8];
#pragma unroll
            for (int e = 0; e < 8; ++e) lg[e] = 0.f;
#pragma unroll
            for (int j = 0; j < 4; ++j)
#pragma unroll
                for (int e = 0; e < 2; ++e)
#pragma unroll
                    for (int t = 0; t < 4; ++t) {
                        const int col = 512 * j + 8 * lane + 4 * e + t; const f32x4* w = (const f32x4*)(wr + (size_t)col * 8); const f32x4 w0 = w[0], w1 = w[1]; const float yv = v[j][e][t];
                        lg[0] += yv * w0.x; lg[1] += yv * w0.y; lg[2] += yv * w0.z; lg[3] += yv * w0.w; lg[4] += yv * w1.x; lg[5] += yv * w1.y; lg[6] += yv * w1.z; lg[7] += yv * w1.w; }
#pragma unroll
            for (int e = 0; e < 8; ++e) lg[e] = wave_sum(lg[e]);
            int i0 = 0; float l0 = lg[0];
#pragma unroll
            for (int e = 1; e < 8; ++e) if (lg[e] > l0) { l0 = lg[e]; i0 = e; }
            int i1 = -1; float l1 = -3.0e38f;
#pragma unroll
            for (int e = 0; e < 8; ++e) if (e != i0 && lg[e] > l1) { l1 = lg[e]; i1 = e; }
            const float e1 = __expf(l1 - l0); const float g0 = 1.0f / (1.0f + e1), g1 = e1 * g0;
            if (lane == (it & 63)) { my_e0 = i0; my_e1 = i1; my_g0 = g0; my_g1 = g1; my_row = row; }
            ++it;
            if ((it & 63) == 0 || row + NGW >= M) {
                int rank0 = 0, rank1 = 0, mycount = 0;
#pragma unroll
                for (int e = 0; e < 8; ++e) {
                    const unsigned long long m0 = __ballot(my_e0 == e), m1 = __ballot(my_e1 == e);
                    const int r0 = __builtin_amdgcn_mbcnt_hi((unsigned)(m0 >> 32), __builtin_amdgcn_mbcnt_lo((unsigned)m0, 0u));
                    const int r1 = __builtin_amdgcn_mbcnt_hi((unsigned)(m1 >> 32), __builtin_amdgcn_mbcnt_lo((unsigned)m1, 0u));
                    if (my_e0 == e) rank0 = r0; if (my_e1 == e) rank1 = r1;
                    if (lane == e) mycount = __builtin_popcountll(m0); if (lane == 8 + e) mycount = __builtin_popcountll(m1);
                }
                int base = 0;
                if (lane < 16 && mycount > 0) base = (int)__hip_atomic_fetch_add(cnt + 64 * lane, (unsigned)mycount, __ATOMIC_RELAXED, __HIP_MEMORY_SCOPE_AGENT);
                const int b0 = __shfl(base, my_e0 & 7), b1 = __shfl(base, 8 + (my_e1 & 7));
                if (my_row >= 0) {
                    v4u a; a.x = (unsigned)my_e0; a.y = (unsigned)(b0 + rank0); a.z = __builtin_bit_cast(unsigned, my_g0); a.w = (unsigned)my_row;
                    v4u b; b.x = (unsigned)(8 + my_e1); b.y = (unsigned)(b1 + rank1); b.z = __builtin_bit_cast(unsigned, my_g1); b.w = (unsigned)my_row;
                    map[(size_t)my_row * 2] = a; map[(size_t)my_row * 2 + 1] = b;
                }
                my_e0 = -1; my_e1 = -1; my_row = -1;
            }
        }
    }
    (void)my_e0; (void)my_e1; (void)my_row; (void)it; (void)my_g0; (void)my_g1;
}

__device__ __forceinline__ void qkprep_phase(bf16* H, const float* qn_sb, const float* kn_sb, const float* qn_dil, const float* kn_dil, const float* rope_c, const float* rope_s, int gw, int NGW, int lane) {
    const int d0 = 8 * (lane & 15);
    f32x4 gq[4][2];
    { const float* gp[4] = {qn_sb, kn_sb, qn_dil, kn_dil};
#pragma unroll
      for (int p = 0; p < 4; ++p) { gq[p][0] = *(const f32x4*)(gp[p] + d0); gq[p][1] = *(const f32x4*)(gp[p] + d0 + 4); } }
    const int ri = d0 & 63;
    for (int tok = gw; tok < M; tok += NGW) {
        bf16* hrow = H + (size_t)tok * DIN;
        const f32x4 c0 = *(const f32x4*)(rope_c + (size_t)tok * 64 + ri), c1 = *(const f32x4*)(rope_c + (size_t)tok * 64 + ri + 4);
        const f32x4 s0 = *(const f32x4*)(rope_s + (size_t)tok * 64 + ri), s1 = *(const f32x4*)(rope_s + (size_t)tok * 64 + ri + 4);
#pragma unroll
        for (int p = 0; p < 4; ++p) {
            const int colbase = (p == 0) ? C_QSB : (p == 1) ? C_KSB : (p == 2) ? C_QDIL : C_KDIL;
            v4u* ptr = (v4u*)(hrow + colbase + 8 * lane);
            const v4u raw = *ptr;
            float y[8]; y[0] = bf_lo(raw.x); y[1] = bf_hi(raw.x); y[2] = bf_lo(raw.y); y[3] = bf_hi(raw.y); y[4] = bf_lo(raw.z); y[5] = bf_hi(raw.z); y[6] = bf_lo(raw.w); y[7] = bf_hi(raw.w);
            float ss = 0.f;
#pragma unroll
            for (int e = 0; e < 8; ++e) ss += y[e] * y[e];
            ss += __shfl_xor(ss, 1); ss += __shfl_xor(ss, 2); ss += __shfl_xor(ss, 4); ss += __shfl_xor(ss, 8);
            const float rstd = __builtin_amdgcn_rsqf(ss * (1.0f / HD) + EPS);
#pragma unroll
            for (int e = 0; e < 8; ++e) y[e] = y[e] * rstd * gq[p][e >> 2][e & 3];
            if (p >= 2) {
                const bool lowhalf = (lane & 8) == 0;
#pragma unroll
                for (int e = 0; e < 8; ++e) { const float partner = __shfl_xor(y[e], 8); const float cc = (e < 4) ? c0[e & 3] : c1[e & 3], sn = (e < 4) ? s0[e & 3] : s1[e & 3];
                    y[e] = lowhalf ? (y[e] * cc - partner * sn) : (y[e] * cc + partner * sn); }
            }
            v4u o; o.x = pk2(y[0], y[1]); o.y = pk2(y[2], y[3]); o.z = pk2(y[4], y[5]); o.w = pk2(y[6], y[7]);
            *ptr = o;
        }
    }
}

#define MFMA32(a, b, c) __builtin_amdgcn_mfma_f32_32x32x16_bf16((a), (b), (c), 0, 0, 0)
__device__ __forceinline__ int crow16(int i, int hh) { return (i & 3) + 8 * (i >> 2) + 4 * hh; }
__device__ __forceinline__ int voff(int row, int ch) { return 256 * row + 16 * (ch ^ (((row & 3) << 2) | ((row >> 2) & 3))); }
__device__ __forceinline__ void load_frag8(bf16x8 (&f)[8], const bf16* rowptr, int hh) {
    const v4u* p = (const v4u*)rowptr + 2 * hh;
#pragma unroll
    for (int c = 0; c < 4; ++c) { f[2 * c] = __builtin_bit_cast(bf16x8, p[4 * c]); f[2 * c + 1] = __builtin_bit_cast(bf16x8, p[4 * c + 1]); }
}
__device__ __forceinline__ void stage_v(LAS unsigned char* vimg, const bf16* vbase, size_t rstride, int lane) {
    v4u t[8];
#pragma unroll
    for (int i = 0; i < 8; ++i) { const int row = 4 * i + (lane >> 4); t[i] = *(const v4u*)(vbase + (size_t)row * rstride + 8 * (lane & 15)); }
#pragma unroll
    for (int i = 0; i < 8; ++i) { const int row = 4 * i + (lane >> 4); *(LAS v4u*)(vimg + voff(row, lane & 15)) = t[i]; }
}
__device__ __forceinline__ bf16x8 pack8(const float* p) {
    v4u w; w.x = pk2(p[0], p[1]); w.y = pk2(p[2], p[3]); w.z = pk2(p[4], p[5]); w.w = pk2(p[6], p[7]);
    return __builtin_bit_cast(bf16x8, w);
}
__device__ __forceinline__ void pv_tile(f32x16 (&O)[4], const float (&P)[16], LAS unsigned char* vimg, int lane) {
    const int hh = lane >> 5, i16 = lane & 15, q = i16 >> 2, p = i16 & 3, blk = (lane >> 4) & 1;
    const bf16x8 pf0 = pack8(&P[0]), pf1 = pack8(&P[8]);
    asm volatile("" ::: "memory");
#pragma unroll
    for (int dt = 0; dt < 4; ++dt) {
#pragma unroll
        for (int s = 0; s < 2; ++s) {
            const int ch = 4 * dt + 2 * blk + (p >> 1);
            const int rlo = 16 * s + 4 * hh + q, rhi = rlo + 8;
            const s16x4 lo = __builtin_amdgcn_ds_read_tr16_b64_v4i16((LAS s16x4*)(vimg + voff(rlo, ch) + 8 * (p & 1)));
            const s16x4 hi = __builtin_amdgcn_ds_read_tr16_b64_v4i16((LAS s16x4*)(vimg + voff(rhi, ch) + 8 * (p & 1)));
            const bf16x8 va = __builtin_shufflevector(lo, hi, 0, 1, 2, 3, 4, 5, 6, 7);
            O[dt] = MFMA32(va, s == 0 ? pf0 : pf1, O[dt]);
        }
    }
    asm volatile("" ::: "memory");
}
constexpr float ATT_C = 0.08838834764831845f * 1.4426950408889634f;
constexpr float SB_STOP = 160.0f;

__device__ __forceinline__ void sb_unit(const bf16* H, float* OSB, LAS unsigned char* vimg, int b, int hd, int qt, int lane) {
    const int r = lane & 31, hh = lane >> 5;
    const size_t tokq = (size_t)b * SEQ + 32 * qt + r;
    bf16x8 Q[8]; load_frag8(Q, H + tokq * DIN + C_QSB + hd * HD, hh);
    f32x16 O[4];
#pragma unroll
    for (int dt = 0; dt < 4; ++dt)
#pragma unroll
        for (int i = 0; i < 16; ++i) O[dt][i] = 0.f;
    float later = 0.f;
    for (int kt = qt; kt >= 0; --kt) {
        const size_t tok0 = (size_t)b * SEQ + 32 * kt;
        bf16x8 K[8]; load_frag8(K, H + (tok0 + r) * DIN + C_KSB + hd * HD, hh);
        stage_v(vimg, H + tok0 * DIN + C_VSB + hd * HD, DIN, lane);
        f32x16 S;
#pragma unroll
        for (int i = 0; i < 16; ++i) S[i] = 0.f;
#pragma unroll
        for (int c = 0; c < 8; ++c) S = MFMA32(K[c], Q[c], S);
        const bool diag = (kt == qt);
        float u[16], a[16]; bool valid[16];
#pragma unroll
        for (int i = 0; i < 16; ++i) {
            u[i] = S[i] * ATT_C; valid[i] = !diag || (crow16(i, hh) < r);
            const float e = __builtin_amdgcn_exp2f(-__builtin_fabsf(u[i]));
            const float sp = __builtin_fmaxf(u[i], 0.f) + __builtin_amdgcn_logf(1.0f + e);
            a[i] = valid[i] ? sp : 0.f;
        }
        float T[4], To[4];
#pragma unroll
        for (int G = 0; G < 4; ++G) { a[4 * G + 2] += a[4 * G + 3]; a[4 * G + 1] += a[4 * G + 2]; a[4 * G] += a[4 * G + 1]; T[G] = a[4 * G]; }
#pragma unroll
        for (int G = 0; G < 4; ++G) To[G] = __shfl_xor(T[G], 32);
        const float P3 = T[3] + To[3], P2 = T[2] + To[2], P1 = T[1] + To[1], P0 = T[0] + To[0];
        float Qs[4]; Qs[3] = 0.f; Qs[2] = P3; Qs[1] = P3 + P2; Qs[0] = Qs[1] + P1;
        const float total = Qs[0] + P0;
        float P[16];
#pragma unroll
        for (int i = 0; i < 16; ++i) { const int G = i >> 2; const float off = Qs[G] + (hh == 0 ? To[G] : 0.f);
            const float l2a = u[i] - (a[i] + off) - later; P[i] = valid[i] ? __builtin_amdgcn_exp2f(l2a) : 0.f; }
        pv_tile(O, P, vimg, lane);
        later += total;
        if (__all(later > SB_STOP)) break;
    }
    float* orow = OSB + tokq * DSB + hd * HD;
#pragma unroll
    for (int dt = 0; dt < 4; ++dt)
#pragma unroll
        for (int G = 0; G < 4; ++G) { f32x4 o; o.x = O[dt][4 * G]; o.y = O[dt][4 * G + 1]; o.z = O[dt][4 * G + 2]; o.w = O[dt][4 * G + 3];
            *(f32x4*)(orow + 32 * dt + 8 * G + 4 * hh) = o; }
}

__device__ __forceinline__ void dil_unit(const bf16* H, bf16* ODIL, float* LSE, LAS unsigned char* vimg, int b, int hd, int g, int rc, int mt, int lane) {
    const int r = lane & 31, hh = lane >> 5;
    const int delta = (g == 0) ? 1 : (g == 1 ? 4 : 16);
    const size_t tokq = (size_t)b * SEQ + (size_t)(32 * mt + r) * delta + rc;
    bf16x8 Q[8]; load_frag8(Q, H + tokq * DIN + C_QDIL + hd * HD, hh);
    f32x16 O[4];
#pragma unroll
    for (int dt = 0; dt < 4; ++dt)
#pragma unroll
        for (int i = 0; i < 16; ++i) O[dt][i] = 0.f;
    float mrun = -1.0e30f, lsum = 0.f;
    const int ktlo = (mt - 4 > 0) ? (mt - 4) : 0;
    for (int kt = mt; kt >= ktlo; --kt) {
        const size_t tok0 = (size_t)b * SEQ + (size_t)(32 * kt) * delta + rc;
        bf16x8 K[8]; load_frag8(K, H + (tok0 + (size_t)r * delta) * DIN + C_KDIL + hd * HD, hh);
        stage_v(vimg, H + tok0 * DIN + C_VDIL + hd * HD, (size_t)DIN * delta, lane);
        f32x16 S;
#pragma unroll
        for (int i = 0; i < 16; ++i) S[i] = 0.f;
#pragma unroll
        for (int c = 0; c < 8; ++c) S = MFMA32(K[c], Q[c], S);
        const int dq = 32 * (mt - kt) + r;
        float u[16]; float tmax = -1.0e30f;
#pragma unroll
        for (int i = 0; i < 16; ++i) { const int dist = dq - crow16(i, hh); const bool ok = (dist >= 0) && (dist <= 128);
            u[i] = ok ? S[i] * ATT_C : -1.0e30f; tmax = __builtin_fmaxf(tmax, u[i]); }
        tmax = __builtin_fmaxf(tmax, __shfl_xor(tmax, 32));
        const float mnew = __builtin_fmaxf(mrun, tmax);
        const float alpha = __builtin_amdgcn_exp2f(mrun - mnew);
        float P[16]; float ps = 0.f;
#pragma unroll
        for (int i = 0; i < 16; ++i) { P[i] = __builtin_amdgcn_exp2f(u[i] - mnew); ps += P[i]; }
        lsum = lsum * alpha + ps;
#pragma unroll
        for (int dt = 0; dt < 4; ++dt)
#pragma unroll
            for (int i = 0; i < 16; ++i) O[dt][i] *= alpha;
        pv_tile(O, P, vimg, lane);
        mrun = mnew;
    }
    const float ltot = lsum + __shfl_xor(lsum, 32);
    const float inv = 1.0f / ltot;
    bf16* orow = ODIL + ((size_t)g * M + tokq) * 512 + hd * HD;
#pragma unroll
    for (int dt = 0; dt < 4; ++dt)
#pragma unroll
        for (int G = 0; G < 4; ++G) { v2u o; o.x = pk2(O[dt][4 * G] * inv, O[dt][4 * G + 1] * inv); o.y = pk2(O[dt][4 * G + 2] * inv, O[dt][4 * G + 3] * inv);
            *(v2u*)(orow + 32 * dt + 8 * G + 4 * hh) = o; }
    if (hh == 0) LSE[((size_t)g * M + tokq) * 4 + hd] = (mrun + __builtin_amdgcn_logf(ltot)) * 0.6931471805599453f;
}

__device__ __forceinline__ void attn_phase(const bf16* H, float* OSB, bf16* ODIL, float* LSE, LAS unsigned char* lds, int gw, int NGW, int wave, int lane) {
    LAS unsigned char* vimg = lds + wave * 8192;
    constexpr int NSB = NB * 4 * 256, NDIL = 3 * NSB;
    for (int uidx = gw; uidx < NSB + NDIL; uidx += NGW) {
        if (uidx < NSB) { const int qt = uidx & 255, hd = (uidx >> 8) & 3, b = uidx >> 10; sb_unit(H, OSB, vimg, b, hd, qt, lane); }
        else { const int did = uidx - NSB; const int g = did / NSB, rem = did % NSB; const int b = rem >> 10, hd = (rem >> 8) & 3, sub = rem & 255;
            const int delta = (g == 0) ? 1 : (g == 1 ? 4 : 16); const int rc = sub % delta, mt = sub / delta;
            dil_unit(H, ODIL, LSE, vimg, b, hd, g, rc, mt, lane); }
    }
}

__device__ __forceinline__ void combine_phase(const float* OSB, const bf16* ODIL, const float* LSE, const float* g_sb, const float* g_dil, bf16* ATT, int gw, int NGW, int lane) {
    const f32x4 gs0 = *(const f32x4*)(g_sb + 8 * lane), gs1 = *(const f32x4*)(g_sb + 8 * lane + 4);
    const f32x4 gd0 = *(const f32x4*)(g_dil + 8 * lane), gd1 = *(const f32x4*)(g_dil + 8 * lane + 4);
    const int hd = lane >> 4;
    for (int tok = gw; tok < M; tok += NGW) {
        { const float* p = OSB + (size_t)tok * DSB + 8 * lane; f32x4 v0 = *(const f32x4*)p, v1 = *(const f32x4*)(p + 4);
          float ss = (v0.x * v0.x + v0.y * v0.y) + (v0.z * v0.z + v0.w * v0.w) + (v1.x * v1.x + v1.y * v1.y) + (v1.z * v1.z + v1.w * v1.w);
          ss = wave_sum(ss); const float rstd = __builtin_amdgcn_rsqf(ss * (1.0f / DSB) + EPS);
          v0 = v0 * rstd * gs0; v1 = v1 * rstd * gs1;
          v4u o; o.x = pk2(v0.x, v0.y); o.y = pk2(v0.z, v0.w); o.z = pk2(v1.x, v1.y); o.w = pk2(v1.z, v1.w);
          *(v4u*)(ATT + (size_t)tok * DMIX + 8 * lane) = o; }
        { float l0 = LSE[((size_t)0 * M + tok) * 4 + hd], l1 = LSE[((size_t)1 * M + tok) * 4 + hd], l2 = LSE[((size_t)2 * M + tok) * 4 + hd];
          const float mx = __builtin_fmaxf(l0, __builtin_fmaxf(l1, l2));
          float w0 = __expf(l0 - mx), w1 = __expf(l1 - mx), w2 = __expf(l2 - mx); const float iw = 1.0f / (w0 + w1 + w2); w0 *= iw; w1 *= iw; w2 *= iw;
          const v4u a = *(const v4u*)(ODIL + ((size_t)0 * M + tok) * 512 + 8 * lane), bq = *(const v4u*)(ODIL + ((size_t)1 * M + tok) * 512 + 8 * lane), c = *(const v4u*)(ODIL + ((size_t)2 * M + tok) * 512 + 8 * lane);
          float y[8];
          y[0] = w0 * bf_lo(a.x) + w1 * bf_lo(bq.x) + w2 * bf_lo(c.x); y[1] = w0 * bf_hi(a.x) + w1 * bf_hi(bq.x) + w2 * bf_hi(c.x);
          y[2] = w0 * bf_lo(a.y) + w1 * bf_lo(bq.y) + w2 * bf_lo(c.y); y[3] = w0 * bf_hi(a.y) + w1 * bf_hi(bq.y) + w2 * bf_hi(c.y);
          y[4] = w0 * bf_lo(a.z) + w1 * bf_lo(bq.z) + w2 * bf_lo(c.z); y[5] = w0 * bf_hi(a.z) + w1 * bf_hi(bq.z) + w2 * bf_hi(c.z);
          y[6] = w0 * bf_lo(a.w) + w1 * bf_lo(bq.w) + w2 * bf_lo(c.w); y[7] = w0 * bf_hi(a.w) + w1 * bf_hi(bq.w) + w2 * bf_hi(c.w);
          float ss = 0.f;
#pragma unroll
          for (int e = 0; e < 8; ++e) ss += y[e] * y[e];
          ss = wave_sum(ss); const float rstd = __builtin_amdgcn_rsqf(ss * (1.0f / 512.0f) + EPS);
#pragma unroll
          for (int e = 0; e < 8; ++e) y[e] = y[e] * rstd * ((e < 4) ? gd0[e & 3] : gd1[e & 3]);
          v4u o; o.x = pk2(y[0], y[1]); o.y = pk2(y[2], y[3]); o.z = pk2(y[4], y[5]); o.w = pk2(y[6], y[7]);
          *(v4u*)(ATT + (size_t)tok * DMIX + 512 + 8 * lane) = o; }
    }
}

__device__ __forceinline__ void moe_tiles(unsigned* cnt, int lane, int& c, int& incl) {
    c = (lane < 16) ? (int)__hip_atomic_load(cnt + 64 * (lane & 15), __ATOMIC_RELAXED, __HIP_MEMORY_SCOPE_AGENT) : 0;
    const int tiles = (c + 255) >> 8; int v = tiles;
#pragma unroll
    for (int o = 1; o < 16; o <<= 1) { const int t = __shfl_up(v, o); if ((lane & 15) >= o) v += t; }
    incl = v;
}
__device__ __forceinline__ void moe_table(unsigned* cnt, LAS int* tbi, int wave, int lane) {
    if (wave == 0) { int c, incl; moe_tiles(cnt, lane, c, incl); if (lane < 16) tbi[lane] = incl; }
    __syncthreads();
}
__device__ __forceinline__ void moe_gather_phase(const bf16* XN, const v4u* map, unsigned* cnt, bf16* XG, int* rowtok, float* rowgate, int gw, int NGW, int lane) {
    int c, incl; moe_tiles(cnt, lane, c, incl);
    const int excl = incl - ((c + 255) >> 8);
    for (int tok = gw; tok < M; tok += NGW) {
        const v4u* src = (const v4u*)(XN + (size_t)tok * DM) + lane;
        const v4u d0 = src[0], d1 = src[64], d2 = src[128], d3 = src[192];
#pragma unroll
        for (int k = 0; k < 2; ++k) {
            const v4u m = map[(size_t)tok * 2 + k];
            const int grp = __builtin_amdgcn_readfirstlane((int)m.x), slot = __builtin_amdgcn_readfirstlane((int)m.y);
            const int row = (__shfl(excl, grp) << 8) + slot;
            v4u* dst = (v4u*)(XG + (size_t)row * DM) + lane;
            dst[0] = d0; dst[64] = d1; dst[128] = d2; dst[192] = d3;
            const unsigned gbits = m.z;
            if (lane == 0) { rowtok[row] = tok; rowgate[row] = __uint_as_float(gbits); }
        }
    }
    for (int g = 0; g < 16; ++g) {
        const int cg = __shfl(c, g), start = (__shfl(excl, g) << 8) + cg, end = __shfl(incl, g) << 8;
        for (int r = start + gw; r < end; r += NGW) {
            v4u* dst = (v4u*)(XG + (size_t)r * DM) + lane; const v4u z = {0u, 0u, 0u, 0u};
            dst[0] = z; dst[64] = z; dst[128] = z; dst[192] = z;
            if (lane == 0) { rowtok[r] = -1; rowgate[r] = 0.f; }
        }
    }
}

struct Args { const void* in[19]; float* out; unsigned char* ws; int ph_lo, ph_hi, li, pad; };
__global__ void __launch_bounds__(NWAVES * 64, 2) mega_fwd(Args args) {
    extern __shared__ __attribute__((aligned(16))) unsigned char lds_raw[];
    LAS unsigned char* lds = (LAS unsigned char*)lds_raw;
    const int G = gridDim.x;
    const int NGW = G * NWAVES;
    unsigned char* ws = args.ws;
    unsigned* ctl = (unsigned*)(ws + WS_CTL);
    for (int u = threadIdx.x; u < (LDS_BYTES - LDSCTL_OFF) / 4; u += NWAVES * 64) ((LAS unsigned*)(lds + LDSCTL_OFF))[u] = 0u;
    __syncthreads();
    volatile LAS unsigned* MISC = (volatile LAS unsigned*)(lds + MISC_OFF);
    const int lo = args.ph_lo, hi = args.ph_hi;
    XcdBarrier bar; bar.bar = ctl + CW_BAR + args.li * XCD_BAR_WORDS; bar.x = 0; bar.st = nullptr;
    if (hi - lo > 1) bar = xcd_barrier_post(ctl + CW_BAR + args.li * XCD_BAR_WORDS, MISC + 8);
    int ph = 0;
#define PH_BEGIN if (ph >= lo && ph < hi) { int tid = threadIdx.x; asm volatile("" : "+v"(tid)); const int lane = tid & 63, wave = __builtin_amdgcn_readfirstlane(tid >> 6); const int gw = blockIdx.x * NWAVES + wave; (void)lane; (void)gw;
#define PH_END   if (ph + 1 < hi) xcd_barrier(bar); } ++ph;

    const float* x_in = (const float*)args.in[0];
    const int* positions = (const int*)args.in[1];
    float* xres = args.out;
    bf16* Wt_in = (bf16*)(ws + WS_WIN); bf16* Wt_out = (bf16*)(ws + WS_WOUT); bf16* Wt_gud = (bf16*)(ws + WS_WGU_D); bf16* Wt_dnd = (bf16*)(ws + WS_WDN_D);
    bf16* Wt_gum = (bf16*)(ws + WS_WGU_M); bf16* Wt_dnm = (bf16*)(ws + WS_WDN_M);
    float* rope_c = (float*)(ws + WS_ROPE); float* rope_s = rope_c + (size_t)M * 64;
    bf16* XN = (bf16*)(ws + WS_XN); bf16* ATT = (bf16*)(ws + WS_ATT); v4u* MAP = (v4u*)(ws + WS_MAP); float* LSE = (float*)(ws + WS_LSE);
    int* ROWTOK = (int*)(ws + WS_ROWTOK); float* ROWGATE = (float*)(ws + WS_ROWTOK) + MOE_ROWS; bf16* XG = (bf16*)(ws + WS_XG); bf16* HMID_M = (bf16*)(ws + WS_HMID_M);
    LAS int* tbi = (LAS int*)(lds + LDSCTL_OFF);
    bf16* Hb = (bf16*)(ws + WS_H); float* OSB = (float*)(ws + WS_OSB); bf16* ODIL = (bf16*)(ws + WS_ODIL); bf16* HMID = (bf16*)(ws + WS_HMID);

    PH_BEGIN
    {
        LAS float* scr = (LAS float*)(lds + RING_OFF + wave * 16384);
        constexpr int I_IN = 4 * (DM / 64) * (DIN / 32), I_OUT = 4 * (DMIX / 64) * (DM / 32), I_GD = 2 * (DM / 64) * (DFF / 32), I_DD = 2 * (DFF / 64) * (DM / 32);
        constexpr int I_GM = 16 * (DM / 64) * (DFE / 32), I_DM = 16 * (DFE / 64) * (DM / 32);
        constexpr int NITEMS = I_IN + I_OUT + 2 * I_GD + I_DD + 2 * I_GM + I_DM;
        for (int it = gw; it < NITEMS; it += NGW) {
            int r = it;
            if (r < I_IN) { transpose_group((const float*)args.in[3], Wt_in, DM, DIN, 0, (size_t)DIN * DM, r, scr, lane); continue; } r -= I_IN;
            if (r < I_OUT) { transpose_group((const float*)args.in[10], Wt_out, DMIX, DM, 0, (size_t)DM * DMIX, r, scr, lane); continue; } r -= I_OUT;
            if (r < I_GD) { transpose_group((const float*)args.in[12], Wt_gud, DM, DFF, 1, (size_t)2 * DFF * DM, r, scr, lane); continue; } r -= I_GD;
            if (r < I_GD) { transpose_group((const float*)args.in[13], Wt_gud, DM, DFF, 2, (size_t)2 * DFF * DM, r, scr, lane); continue; } r -= I_GD;
            if (r < I_DD) { transpose_group((const float*)args.in[14], Wt_dnd, DFF, DM, 0, (size_t)DM * DFF, r, scr, lane); continue; } r -= I_DD;
            if (r < I_GM) { transpose_group((const float*)args.in[16], Wt_gum, DM, DFE, 1, (size_t)2 * DFE * DM, r, scr, lane); continue; } r -= I_GM;
            if (r < I_GM) { transpose_group((const float*)args.in[17], Wt_gum, DM, DFE, 2, (size_t)2 * DFE * DM, r, scr, lane); continue; } r -= I_GM;
            transpose_group((const float*)args.in[18], Wt_dnm, DFE, DM, 0, (size_t)DM * DFE, r, scr, lane);
        }
        for (int idx = blockIdx.x * (NWAVES * 64) + tid; idx < M * 64; idx += G * NWAVES * 64) {
            const int tok = idx >> 6, i = idx & 63; const float ang = (float)positions[tok] * ROPE_INV[i];
            float sn, cs; sincos_d((double)ang, sn, cs); rope_c[idx] = cs; rope_s[idx] = sn; }
    }
    PH_END

    for (int layer = 0; layer < DEPTH; ++layer) {
        const int j2 = layer >> 1; const bool dense = (layer & 1) == 0;
        const float* xsrc = (layer == 0) ? x_in : xres;
        PH_BEGIN
        norm_phase<false>(xsrc, (const float*)args.in[2] + (size_t)layer * DM, XN, nullptr, nullptr, nullptr, gw, NGW, lane);
        PH_END
        PH_BEGIN
        { pg8::Gemm g{XN, Wt_in + (size_t)layer * DIN * DM, M, DIN, DM}; pg8::StaticOrder S; S.init(M, DIN, G, (int)blockIdx.x);
          pg8::EpiBf16 E{Hb, DIN};
          pg8::gemm_phase<pg8::EpiBf16, pg8::StaticOrder, PG8_ALIGN, PG8_SP2>(lds + RING_OFF, g, S, E); }
        PH_END
        PH_BEGIN
        qkprep_phase(Hb, (const float*)args.in[4] + layer * HD, (const float*)args.in[5] + layer * HD, (const float*)args.in[6] + layer * HD, (const float*)args.in[7] + layer * HD, rope_c, rope_s, gw, NGW, lane);
        PH_END
        PH_BEGIN
        attn_phase(Hb, OSB, ODIL, LSE, lds + RING_OFF, gw, NGW, wave, lane);
        PH_END
        PH_BEGIN
        combine_phase(OSB, ODIL, LSE, (const float*)args.in[8] + layer * DSB, (const float*)args.in[9] + layer * 512, ATT, gw, NGW, lane);
        PH_END
        PH_BEGIN
        { pg8::Gemm g{ATT, Wt_out + (size_t)layer * DM * DMIX, M, DM, DMIX}; pg8::StaticOrder S; S.init(M, DM, G, (int)blockIdx.x);
          pg8::EpiResAdd E{xsrc, xres, DM, nullptr, 0};
          pg8::gemm_phase<pg8::EpiResAdd, pg8::StaticOrder, PG8_ALIGN, PG8_SP2>(lds + RING_OFF, g, S, E); }
        PH_END
        PH_BEGIN
        if (dense) norm_phase<false>(xres, (const float*)args.in[11] + (size_t)layer * DM, XN, nullptr, nullptr, nullptr, gw, NGW, lane);
        else norm_phase<true>(xres, (const float*)args.in[11] + (size_t)layer * DM, XN, (const float*)args.in[15] + (size_t)j2 * DM * NE, MAP, ctl + CW_MOE + 64 * 16 * j2, gw, NGW, lane);
        PH_END
        if (dense) {
            PH_BEGIN
            { pg8::Gemm g{XN, Wt_gud + (size_t)j2 * 2 * DFF * DM, M, 2 * DFF, DM}; pg8::StaticOrder S; S.init(M, 2 * DFF, G, (int)blockIdx.x);
              pg8::EpiSwiGLU E{HMID, DFF};
              pg8::gemm_phase<pg8::EpiSwiGLU, pg8::StaticOrder, PG8_ALIGN, PG8_SP2>(lds + RING_OFF, g, S, E); }
            PH_END
            PH_BEGIN
            { pg8::Gemm g{HMID, Wt_dnd + (size_t)j2 * DM * DFF, M, DM, DFF}; pg8::StaticOrder S; S.init(M, DM, G, (int)blockIdx.x);
              pg8::EpiResAdd E{xres, xres, DM, nullptr, 0};
              pg8::gemm_phase<pg8::EpiResAdd, pg8::StaticOrder, PG8_ALIGN, PG8_SP2>(lds + RING_OFF, g, S, E); }
            PH_END
        } else {
            unsigned* mcnt = ctl + CW_MOE + 64 * 16 * j2;
            PH_BEGIN
            moe_gather_phase(XN, MAP, mcnt, XG, ROWTOK, ROWGATE, gw, NGW, lane);
            PH_END
            PH_BEGIN
            { moe_table(mcnt, tbi, wave, lane);
              const int T = tbi[15];
              pg8::Gemm g{XG, Wt_gum, MOE_ROWS, 2 * DFE, DM}; pg8::MoeOrder S; S.init_tiles(T, (2 * DFE) / 256, G, (int)blockIdx.x);
              S.pm_off = 0; S.wbase = Wt_gum + (size_t)(j2 * NE) * 2 * DFE * DM; S.wstride = (size_t)2 * DFE * DM; S.tbi = tbi;
              pg8::EpiSwiGLU E{HMID_M, DFE};
              pg8::gemm_phase<pg8::EpiSwiGLU, pg8::MoeOrder, PG8_ALIGN, PG8_SP2>(lds + RING_OFF, g, S, E); }
            PH_END
            for (int pass = 0; pass < 2; ++pass) {
                PH_BEGIN
                { moe_table(mcnt, tbi, wave, lane);
                  const int T0 = tbi[7], T = tbi[15];
                  pg8::Gemm g{HMID_M, Wt_dnm, MOE_ROWS, DM, DFE}; pg8::MoeOrder S; S.init_tiles(pass == 0 ? T0 : T - T0, DM / 256, G, (int)blockIdx.x);
                  S.pm_off = pass == 0 ? 0 : T0; S.wbase = Wt_dnm + (size_t)(j2 * NE) * DM * DFE; S.wstride = (size_t)DM * DFE; S.tbi = tbi;
                  pg8::EpiMoeDown E{xres, ROWTOK, ROWGATE, DM};
                  pg8::gemm_phase<pg8::EpiMoeDown, pg8::MoeOrder, PG8_ALIGN, PG8_SP2>(lds + RING_OFF, g, S, E); }
                PH_END
            }
        }
    }
#ifdef MK_DIAG
    PH_BEGIN
    if (blockIdx.x == 0) {
        unsigned* mcnt = ctl + CW_MOE + 64 * 16 * 1;
        moe_table(mcnt, tbi, wave, lane);
        const int T = tbi[15];
        float gs = 0.f, hs = 0.f;
        for (int r = tid; r < T * 256; r += NWAVES * 64) { if (ROWTOK[r] >= 0) { gs += ROWGATE[r]; float t = 0.f; for (int c = 0; c < 64; ++c) t += __builtin_fabsf(bf_lo((unsigned)HMID_M[(size_t)r * DFE + c * 22])); hs += t * (1.0f / 64.0f); } }
        gs = wave_sum(gs); hs = wave_sum(hs);
        LAS float* red = (LAS float*)(lds + 1024);
        if (lane == 0) { red[wave] = gs; red[8 + wave] = hs; }
        __syncthreads();
        if (tid == 0) { float tg = 0.f, th = 0.f; for (int w = 0; w < NWAVES; ++w) { tg += red[w]; th += red[8 + w]; }
            xres[0] = 10.0f + 1000.0f * th * (1.0f / 65536.0f);
            for (int i = 1; i <= 1000; ++i) xres[i] = tg * (256.0f / 32768.0f); }
    }
    PH_END
#endif
#undef PH_BEGIN
#undef PH_END
}

#ifdef MK_DIAG
constexpr int N_PHASES = 1 + 2 * (7 + 2) + 2 * (7 + 4) + 1;
#else
constexpr int N_PHASES = 1 + 2 * (7 + 2) + 2 * (7 + 4);
#endif
#ifndef MK_PHASES_PER_LAUNCH
#define MK_PHASES_PER_LAUNCH N_PHASES
#endif
extern "C" void kernel_launch(void* const* d_in, const int* in_sizes, int n_in, void* d_out, int out_size, void* d_ws, size_t ws_size, hipStream_t stream) {
    static int grid = 0;
    if (grid == 0) {
        if (n_in != 19 || in_sizes[0] != M * DM || out_size != M * DM || ws_size < WS_END) { fprintf(stderr, "kernel_launch: unexpected problem (n_in %d, in0 %d, out %d, ws %zu)\n", n_in, n_in > 0 ? in_sizes[0] : -1, out_size, ws_size); grid = -1; return; }
        int dev = 0, cus = 0, per_cu = 0;
        if (hipGetDevice(&dev) != hipSuccess || hipDeviceGetAttribute(&cus, hipDeviceAttributeMultiprocessorCount, dev) != hipSuccess) { grid = -1; return; }
        if (hipFuncSetAttribute((const void*)mega_fwd, hipFuncAttributeMaxDynamicSharedMemorySize, LDS_BYTES) != hipSuccess) { fprintf(stderr, "kernel_launch: hipFuncSetAttribute failed\n"); grid = -1; return; }
        if (hipOccupancyMaxActiveBlocksPerMultiprocessor(&per_cu, (const void*)mega_fwd, NWAVES * 64, LDS_BYTES) != hipSuccess || per_cu < 1) { fprintf(stderr, "kernel_launch: occupancy query says %d\n", per_cu); }
        (void)hipGetLastError();
        grid = cus;
    }
    if (grid < 0) return;
    if (hipMemsetAsync((char*)d_ws + WS_CTL, 0, CTL_ZERO_BYTES, stream) != hipSuccess) return;
    Args a{};
    for (int i = 0; i < 19; ++i) a.in[i] = d_in[i];
    a.out = (float*)d_out; a.ws = (unsigned char*)d_ws;
    int li = 0;
    for (int p = 0; p < N_PHASES; p += MK_PHASES_PER_LAUNCH, ++li) {
        a.li = li; a.ph_lo = p; a.ph_hi = (p + MK_PHASES_PER_LAUNCH < N_PHASES) ? p + MK_PHASES_PER_LAUNCH : N_PHASES;
        hipLaunchKernelGGL(mega_fwd, dim3(grid), dim3(NWAVES * 64), LDS_BYTES, stream, a);
        if (hipPeekAtLastError() != hipSuccess) { fprintf(stderr, "kernel_launch: launch failed at phase %d\n", p); break; }
    }
}
```

```cpp
#include <hip/hip_runtime.h>
#include <cstdio>
#include <cstdint>
namespace pg8 {
#define PG8_LAS __attribute__((address_space(3)))
typedef unsigned short bf16_t;
typedef short bf16x8 __attribute__((ext_vector_type(8)));
typedef float f32x4 __attribute__((ext_vector_type(4)));
typedef unsigned u32x4 __attribute__((ext_vector_type(4)));
typedef int i32x4 __attribute__((ext_vector_type(4)));
typedef int i32x8 __attribute__((ext_vector_type(8)));
template <bool I8> struct AccSel { typedef f32x4 T; }; template <> struct AccSel<true> { typedef i32x4 T; };
constexpr int BM = 256, BK = 64, HALF = 128, HTB = HALF * BK * 2  , STAGE_BYTES = 8 * HTB, NXCD = 8, WGM = 4;

__host__ __device__ __forceinline__ int lds_byte(int r, int c) { const int st = (r >> 4) * 2 + (c >> 5), rr = r & 15, cc = c & 31, ob = rr * 64 + cc * 2; return st * 1024 + (ob ^ (((ob >> 9) & 1) << 5)); }
__host__ __device__ __forceinline__ void stage_rc(int b, int& R, int& C) { const int st = b / 1024, sb = b % 1024, swz = sb ^ (((sb >> 9) & 1) << 5); R = (st >> 1) * 16 + swz / 64; C = (st & 1) * 32 + (swz % 64) / 2; }
__host__ __device__ __forceinline__ int perm32(int rho) { const int n = rho >> 4, i = rho & 15; return 8 * (i >> 2) + 4 * n + (i & 3); }

struct Unit { int pm, pn; };
struct Gemm { const void* A; const void* Bt; int M, N, K, rowbytes; };

struct StaticOrder {
    int nM, nN, nwg, G, c;
    __host__ __device__ void init(int M, int N, int G_, int c_) { nM = M / BM; nN = N / BM; nwg = nM * nN; G = G_; c = c_; }
    __host__ __device__ bool next(int i, Unit& u) const {
        const long L = (long)i * G + c; if (L >= nwg) return false;
        int wgid = (int)L; { const int q = nwg / NXCD, r = nwg % NXCD, xcd = wgid % NXCD, off = wgid / NXCD; wgid = (xcd < r ? xcd * (q + 1) : r * (q + 1) + (xcd - r) * q) + off; }
        const int nig = WGM * nN, gid = wgid / nig, fm = gid * WGM, gsz = (nM - fm) < WGM ? (nM - fm) : WGM;
        u.pm = fm + ((wgid % nig) % gsz); u.pn = (wgid % nig) / gsz; return true;
    }
    __device__ __forceinline__ void a_ready(const Unit&) const {}
    __device__ __forceinline__ void done(const Unit&) const {}
    __device__ __forceinline__ unsigned bt_off(const Unit&) const { return 0u; }
    const float* wsp;
    __device__ __forceinline__ const float* wsc(const Unit&) const { return wsp; }
};
struct MoeOrder : StaticOrder {
    int pm_off; unsigned wstride; const PG8_LAS int* tbi; size_t wsstride;
    __device__ void init_tiles(int nM_, int nN_, int G_, int c_) { nM = nM_; nN = nN_; nwg = nM * nN; G = G_; c = c_; }
    __device__ bool next(int i, Unit& u) const { if (!StaticOrder::next(i, u)) return false; u.pm += pm_off; return true; }
    __device__ __forceinline__ int expert(const Unit& u) const { int grp = 0;
#pragma unroll
        for (int j = 0; j < 16; ++j) grp += (tbi[j] <= u.pm) ? 1 : 0;
        return __builtin_amdgcn_readfirstlane(grp) & 7; }
    __device__ __forceinline__ unsigned bt_off(const Unit& u) const { return (unsigned)expert(u) * wstride; }
    __device__ __forceinline__ const float* wsc(const Unit& u) const { return wsp + (size_t)expert(u) * wsstride; }
};


__device__ __forceinline__ unsigned cvt_pk_bf16(float lo, float hi) { unsigned r; asm volatile("v_cvt_pk_bf16_f32 %0, %1, %2" : "=v"(r) : "v"(lo), "v"(hi)); return r; }

struct EpiBf16 {
    static constexpr bool PERM = true, AFTER_DRAIN = false, I8 = false, F8 = false, LDSX = false;
    bf16_t* O; int ldc;
    __device__ __forceinline__ void operator()(const f32x4 (&acc)[2][2][4][2], const Unit& u, int wr, int wc, int fr, int fq) const {
        const int row0 = u.pm * BM + wr * 64 + fr; const int col0 = u.pn * BM + wc * 32 + 8 * fq;
#pragma unroll
        for (int ai = 0; ai < 2; ++ai)
#pragma unroll
            for (int m = 0; m < 4; ++m) { bf16_t* rowp = O + (size_t)(row0 + ai * HALF + m * 16) * ldc + col0;
#pragma unroll
                for (int bj = 0; bj < 2; ++bj) { const f32x4 v0 = acc[ai][bj][m][0], v1 = acc[ai][bj][m][1];
                    u32x4 w; w.x = cvt_pk_bf16(v0[0], v0[1]); w.y = cvt_pk_bf16(v0[2], v0[3]); w.z = cvt_pk_bf16(v1[0], v1[1]); w.w = cvt_pk_bf16(v1[2], v1[3]);
                    *(u32x4*)(rowp + bj * HALF) = w; } }
    }
};
__device__ __forceinline__ float silu_mul(float g, float u) { const float e = __builtin_amdgcn_exp2f(-1.4426950408889634f * g); return g * __builtin_amdgcn_rcpf(1.0f + e) * u; }
struct EpiSwiGLU {
    static constexpr bool PERM = true, AFTER_DRAIN = false, I8 = false, F8 = false, LDSX = false;
    bf16_t* O; int ldc;
    __device__ __forceinline__ void operator()(const f32x4 (&acc)[2][2][4][2], const Unit& u, int wr, int wc, int fr, int fq) const {
        const int row0 = u.pm * BM + wr * 64 + fr; const int col0 = u.pn * HALF + wc * 32 + 8 * fq;
#pragma unroll
        for (int ai = 0; ai < 2; ++ai)
#pragma unroll
            for (int m = 0; m < 4; ++m) { bf16_t* rowp = O + (size_t)(row0 + ai * HALF + m * 16) * ldc + col0;
                const f32x4 g0 = acc[ai][0][m][0], g1 = acc[ai][0][m][1], u0 = acc[ai][1][m][0], u1 = acc[ai][1][m][1];
                u32x4 w; w.x = cvt_pk_bf16(silu_mul(g0[0], u0[0]), silu_mul(g0[1], u0[1])); w.y = cvt_pk_bf16(silu_mul(g0[2], u0[2]), silu_mul(g0[3], u0[3]));
                w.z = cvt_pk_bf16(silu_mul(g1[0], u1[0]), silu_mul(g1[1], u1[1])); w.w = cvt_pk_bf16(silu_mul(g1[2], u1[2]), silu_mul(g1[3], u1[3]));
                *(u32x4*)rowp = w; }
    }
};
struct EpiBf16Q {
    static constexpr bool PERM = true, AFTER_DRAIN = false, I8 = true, F8 = false, LDSX = false;
    bf16_t* O; int ldc; const float* sa;
    __device__ __forceinline__ void operator()(const i32x4 (&acc)[2][2][4][2], const Unit& u, int wr, int wc, int fr, int fq, const float* cm) const {
        const int row0 = u.pm * BM + wr * 64 + fr; const int col0 = u.pn * BM + wc * 32 + 8 * fq;
        f32x4 sw[2][2];
#pragma unroll
        for (int bj = 0; bj < 2; ++bj)
#pragma unroll
            for (int n = 0; n < 2; ++n) sw[bj][n] = *(const f32x4*)(cm + col0 + bj * HALF + 4 * n) * (1.0f / 127.0f);
#pragma unroll
        for (int ai = 0; ai < 2; ++ai)
#pragma unroll
            for (int m = 0; m < 4; ++m) { const int r = row0 + ai * HALF + m * 16; const float rs = sa[r]; bf16_t* rowp = O + (size_t)r * ldc + col0;
#pragma unroll
                for (int bj = 0; bj < 2; ++bj) { const f32x4 v0 = __builtin_convertvector(acc[ai][bj][m][0], f32x4) * sw[bj][0] * rs, v1 = __builtin_convertvector(acc[ai][bj][m][1], f32x4) * sw[bj][1] * rs;
                    u32x4 w; w.x = cvt_pk_bf16(v0[0], v0[1]); w.y = cvt_pk_bf16(v0[2], v0[3]); w.z = cvt_pk_bf16(v1[0], v1[1]); w.w = cvt_pk_bf16(v1[2], v1[3]);
                    *(u32x4*)(rowp + bj * HALF) = w; } }
    }
};
struct EpiQKV {
    static constexpr bool PERM = true, AFTER_DRAIN = false, I8 = true, F8 = false, LDSX = true;
    bf16_t* O; int ldc; const float* sa; const float* qn_sb; const float* kn_sb; const float* qn_dil; const float* kn_dil; const unsigned* rope_cs;
    __device__ __forceinline__ void operator()(i32x4 (&acc)[2][2][4][2], const Unit& u, int wr, int wc, int fr, int fq, const float* cm, PG8_LAS unsigned char* ptab, int ui) const {
        const int row0 = u.pm * BM + wr * 64 + fr; const int ccol0 = u.pn * BM + wc * 32 + 8 * fq;
        const int kind = (u.pn < 2) ? 0 : (u.pn < 4) ? 1 : (u.pn < 6) ? 4 : (u.pn < 8) ? 2 : (u.pn < 10) ? 3 : 4;
#pragma unroll
        for (int bj = 0; bj < 2; ++bj) { const f32x4 sw0 = *(const f32x4*)(cm + ccol0 + bj * HALF) * (1.0f / 127.0f), sw1 = *(const f32x4*)(cm + ccol0 + bj * HALF + 4) * (1.0f / 127.0f);
#pragma unroll
            for (int ai = 0; ai < 2; ++ai)
#pragma unroll
                for (int m = 0; m < 4; ++m) { const float rs = sa[row0 + ai * HALF + m * 16];
                    acc[ai][bj][m][0] = __builtin_bit_cast(i32x4, __builtin_convertvector(acc[ai][bj][m][0], f32x4) * sw0 * rs); acc[ai][bj][m][1] = __builtin_bit_cast(i32x4, __builtin_convertvector(acc[ai][bj][m][1], f32x4) * sw1 * rs); } }
        if (kind == 4) {
#pragma unroll
            for (int ai = 0; ai < 2; ++ai)
#pragma unroll
                for (int m = 0; m < 4; ++m)
#pragma unroll
                    for (int bj = 0; bj < 2; ++bj) { const f32x4 v0 = __builtin_bit_cast(f32x4, acc[ai][bj][m][0]), v1 = __builtin_bit_cast(f32x4, acc[ai][bj][m][1]);
                        u32x4 w; w.x = cvt_pk_bf16(v0[0], v0[1]); w.y = cvt_pk_bf16(v0[2], v0[3]); w.z = cvt_pk_bf16(v1[0], v1[1]); w.w = cvt_pk_bf16(v1[2], v1[3]);
                        *(u32x4*)(O + (size_t)(row0 + ai * HALF + m * 16) * ldc + ccol0 + bj * HALF) = w; }
            return;
        }
        PG8_LAS float* P = (PG8_LAS float*)(ptab + (ui & 1) * 8192);
        const int dlo = 16 * wc + 4 * fq;
        const float* gn = (kind == 0) ? qn_sb : (kind == 1) ? kn_sb : (kind == 2) ? qn_dil : kn_dil;
        const f32x4 g0 = *(const f32x4*)(gn + dlo), g1 = *(const f32x4*)(gn + 64 + dlo);
        u32x4 rp[2][4];
        if (kind >= 2) {
#pragma unroll
            for (int ai = 0; ai < 2; ++ai)
#pragma unroll
                for (int m = 0; m < 4; ++m) rp[ai][m] = *(const u32x4*)(rope_cs + (size_t)(row0 + ai * HALF + m * 16) * 64 + dlo);
        }
#pragma unroll
        for (int ai = 0; ai < 2; ++ai)
#pragma unroll
            for (int m = 0; m < 4; ++m)
#pragma unroll
                for (int bj = 0; bj < 2; ++bj) { const f32x4 v0 = __builtin_bit_cast(f32x4, acc[ai][bj][m][0]), v1 = __builtin_bit_cast(f32x4, acc[ai][bj][m][1]);
                    float q = (v0[0] * v0[0] + v0[1] * v0[1]) + (v0[2] * v0[2] + v0[3] * v0[3]) + (v1[0] * v1[0] + v1[1] * v1[1]) + (v1[2] * v1[2] + v1[3] * v1[3]);
                    { const unsigned own = __builtin_bit_cast(unsigned, q); const auto r = __builtin_amdgcn_permlane16_swap(own, own, false, false); q += __builtin_bit_cast(float, r[0] ^ r[1] ^ own); }
                    { const unsigned own = __builtin_bit_cast(unsigned, q); const auto r = __builtin_amdgcn_permlane32_swap(own, own, false, false); q += __builtin_bit_cast(float, r[0] ^ r[1] ^ own); }
                    if (fq == 0) P[((ai * HALF + wr * 64 + m * 16 + fr) * 2 + bj) * 4 + wc] = q; }
        asm volatile("s_waitcnt lgkmcnt(0)" ::: "memory"); __builtin_amdgcn_s_barrier(); asm volatile("" ::: "memory");
#pragma unroll
        for (int ai = 0; ai < 2; ++ai)
#pragma unroll
            for (int m = 0; m < 4; ++m) { const int rl = ai * HALF + wr * 64 + m * 16 + fr; const int row = u.pm * BM + rl;
                f32x4 cs = {1.f, 1.f, 1.f, 1.f}, sn = {0.f, 0.f, 0.f, 0.f};
                if (kind >= 2) { typedef _Float16 h2_t __attribute__((ext_vector_type(2))); const u32x4 rw = rp[ai][m];
#pragma unroll
                    for (int j = 0; j < 4; ++j) { const unsigned wj = rw[j]; const h2_t hv = __builtin_bit_cast(h2_t, wj); cs[j] = (float)hv.x; sn[j] = (float)hv.y; } }
#pragma unroll
                for (int bj = 0; bj < 2; ++bj) { const f32x4 p4 = *(const PG8_LAS f32x4*)(P + (rl * 2 + bj) * 4);
                    const float rstd = __builtin_amdgcn_rsqf(((p4[0] + p4[1]) + (p4[2] + p4[3])) * (1.0f / 128.0f) + 1e-6f);
                    f32x4 y0 = __builtin_bit_cast(f32x4, acc[ai][bj][m][0]) * rstd * g0, y1 = __builtin_bit_cast(f32x4, acc[ai][bj][m][1]) * rstd * g1;
                    if (kind >= 2) { const f32x4 t0 = y0 * cs - y1 * sn, t1 = y1 * cs + y0 * sn; y0 = t0; y1 = t1; }
                    typedef unsigned u32x2 __attribute__((ext_vector_type(2)));
                    bf16_t* hp = O + (size_t)row * ldc + u.pn * BM + bj * HALF + dlo;
                    u32x2 w0; w0.x = cvt_pk_bf16(y0[0], y0[1]); w0.y = cvt_pk_bf16(y0[2], y0[3]);
                    u32x2 w1; w1.x = cvt_pk_bf16(y1[0], y1[1]); w1.y = cvt_pk_bf16(y1[2], y1[3]);
                    asm volatile("s_nop 1" : "+v"(w0.x), "+v"(w0.y), "+v"(w1.x), "+v"(w1.y));
                    const auto r0 = __builtin_amdgcn_permlane16_swap(w0.x, w1.x, false, false); const auto r1 = __builtin_amdgcn_permlane16_swap(w0.y, w1.y, false, false);
                    u32x4 wq; wq.x = r0[0]; wq.y = r1[0]; wq.z = r0[1]; wq.w = r1[1];
                    *(u32x4*)(hp + ((fq & 1) ? 60 : 0)) = wq; } }
    }
};
struct EpiSwiGLUQ {
    static constexpr bool PERM = true, AFTER_DRAIN = false, I8 = true, F8 = false, LDSX = false;
    bf16_t* O; int ldc; const float* sa;
    __device__ __forceinline__ void operator()(const i32x4 (&acc)[2][2][4][2], const Unit& u, int wr, int wc, int fr, int fq, const float* cm) const {
        const int row0 = u.pm * BM + wr * 64 + fr; const int col0 = u.pn * HALF + wc * 32 + 8 * fq, ccol0 = u.pn * BM + wc * 32 + 8 * fq;
        f32x4 sw[2][2];
#pragma unroll
        for (int bj = 0; bj < 2; ++bj)
#pragma unroll
            for (int n = 0; n < 2; ++n) sw[bj][n] = *(const f32x4*)(cm + ccol0 + bj * HALF + 4 * n) * (1.0f / 127.0f);
#pragma unroll
        for (int ai = 0; ai < 2; ++ai)
#pragma unroll
            for (int m = 0; m < 4; ++m) { const int r = row0 + ai * HALF + m * 16; const float rs = sa[r]; bf16_t* rowp = O + (size_t)r * ldc + col0;
                const f32x4 g0 = __builtin_convertvector(acc[ai][0][m][0], f32x4) * sw[0][0] * rs, g1 = __builtin_convertvector(acc[ai][0][m][1], f32x4) * sw[0][1] * rs;
                const f32x4 u0 = __builtin_convertvector(acc[ai][1][m][0], f32x4) * sw[1][0] * rs, u1 = __builtin_convertvector(acc[ai][1][m][1], f32x4) * sw[1][1] * rs;
                u32x4 w; w.x = cvt_pk_bf16(silu_mul(g0[0], u0[0]), silu_mul(g0[1], u0[1])); w.y = cvt_pk_bf16(silu_mul(g0[2], u0[2]), silu_mul(g0[3], u0[3]));
                w.z = cvt_pk_bf16(silu_mul(g1[0], u1[0]), silu_mul(g1[1], u1[1])); w.w = cvt_pk_bf16(silu_mul(g1[2], u1[2]), silu_mul(g1[3], u1[3]));
                *(u32x4*)rowp = w; }
    }
};
__device__ __forceinline__ float clamp_f8(float v) { return __builtin_amdgcn_fmed3f(v, -448.0f, 448.0f); }
__device__ __forceinline__ unsigned pk_fp8x4(float a, float b, float c, float d) { int p = 0; p = __builtin_amdgcn_cvt_pk_fp8_f32(clamp_f8(a), clamp_f8(b), p, false); p = __builtin_amdgcn_cvt_pk_fp8_f32(clamp_f8(c), clamp_f8(d), p, true); return (unsigned)p; }
struct EpiSwiGLUQ8 {
    static constexpr bool PERM = true, AFTER_DRAIN = false, I8 = true, F8 = false, LDSX = false;
    unsigned char* O; int ldc; const float* sa;
    __device__ __forceinline__ void operator()(const i32x4 (&acc)[2][2][4][2], const Unit& u, int wr, int wc, int fr, int fq, const float* cm) const {
        const int row0 = u.pm * BM + wr * 64 + fr; const int col0 = u.pn * HALF + wc * 32 + 8 * fq, ccol0 = u.pn * BM + wc * 32 + 8 * fq;
        f32x4 sw[2][2];
#pragma unroll
        for (int bj = 0; bj < 2; ++bj)
#pragma unroll
            for (int n = 0; n < 2; ++n) sw[bj][n] = *(const f32x4*)(cm + ccol0 + bj * HALF + 4 * n) * (1.0f / 127.0f);
#pragma unroll
        for (int ai = 0; ai < 2; ++ai)
#pragma unroll
            for (int m = 0; m < 4; ++m) { const int r = row0 + ai * HALF + m * 16; const float rs = sa[r]; unsigned char* rowp = O + (size_t)r * ldc + col0;
                const f32x4 g0 = __builtin_convertvector(acc[ai][0][m][0], f32x4) * sw[0][0] * rs, g1 = __builtin_convertvector(acc[ai][0][m][1], f32x4) * sw[0][1] * rs;
                const f32x4 u0 = __builtin_convertvector(acc[ai][1][m][0], f32x4) * sw[1][0] * rs, u1 = __builtin_convertvector(acc[ai][1][m][1], f32x4) * sw[1][1] * rs;
                unsigned lo = pk_fp8x4(silu_mul(g0[0], u0[0]), silu_mul(g0[1], u0[1]), silu_mul(g0[2], u0[2]), silu_mul(g0[3], u0[3]));
                unsigned hi = pk_fp8x4(silu_mul(g1[0], u1[0]), silu_mul(g1[1], u1[1]), silu_mul(g1[2], u1[2]), silu_mul(g1[3], u1[3]));
                typedef unsigned u32x2 __attribute__((ext_vector_type(2))); u32x2 w; w.x = lo; w.y = hi; *(u32x2*)rowp = w; }
    }
};
constexpr float F8_WMAX = 224.0f;
__device__ __forceinline__ float bflo(unsigned w) { return __uint_as_float(w << 16); }
__device__ __forceinline__ float bfhi(unsigned w) { return __uint_as_float(w & 0xffff0000u); }
template <bool F8_> struct EpiResAddB {
    static constexpr bool PERM = true, AFTER_DRAIN = false, I8 = false, F8 = F8_, LDSX = false;
    const float* in32; bf16_t* xb; int ldc;
    __device__ __forceinline__ void operator()(const f32x4 (&acc)[2][2][4][2], const Unit& u, int wr, int wc, int fr, int fq, const float* cm = nullptr) const {
        const int col0 = u.pn * BM + wc * 32 + 8 * fq;
        f32x4 sw[2][2];
#pragma unroll
        for (int bj = 0; bj < 2; ++bj)
#pragma unroll
            for (int n = 0; n < 2; ++n) sw[bj][n] = F8_ ? *(const f32x4*)(cm + col0 + bj * HALF + 4 * n) * (1.0f / F8_WMAX) : (f32x4){1.f, 1.f, 1.f, 1.f};
#pragma unroll
        for (int ai = 0; ai < 2; ++ai) {
            const size_t off0 = (size_t)(u.pm * BM + ai * HALF + wr * 64 + fr) * ldc + col0;
            if (in32) {
#pragma unroll
                for (int m = 0; m < 4; ++m) { const size_t off = off0 + (size_t)(m * 16) * ldc;
#pragma unroll
                    for (int bj = 0; bj < 2; ++bj) { const f32x4 a0 = *(const f32x4*)(in32 + off + bj * HALF), a1 = *(const f32x4*)(in32 + off + bj * HALF + 4);
                        const f32x4 v0 = a0 + acc[ai][bj][m][0] * sw[bj][0], v1 = a1 + acc[ai][bj][m][1] * sw[bj][1];
                        u32x4 o; o.x = cvt_pk_bf16(v0[0], v0[1]); o.y = cvt_pk_bf16(v0[2], v0[3]); o.z = cvt_pk_bf16(v1[0], v1[1]); o.w = cvt_pk_bf16(v1[2], v1[3]);
                        *(u32x4*)(xb + off + bj * HALF) = o; }
                    if (m & 1) asm volatile("" ::: "memory"); }
            } else {
                u32x4 w[4][2];
#pragma unroll
                for (int m = 0; m < 4; ++m)
#pragma unroll
                    for (int bj = 0; bj < 2; ++bj) w[m][bj] = __builtin_nontemporal_load((const u32x4*)(xb + off0 + (size_t)(m * 16) * ldc + bj * HALF));
#pragma unroll
                for (int m = 0; m < 4; ++m)
#pragma unroll
                    for (int bj = 0; bj < 2; ++bj) { const u32x4 ww = w[m][bj];
                        const f32x4 a0 = (f32x4){bflo(ww.x), bfhi(ww.x), bflo(ww.y), bfhi(ww.y)}, a1 = (f32x4){bflo(ww.z), bfhi(ww.z), bflo(ww.w), bfhi(ww.w)};
                        const f32x4 v0 = a0 + acc[ai][bj][m][0] * sw[bj][0], v1 = a1 + acc[ai][bj][m][1] * sw[bj][1];
                        u32x4 o; o.x = cvt_pk_bf16(v0[0], v0[1]); o.y = cvt_pk_bf16(v0[2], v0[3]); o.z = cvt_pk_bf16(v1[0], v1[1]); o.w = cvt_pk_bf16(v1[2], v1[3]);
                        *(u32x4*)(xb + off0 + (size_t)(m * 16) * ldc + bj * HALF) = o; }
            }
            asm volatile("" ::: "memory");
        }
    }
};

struct EpiResAddQ {
    static constexpr bool PERM = true, AFTER_DRAIN = false, I8 = true, F8 = false, LDSX = false;
    const float* in32; bf16_t* xb; int ldc; const float* sa;
    __device__ __forceinline__ void operator()(const i32x4 (&acc)[2][2][4][2], const Unit& u, int wr, int wc, int fr, int fq, const float* cm) const {
        const int col0 = u.pn * BM + wc * 32 + 8 * fq;
        f32x4 sw[2][2];
#pragma unroll
        for (int bj = 0; bj < 2; ++bj)
#pragma unroll
            for (int n = 0; n < 2; ++n) sw[bj][n] = *(const f32x4*)(cm + col0 + bj * HALF + 4 * n) * (1.0f / 127.0f);
#pragma unroll
        for (int ai = 0; ai < 2; ++ai) {
            const int r0 = u.pm * BM + ai * HALF + wr * 64 + fr; const size_t off0 = (size_t)r0 * ldc + col0;
            float rs[4];
#pragma unroll
            for (int m = 0; m < 4; ++m) rs[m] = sa[r0 + m * 16];
            if (in32) {
#pragma unroll
                for (int m = 0; m < 4; ++m) { const size_t off = off0 + (size_t)(m * 16) * ldc;
#pragma unroll
                    for (int bj = 0; bj < 2; ++bj) { const f32x4 a0 = *(const f32x4*)(in32 + off + bj * HALF), a1 = *(const f32x4*)(in32 + off + bj * HALF + 4);
                        const f32x4 v0 = a0 + __builtin_convertvector(acc[ai][bj][m][0], f32x4) * (sw[bj][0] * rs[m]), v1 = a1 + __builtin_convertvector(acc[ai][bj][m][1], f32x4) * (sw[bj][1] * rs[m]);
                        u32x4 o; o.x = cvt_pk_bf16(v0[0], v0[1]); o.y = cvt_pk_bf16(v0[2], v0[3]); o.z = cvt_pk_bf16(v1[0], v1[1]); o.w = cvt_pk_bf16(v1[2], v1[3]);
                        *(u32x4*)(xb + off + bj * HALF) = o; }
                    if (m & 1) asm volatile("" ::: "memory"); }
            } else {
                u32x4 w[4][2];
#pragma unroll
                for (int m = 0; m < 4; ++m)
#pragma unroll
                    for (int bj = 0; bj < 2; ++bj) w[m][bj] = __builtin_nontemporal_load((const u32x4*)(xb + off0 + (size_t)(m * 16) * ldc + bj * HALF));
#pragma unroll
                for (int m = 0; m < 4; ++m)
#pragma unroll
                    for (int bj = 0; bj < 2; ++bj) { const u32x4 ww = w[m][bj];
                        const f32x4 a0 = (f32x4){bflo(ww.x), bfhi(ww.x), bflo(ww.y), bfhi(ww.y)}, a1 = (f32x4){bflo(ww.z), bfhi(ww.z), bflo(ww.w), bfhi(ww.w)};
                        const f32x4 v0 = a0 + __builtin_convertvector(acc[ai][bj][m][0], f32x4) * (sw[bj][0] * rs[m]), v1 = a1 + __builtin_convertvector(acc[ai][bj][m][1], f32x4) * (sw[bj][1] * rs[m]);
                        u32x4 o; o.x = cvt_pk_bf16(v0[0], v0[1]); o.y = cvt_pk_bf16(v0[2], v0[3]); o.z = cvt_pk_bf16(v1[0], v1[1]); o.w = cvt_pk_bf16(v1[2], v1[3]);
                        *(u32x4*)(xb + off0 + (size_t)(m * 16) * ldc + bj * HALF) = o; }
            }
            asm volatile("" ::: "memory");
        }
    }
};

template <int MODE> struct EpiMoeDownB {
    static constexpr bool PERM = true, AFTER_DRAIN = false, I8 = false, F8 = true, LDSX = false;
    bf16_t* xb; float* out32; const int* rowtok; const float* rowgate; int ldc;
    __device__ __forceinline__ void operator()(const f32x4 (&acc)[2][2][4][2], const Unit& u, int wr, int wc, int fr, int fq, const float* cm) const {
        const int col0 = u.pn * BM + wc * 32 + 8 * fq;
        f32x4 sw[2][2];
#pragma unroll
        for (int bj = 0; bj < 2; ++bj)
#pragma unroll
            for (int n = 0; n < 2; ++n) sw[bj][n] = *(const f32x4*)(cm + col0 + bj * HALF + 4 * n) * (1.0f / F8_WMAX);
        int tk[2][4]; float gg[2][4];
#pragma unroll
        for (int ai = 0; ai < 2; ++ai)
#pragma unroll
            for (int m = 0; m < 4; ++m) { const int r = u.pm * BM + ai * HALF + wr * 64 + m * 16 + fr; tk[ai][m] = rowtok[r]; gg[ai][m] = rowgate[r]; }
#pragma unroll
        for (int ai = 0; ai < 2; ++ai) {
            if (MODE == 2) {
#pragma unroll
                for (int m = 0; m < 4; ++m) { const int tok = tk[ai][m]; const float gt = gg[ai][m];
                    if (tok >= 0) { const size_t off = (size_t)tok * ldc + col0;
#pragma unroll
                        for (int bj = 0; bj < 2; ++bj) { const f32x4 a0 = *(const f32x4*)(out32 + off + bj * HALF), a1 = *(const f32x4*)(out32 + off + bj * HALF + 4);
                            const f32x4 v0 = a0 + acc[ai][bj][m][0] * (sw[bj][0] * gt), v1 = a1 + acc[ai][bj][m][1] * (sw[bj][1] * gt);
                            *(f32x4*)(out32 + off + bj * HALF) = v0; *(f32x4*)(out32 + off + bj * HALF + 4) = v1; } }
                    if (m & 1) asm volatile("" ::: "memory"); }
            } else {
                u32x4 w[4][2];
#pragma unroll
                for (int m = 0; m < 4; ++m) { const size_t off = (size_t)(tk[ai][m] < 0 ? 0 : tk[ai][m]) * ldc + col0;
#pragma unroll
                    for (int bj = 0; bj < 2; ++bj) w[m][bj] = __builtin_nontemporal_load((const u32x4*)(xb + off + bj * HALF)); }
#pragma unroll
                for (int m = 0; m < 4; ++m) { const int tok = tk[ai][m]; const float gt = gg[ai][m]; const size_t off = (size_t)(tok < 0 ? 0 : tok) * ldc + col0;
#pragma unroll
                    for (int bj = 0; bj < 2; ++bj) { const u32x4 ww = w[m][bj];
                        const f32x4 a0 = (f32x4){bflo(ww.x), bfhi(ww.x), bflo(ww.y), bfhi(ww.y)}, a1 = (f32x4){bflo(ww.z), bfhi(ww.z), bflo(ww.w), bfhi(ww.w)};
                        const f32x4 v0 = a0 + acc[ai][bj][m][0] * (sw[bj][0] * gt), v1 = a1 + acc[ai][bj][m][1] * (sw[bj][1] * gt);
                        if (tok >= 0) {
                            if (MODE == 0) { u32x4 o; o.x = cvt_pk_bf16(v0[0], v0[1]); o.y = cvt_pk_bf16(v0[2], v0[3]); o.z = cvt_pk_bf16(v1[0], v1[1]); o.w = cvt_pk_bf16(v1[2], v1[3]); *(u32x4*)(xb + off + bj * HALF) = o; }
                            else { *(f32x4*)(out32 + off + bj * HALF) = v0; *(f32x4*)(out32 + off + bj * HALF + 4) = v1; } } } }
            }
            asm volatile("" ::: "memory");
        }
    }
};

template <class Epi, class Sched, bool ALIGN_EPI = false, bool SP2 = false>
__device__ __forceinline__ void gemm_phase(PG8_LAS unsigned char* lds, const Gemm g, const Sched& S, const Epi& E, int tid_in) {
    int tid_ = tid_in; asm volatile("" : "+v"(tid_));
    const int tid = tid_, wid = __builtin_amdgcn_readfirstlane(tid >> 6), lane = tid & 63, wr = wid >> 2, wc = wid & 3, fr = lane & 15, fq = lane >> 4;
    const int RB = g.rowbytes, nt = RB / 128;
    typedef typename AccSel<Epi::I8>::T AccT;
    unsigned voffA[2], voffB[2];
#pragma unroll
    for (int i = 0; i < 2; ++i) { int R, C; stage_rc(tid * 16 + i * 8192, R, C); const int Rb = Epi::PERM ? ((R & ~31) + perm32(R & 31)) : R;
        voffA[i] = (unsigned)(R * RB + C * 2); voffB[i] = (unsigned)(Rb * RB + C * 2); }
    const unsigned kstep = 128u;
    const unsigned hstep = (unsigned)(HALF * RB);
    const unsigned tstep = 2u * hstep;
    const unsigned ldsw = (unsigned)wid * 1024u;
    const int aoff = lds_byte(wr * 64 + fr, fq * 8), boff = lds_byte(wc * 32 + fr, fq * 8);
#define PG8_SA(b, h) (((b) * 2 + (h)) * HTB)
#define PG8_SB(b, h) ((4 + (b) * 2 + (h)) * HTB)
    const __amdgpu_buffer_rsrc_t rsrcA = __builtin_amdgcn_make_buffer_rsrc((void*)g.A, (short)0, 0x7ffffff0, 0x00020000), rsrcB = __builtin_amdgcn_make_buffer_rsrc((void*)g.Bt, (short)0, 0x7ffffff0, 0x00020000);
#define PG8_STAGEX(bufoff, rs, goff, voff) do { _Pragma("unroll") for (int _i = 0; _i < 2; ++_i) \
        __builtin_amdgcn_raw_ptr_buffer_load_lds(rs, (PG8_LAS unsigned*)(lds + (bufoff) + ldsw + _i * 8192), 16, (voff)[_i], __builtin_amdgcn_readfirstlane((int)(goff)), 0, 0); } while (0)
#define PG8_STAGEA(bufoff, goff) PG8_STAGEX(bufoff, rsrcA, goff, voffA)
#define PG8_STAGEB(bufoff, goff) PG8_STAGEX(bufoff, rsrcB, goff, voffB)
#define PG8_LDA(dst, b, h) do { if constexpr (Epi::F8) { _Pragma("unroll") for (int m = 0; m < 4; ++m) dst##8[m] = __builtin_shufflevector(*(const PG8_LAS i32x4*)(lds + PG8_SA(b, h) + aoff + m * 2048), *(const PG8_LAS i32x4*)(lds + PG8_SA(b, h) + aoff + m * 2048 + 1024), 0, 1, 2, 3, 4, 5, 6, 7); } \
        else { _Pragma("unroll") for (int m = 0; m < 4; ++m) _Pragma("unroll") for (int k = 0; k < 2; ++k) dst[m][k] = *(const PG8_LAS bf16x8*)(lds + PG8_SA(b, h) + aoff + m * 2048 + k * 1024); } } while (0)
#define PG8_LDB(dst, b, h) do { if constexpr (Epi::F8) { _Pragma("unroll") for (int n = 0; n < 2; ++n) dst##8[n] = __builtin_shufflevector(*(const PG8_LAS i32x4*)(lds + PG8_SB(b, h) + boff + n * 2048), *(const PG8_LAS i32x4*)(lds + PG8_SB(b, h) + boff + n * 2048 + 1024), 0, 1, 2, 3, 4, 5, 6, 7); } \
        else { _Pragma("unroll") for (int n = 0; n < 2; ++n) _Pragma("unroll") for (int k = 0; k < 2; ++k) dst[n][k] = *(const PG8_LAS bf16x8*)(lds + PG8_SB(b, h) + boff + n * 2048 + k * 1024); } } while (0)
#define PG8_MMA(ai, bj, At, Bt) do { __builtin_amdgcn_s_setprio(1); _Pragma("unroll") for (int m = 0; m < 4; ++m) _Pragma("unroll") for (int n = 0; n < 2; ++n) _Pragma("unroll") for (int k = 0; k < 2; ++k) \
        { if constexpr (Epi::I8) acc[ai][bj][m][n] = __builtin_bit_cast(AccT, __builtin_amdgcn_mfma_i32_16x16x64_i8(__builtin_bit_cast(i32x4, Bt[n][k]), __builtin_bit_cast(i32x4, At[m][k]), __builtin_bit_cast(i32x4, acc[ai][bj][m][n]), 0, 0, 0)); \
          else if constexpr (Epi::F8) { if (k == 0) asm volatile("v_mfma_scale_f32_16x16x128_f8f6f4 %0, %1, %2, %0, %3, %3 op_sel_hi:[0,0,0]" : "+v"(acc[ai][bj][m][n]) : "v"(Bt##8[n]), "v"(At##8[m]), "v"(f8scale_)); } \
          else acc[ai][bj][m][n] = __builtin_bit_cast(AccT, __builtin_amdgcn_mfma_f32_16x16x32_bf16(Bt[n][k], At[m][k], __builtin_bit_cast(f32x4, acc[ai][bj][m][n]), 0, 0, 0)); } __builtin_amdgcn_s_setprio(0); } while (0)
#define PG8_WAIT_V(n) asm volatile("s_waitcnt vmcnt(" #n ")" ::: "memory")
#define PG8_WAIT_L(n) asm volatile("s_waitcnt lgkmcnt(" #n ")" ::: "memory")
#define PG8_BAR __builtin_amdgcn_s_barrier()
#define PG8_SCHED __builtin_amdgcn_sched_barrier(0)
    Unit cur, nxt; int ui = 0;
    if (!S.next(0, cur)) return;
    AccT acc[2][2][4][2];
    { int zi_ = 0; asm volatile("" : "+v"(zi_));
#pragma unroll
    for (int a = 0; a < 2; ++a)
#pragma unroll
        for (int b = 0; b < 2; ++b)
#pragma unroll
            for (int m = 0; m < 4; ++m)
#pragma unroll
                for (int n = 0; n < 2; ++n) acc[a][b][m][n] = __builtin_bit_cast(AccT, (i32x4){zi_, zi_, zi_, zi_}); }
    const int f8scale_ = 0x7f7f7f7f; (void)f8scale_;
    bf16x8 At[4][2], B0[2][2], B1[2][2]; i32x8 At8[4], B08[2], B18[2];
    unsigned cA = (unsigned)cur.pm * tstep, cB = S.bt_off(cur) + (unsigned)cur.pn * tstep;
    S.a_ready(cur);
    if constexpr (SP2) {
        PG8_STAGEB(PG8_SB(0, 0), cB); PG8_STAGEB(PG8_SB(0, 1), cB + hstep); PG8_STAGEA(PG8_SA(0, 0), cA); PG8_STAGEA(PG8_SA(0, 1), cA + hstep);
        if (wr == 1) PG8_BAR;
        PG8_WAIT_V(2); PG8_BAR;
        PG8_STAGEB(PG8_SB(1, 0), cB + kstep); PG8_STAGEA(PG8_SA(1, 0), cA + kstep); PG8_STAGEB(PG8_SB(1, 1), cB + hstep + kstep);
        PG8_WAIT_V(6); PG8_BAR;
    } else {
        PG8_STAGEB(PG8_SB(0, 0), cB); PG8_STAGEA(PG8_SA(0, 0), cA); PG8_STAGEB(PG8_SB(0, 1), cB + hstep); PG8_STAGEA(PG8_SA(0, 1), cA + hstep);
        if (wr == 1) PG8_BAR;
        PG8_WAIT_V(4); PG8_BAR;
        PG8_STAGEB(PG8_SB(1, 0), cB + kstep); PG8_STAGEA(PG8_SA(1, 0), cA + kstep); PG8_STAGEB(PG8_SB(1, 1), cB + hstep + kstep);
        PG8_WAIT_V(6); PG8_BAR;
    }
    for (;;) {
        const bool has_next = S.next(ui + 1, nxt);
        const unsigned nA = has_next ? (unsigned)nxt.pm * tstep : cA, nB = has_next ? S.bt_off(nxt) + (unsigned)nxt.pn * tstep : cB;
        for (int t = 0; t < nt; t += 2) {
            const bool last = (t == nt - 2);
            const unsigned a1 = cA + (unsigned)(t + 1) * kstep;
            const unsigned a2 = last ? nA : cA + (unsigned)(t + 2) * kstep, b2 = last ? nB : cB + (unsigned)(t + 2) * kstep;
            const unsigned a3 = a2 + kstep, b3 = b2 + kstep;
            if (last && has_next) S.a_ready(nxt);
            if constexpr (SP2) {
            PG8_LDB(B0, 0, 0); PG8_LDB(B1, 0, 1); PG8_SCHED; PG8_LDA(At, 0, 0); PG8_STAGEA(PG8_SA(1, 1), a1 + hstep);
            PG8_WAIT_V(8); PG8_WAIT_L(0); PG8_BAR; PG8_MMA(0, 0, At, B0); PG8_MMA(0, 1, At, B1); PG8_BAR; PG8_SCHED;
            PG8_LDA(At, 0, 1); PG8_STAGEB(PG8_SB(0, 0), b2); PG8_STAGEB(PG8_SB(0, 1), b2 + hstep); PG8_STAGEA(PG8_SA(0, 0), a2);
            PG8_WAIT_V(8); PG8_WAIT_L(0); PG8_BAR; PG8_MMA(1, 0, At, B0); PG8_MMA(1, 1, At, B1); PG8_BAR; PG8_SCHED;
            PG8_LDB(B0, 1, 0); PG8_LDB(B1, 1, 1); PG8_SCHED; PG8_LDA(At, 1, 0); PG8_STAGEA(PG8_SA(0, 1), a2 + hstep);
            PG8_WAIT_V(8); PG8_WAIT_L(0); PG8_BAR; PG8_MMA(0, 0, At, B0); PG8_MMA(0, 1, At, B1); PG8_BAR; PG8_SCHED;
            PG8_LDA(At, 1, 1); PG8_STAGEB(PG8_SB(1, 0), b3); PG8_STAGEB(PG8_SB(1, 1), b3 + hstep); PG8_STAGEA(PG8_SA(1, 0), a3);
            PG8_WAIT_V(8); PG8_WAIT_L(0); PG8_BAR; PG8_MMA(1, 0, At, B0); PG8_MMA(1, 1, At, B1); PG8_BAR; PG8_SCHED;
            } else {
            PG8_LDB(B0, 0, 0); PG8_SCHED; PG8_LDA(At, 0, 0); PG8_STAGEA(PG8_SA(1, 1), a1 + hstep);
            PG8_WAIT_L(8); PG8_BAR; PG8_WAIT_L(0); PG8_MMA(0, 0, At, B0); PG8_BAR; PG8_SCHED;
            PG8_LDB(B1, 0, 1); PG8_STAGEB(PG8_SB(0, 0), b2);
            PG8_BAR; PG8_WAIT_L(0); PG8_MMA(0, 1, At, B1); PG8_BAR;
            PG8_LDA(At, 0, 1); PG8_STAGEA(PG8_SA(0, 0), a2);
            PG8_BAR; PG8_WAIT_L(0); PG8_MMA(1, 0, At, B0); PG8_BAR; PG8_SCHED;
            PG8_STAGEB(PG8_SB(0, 1), b2 + hstep);
            PG8_WAIT_V(6); PG8_BAR; PG8_MMA(1, 1, At, B1); PG8_BAR;
            PG8_LDB(B0, 1, 0); PG8_SCHED; PG8_LDA(At, 1, 0); PG8_STAGEA(PG8_SA(0, 1), a2 + hstep);
            PG8_WAIT_L(8); PG8_BAR; PG8_WAIT_L(0); PG8_MMA(0, 0, At, B0); PG8_BAR; PG8_SCHED;
            PG8_LDB(B1, 1, 1); PG8_STAGEB(PG8_SB(1, 0), b3);
            PG8_BAR; PG8_WAIT_L(0); PG8_MMA(0, 1, At, B1); PG8_BAR;
            PG8_LDA(At, 1, 1); PG8_STAGEA(PG8_SA(1, 0), a3);
            PG8_BAR; PG8_WAIT_L(0); PG8_MMA(1, 0, At, B0); PG8_BAR; PG8_SCHED;
            PG8_STAGEB(PG8_SB(1, 1), b3 + hstep);
            PG8_WAIT_V(6); PG8_BAR; PG8_MMA(1, 1, At, B1); PG8_BAR;
            }
        }
        if constexpr (ALIGN_EPI) { if (wr == 0) PG8_BAR; }
        if constexpr (Epi::F8) asm volatile("s_nop 15\n\ts_nop 15" ::: "memory");
        if constexpr (!Epi::AFTER_DRAIN) { if constexpr (Epi::LDSX) E(acc, cur, wr, wc, fr, fq, S.wsc(cur), lds + 131072 + 4096, ui); else if constexpr (Epi::I8 || Epi::F8) E(acc, cur, wr, wc, fr, fq, S.wsc(cur)); else E(acc, cur, wr, wc, fr, fq); S.done(cur); }
        if (!has_next) break;
        { int zi_ = 0; asm volatile("" : "+v"(zi_));
#pragma unroll
        for (int a = 0; a < 2; ++a)
#pragma unroll
            for (int b = 0; b < 2; ++b)
#pragma unroll
                for (int m = 0; m < 4; ++m)
#pragma unroll
                    for (int n = 0; n < 2; ++n) acc[a][b][m][n] = __builtin_bit_cast(AccT, (i32x4){zi_, zi_, zi_, zi_}); }
        cur = nxt; cA = nA; cB = nB; ++ui;
        if constexpr (ALIGN_EPI) { if (wr == 1) PG8_BAR; }
    }
    PG8_WAIT_V(0);
    if constexpr (!ALIGN_EPI) { if (wr == 0) PG8_BAR; }
    PG8_BAR;
    if constexpr (Epi::AFTER_DRAIN) { E.fused(acc, cur, wr, wc, fr, fq, lds, wid, lane); S.done(cur); }
#undef PG8_SA
#undef PG8_SB
#undef PG8_STAGEX
#undef PG8_STAGEA
#undef PG8_STAGEB
#undef PG8_LDA
#undef PG8_LDB
#undef PG8_MMA
#undef PG8_WAIT_V
#undef PG8_WAIT_L
#undef PG8_BAR
#undef PG8_SCHED
}
}

#ifndef PG8_SP2
#define PG8_SP2 true
#endif
#ifndef PG8_ALIGN
#define PG8_ALIGN true
#endif

constexpr int NB = 4, SEQ = 8192, DM = 2048, DEPTH = 4, HD = 128, DSB = 512, DMIX = 1024, DIN = 3072, DFF = 5632, DFE = 1408, NE = 8;
constexpr int M = NB * SEQ;
constexpr float EPS = 1e-6f;
constexpr int NWAVES = 8;
constexpr int C_QSB = 0, C_KSB = 512, C_VSB = 1024, C_QDIL = 1536, C_KDIL = 2048, C_VDIL = 2560;

constexpr size_t MiB = 1u << 20;
constexpr size_t WS_CTL = 0, CTL_ZERO_BYTES = 1 * MiB;
constexpr size_t WS_WIN = 1 * MiB;
constexpr size_t WS_WOUT = 49 * MiB;
constexpr size_t WS_WGU_D = 65 * MiB;
constexpr size_t WS_WDN_D = 153 * MiB;
constexpr size_t WS_WGU_M = 197 * MiB;
constexpr size_t WS_WDN_M = 373 * MiB;
constexpr size_t WS_ROPE = 461 * MiB;
constexpr size_t WS_XN = 477 * MiB;
constexpr size_t WS_XB = 541 * MiB;
constexpr size_t WS_MAP = 669 * MiB;
constexpr size_t WS_LSE = 670 * MiB;
constexpr size_t WS_ROWTOK = 672 * MiB;
constexpr size_t WS_BIG = 673 * MiB;
constexpr size_t WS_H = WS_BIG, WS_OSB = WS_BIG + 192 * MiB, WS_ODIL = WS_BIG + 256 * MiB, WS_HMID = WS_BIG;
constexpr size_t WS_ATT = WS_BIG;
constexpr size_t WS_XG = WS_BIG;
constexpr size_t WS_HMID_M = WS_BIG + 136 * MiB;
constexpr int DFEP = 1536;
constexpr int MOE_ROWS = 65536 + 16 * 256;
constexpr size_t WS_END = 1025 * MiB;
static_assert((size_t)(3 * MOE_ROWS + M) * 4 <= MiB, "row tables");
static_assert(WS_WIN + (size_t)4 * 3072 * 2048 * 2 <= WS_WOUT && WS_WOUT + (size_t)4 * 2048 * 1024 * 2 <= WS_WGU_D && WS_WGU_D + (size_t)2 * 11264 * 2048 * 2 <= WS_WDN_D &&
              WS_WDN_D + (size_t)2 * 2048 * 5632 * 2 <= WS_WGU_M && WS_WGU_M + (size_t)16 * 2816 * 2048 * 2 <= WS_WDN_M && WS_WDN_M + (size_t)16 * 2048 * 1408 * 2 <= WS_ROPE &&
              WS_ROPE + (size_t)2 * M * 64 * 4 <= WS_XN && WS_XN + (size_t)M * DM <= WS_XB && WS_XB + (size_t)M * DM * 2 <= WS_MAP && WS_MAP + (size_t)M * 2 * 16 <= WS_LSE &&
              WS_LSE + (size_t)3 * M * 4 * 4 <= WS_ROWTOK && WS_ROWTOK + MiB <= WS_BIG && WS_XG + (size_t)MOE_ROWS * DM <= WS_HMID_M && WS_HMID_M + (size_t)MOE_ROWS * DFEP <= WS_END && WS_ATT + (size_t)M * DMIX * 2 <= WS_OSB &&
              WS_BIG + (size_t)M * DFF * 2 <= WS_END && WS_ODIL + (size_t)3 * M * 512 * 2 <= WS_END, "d_ws map");
constexpr int CW_MOE = 1024;
constexpr int CW_ATTQ = 3200;
constexpr int CW_BAR = 4096;
constexpr int CW_CMAX_IN = 8192, CW_CMAX_GUD = CW_CMAX_IN + 4 * 3072, CW_CMAX_GUM = CW_CMAX_GUD + 2 * 11264, CW_CMAX_DND = CW_CMAX_GUM + 16 * 2816, CW_CMAX_DNM = CW_CMAX_DND + 2 * 2048, CW_CMAX_OUT = CW_CMAX_DNM + 16 * 2048, CW_CMAX_END = CW_CMAX_OUT + 4 * 2048;
static_assert(CW_CMAX_END * 4 <= (int)CTL_ZERO_BYTES, "control words");

constexpr int RING_OFF = 0, RING_BYTES = 131072;
constexpr int LDSCTL_OFF = RING_BYTES, MISC_OFF = LDSCTL_OFF + 320;
constexpr int LDS_BYTES = 151552;
constexpr int PTAB_OFF = LDSCTL_OFF + 4096;

#define GAS __attribute__((address_space(1)))
#define LAS __attribute__((address_space(3)))
typedef unsigned short bf16;
typedef unsigned v4u __attribute__((ext_vector_type(4)));
typedef unsigned v2u __attribute__((ext_vector_type(2)));
typedef float f32x4 __attribute__((ext_vector_type(4)));
typedef float f32x16 __attribute__((ext_vector_type(16)));
typedef short bf16x8 __attribute__((ext_vector_type(8)));
typedef short s16x4 __attribute__((ext_vector_type(4)));
#define LDS_WAIT() asm volatile("s_waitcnt lgkmcnt(0)" ::: "memory")
#define VM_WAIT() asm volatile("s_waitcnt vmcnt(0)" ::: "memory")
__device__ __forceinline__ unsigned f2bf(float f) { unsigned u = __builtin_bit_cast(unsigned, f); return (u + 0x7fffu + ((u >> 16) & 1u)) >> 16; }
__device__ __forceinline__ unsigned pk2(float lo, float hi) { unsigned r; asm("v_cvt_pk_bf16_f32 %0, %1, %2" : "=v"(r) : "v"(lo), "v"(hi)); return r; }
__device__ __forceinline__ float bf_lo(unsigned w) { return __builtin_bit_cast(float, w << 16); }
__device__ __forceinline__ float bf_hi(unsigned w) { return __builtin_bit_cast(float, w & 0xffff0000u); }

#define XB_TMO      128
#define XB_XCNT(j)  (256  + 64 * (j))
#define XB_XSUB(j)  (1280 + 64 * (j))
#define XB_XGEN(j)  (2304 + 64 * (j))
#define XB_TOP      3328
#define XB_TOPGEN   3392
#define XCD_BAR_WORDS 3456
#define XB_SPIN_CAP (1u << 18)

__device__ __forceinline__ unsigned xb_ld(unsigned* p)              { return __hip_atomic_load(p, __ATOMIC_RELAXED, __HIP_MEMORY_SCOPE_AGENT); }
__device__ __forceinline__ unsigned xb_add(unsigned* p, unsigned v) { return __hip_atomic_fetch_add(p, v, __ATOMIC_RELAXED, __HIP_MEMORY_SCOPE_AGENT); }
__device__ __forceinline__ unsigned xb_xcc_id() { return (unsigned)__builtin_amdgcn_s_getreg((3 << 11) | 20) & 0xFu; }
#define XB_SPIN(cond, bar) do { unsigned _sp = 0; while (cond) { __builtin_amdgcn_s_sleep(1); \
    if ((++_sp & 255u) == 0u) { if (xb_ld(&(bar)[XB_TMO])) break; if (_sp > XB_SPIN_CAP) { atomicAdd(&(bar)[XB_TMO], 1u); break; } } } } while (0)

struct XcdBarrier {
    unsigned* bar; unsigned x;
    volatile LAS unsigned* st;
};
__device__ __forceinline__ XcdBarrier xcd_barrier_post(unsigned* bar, volatile LAS unsigned* st, int tid) {
    XcdBarrier b; b.bar = bar; b.x = xb_xcc_id(); b.st = st;
    if (tid == 0) (void)xb_add(&bar[XB_XCNT(b.x)], 1u);
    return b;
}
__device__ __forceinline__ void xcd_barrier_complete(unsigned* bar, unsigned x, unsigned& nloc, unsigned& nx) {
    const unsigned G = gridDim.x * gridDim.y * gridDim.z;
    unsigned sum, cnt, mine, sp = 0u;
    for (;;) {
        sum = 0u; cnt = 0u; mine = 0u;
#pragma unroll
        for (unsigned j = 0; j < 16; ++j) { const unsigned c = xb_ld(&bar[XB_XCNT(j)]); sum += c; cnt += (c > 0u) ? 1u : 0u; mine = (j == x) ? c : mine; }
        if (sum == G) break;
        __builtin_amdgcn_s_sleep(1);
        if ((++sp & 255u) == 0u) { if (xb_ld(&bar[XB_TMO])) break; if (sp > XB_SPIN_CAP) { atomicAdd(&bar[XB_TMO], 1u); break; } }
    }
    nloc = mine > 0u ? mine : 1u; nx = cnt > 0u ? cnt : 1u;
}
__device__ __forceinline__ void xcd_barrier(const XcdBarrier& b, int tid) {
    asm volatile("s_waitcnt vmcnt(0)" ::: "memory");
    __syncthreads();
    if (tid == 0) {
        unsigned* bar = b.bar;
        __builtin_amdgcn_s_waitcnt(0);
        unsigned nloc = b.st[0], nx = b.st[1];
        if (nloc == 0u) { xcd_barrier_complete(bar, b.x, nloc, nx); b.st[0] = nloc; b.st[1] = nx; }
        const unsigned old = xb_add(&bar[XB_XSUB(b.x)], 1u);
        const unsigned gen = old / nloc;
        if (old + 1u == (gen + 1u) * nloc) {
            __builtin_amdgcn_fence(__ATOMIC_RELEASE, "agent");
            asm volatile("s_waitcnt vmcnt(0)" ::: "memory");
            const unsigned og = xb_add(&bar[XB_TOP], 1u);
            const unsigned tg = og / nx;
            if (og + 1u == (tg + 1u) * nx) xb_add(&bar[XB_TOPGEN], 1u);
            else XB_SPIN(xb_ld(&bar[XB_TOPGEN]) == tg, bar);
            __builtin_amdgcn_fence(__ATOMIC_ACQUIRE, "agent");
            xb_add(&bar[XB_XGEN(b.x)], 1u);
            asm volatile("s_waitcnt vmcnt(0)" ::: "memory");
        } else {
            XB_SPIN(xb_ld(&bar[XB_XGEN(b.x)]) == gen, bar);
            __builtin_amdgcn_fence(__ATOMIC_ACQUIRE, "agent");
            asm volatile("s_waitcnt vmcnt(0)" ::: "memory");
        }
    }
    __syncthreads();
}

__device__ __forceinline__ float shx(float v, int m, int lane) { return __int_as_float(__builtin_amdgcn_ds_bpermute((lane ^ m) << 2, __float_as_int(v))); }
__device__ __forceinline__ int shi(int v, int src) { return __builtin_amdgcn_ds_bpermute(src << 2, v); }
__device__ __forceinline__ float wave_sum(float v, int lane) {
#pragma unroll
    for (int o = 1; o < 64; o <<= 1) v += shx(v, o, lane);
    return v;
}
__device__ const float ROPE_INV[64] = {
    1.0f, 0.8659643233600653f, 0.7498942093324559f, 0.6493816315762113f, 0.5623413251903491f, 0.4869675251658631f, 0.4216965034285822f, 0.3651741272548377f,
    0.31622776601683794f, 0.27384196342643613f, 0.23713737056616552f, 0.2053525026457146f, 0.1778279410038923f, 0.1539926526059492f, 0.1333521432163324f, 0.11547819846894582f,
    0.1f, 0.08659643233600653f, 0.07498942093324558f, 0.06493816315762113f, 0.05623413251903491f, 0.04869675251658631f, 0.042169650342858224f, 0.03651741272548377f,
    0.03162277660168379f, 0.027384196342643614f, 0.023713737056616554f, 0.02053525026457146f, 0.01778279410038923f, 0.01539926526059492f, 0.01333521432163324f, 0.011547819846894581f,
    0.01f, 0.008659643233600654f, 0.007498942093324558f, 0.006493816315762113f, 0.005623413251903491f, 0.004869675251658631f, 0.004216965034285823f, 0.003651741272548377f,
    0.0031622776601683794f, 0.0027384196342643613f, 0.0023713737056616554f, 0.002053525026457146f, 0.0017782794100389228f, 0.001539926526059492f, 0.001333521432163324f, 0.0011547819846894581f,
    0.001f, 0.0008659643233600654f, 0.0007498942093324559f, 0.0006493816315762113f, 0.0005623413251903491f, 0.0004869675251658631f, 0.00042169650342858224f, 0.0003651741272548377f,
    0.00031622776601683794f, 0.0002738419634264361f, 0.00023713737056616554f, 0.0002053525026457146f, 0.00017782794100389227f, 0.0001539926526059492f, 0.0001333521432163324f, 0.00011547819846894582f };
__device__ __forceinline__ void sincos_d(double a, float& sn, float& cs) {
    const double k = __builtin_rint(a * 0.15915494309189535);
    double r = __builtin_fma(-k, 6.283185307179586, a); r = __builtin_fma(-k, 2.4492935982947064e-16, r);
    const double r2 = r * r;
    double s = -9.18368986379554601e-29;
    s = s * r2 + 6.44695028438447359e-26; s = s * r2 + -3.86817017063068413e-23; s = s * r2 + 1.95729410633912626e-20; s = s * r2 + -8.22063524662432950e-18;
    s = s * r2 + 2.81145725434552060e-15; s = s * r2 + -7.64716373181981641e-13; s = s * r2 + 1.60590438368216133e-10; s = s * r2 + -2.50521083854417202e-08;
    s = s * r2 + 2.75573192239858925e-06; s = s * r2 + -1.98412698412698413e-04; s = s * r2 + 8.33333333333333322e-03; s = s * r2 + -1.66666666666666657e-01; s = s * r2 + 1.0;
    double c = 3.27988923706983776e-30;
    c = c * r2 + -2.47959626322479759e-27; c = c * r2 + 1.61173757109611839e-24; c = c * r2 + -8.89679139245057408e-22; c = c * r2 + 4.11031762331216484e-19;
    c = c * r2 + -1.56192069685862253e-16; c = c * r2 + 4.77947733238738525e-14; c = c * r2 + -1.14707455977297245e-11; c = c * r2 + 2.08767569878681002e-09;
    c = c * r2 + -2.75573192239858883e-07; c = c * r2 + 2.48015873015873016e-05; c = c * r2 + -1.38888888888888894e-03; c = c * r2 + 4.16666666666666644e-02; c = c * r2 + -0.5; c = c * r2 + 1.0;
    sn = (float)(s * r); cs = (float)c;
}

__device__ __forceinline__ int drow_of(int nn, int mode) {
    if (mode == 3) { const bool qk = (nn < 1024) || (nn >= 1536 && nn < 2560); const int d = nn & 127; return qk ? (nn & ~127) + 32 * ((d >> 4) & 3) + 8 * ((d >> 2) & 3) + 4 * (d >> 6) + (d & 3) : nn; }
    return (mode == 0) ? nn : ((nn >> 7) * 256 + (mode == 2 ? 128 : 0) + (nn & 127)); }
struct WItem { const float* W; int K, N, k0, n0, mode, fmt, Kd, nd, cw, l; size_t dst_off; };
constexpr int WI_IN = 4 * (DM / 64) * (DIN / 32), WI_OUT = 4 * (DMIX / 64) * (DM / 32), WI_GD = 2 * (DM / 64) * (DFF / 32), WI_DD = 2 * (DFF / 64) * (DM / 32);
constexpr int WI_GM = 16 * (DM / 64) * (DFE / 32), WI_DM = 16 * (DFE / 64) * (DM / 32);
constexpr int WI_TOTAL = WI_IN + WI_OUT + 2 * WI_GD + WI_DD + 2 * WI_GM + WI_DM;
__device__ __forceinline__ void resolve_item(const void* const* in, int it, WItem& w) {
    int r = it, idx, L, K, N, mode, fmt, Kd, nd, cw; size_t off;
    if (r < WI_IN) { idx = 3; L = 4; K = DM; N = DIN; mode = 3; fmt = 0; Kd = DM; nd = DIN; cw = CW_CMAX_IN; off = WS_WIN; }
    else if ((r -= WI_IN) < WI_OUT) { idx = 10; L = 4; K = DMIX; N = DM; mode = 0; fmt = 0; Kd = DMIX; nd = DM; cw = CW_CMAX_OUT; off = WS_WOUT; }
    else if ((r -= WI_OUT) < WI_GD) { idx = 12; L = 2; K = DM; N = DFF; mode = 1; fmt = 0; Kd = DM; nd = 2 * DFF; cw = CW_CMAX_GUD; off = WS_WGU_D; }
    else if ((r -= WI_GD) < WI_GD) { idx = 13; L = 2; K = DM; N = DFF; mode = 2; fmt = 0; Kd = DM; nd = 2 * DFF; cw = CW_CMAX_GUD; off = WS_WGU_D; }
    else if ((r -= WI_GD) < WI_DD) { idx = 14; L = 2; K = DFF; N = DM; mode = 0; fmt = 1; Kd = DFF; nd = DM; cw = CW_CMAX_DND; off = WS_WDN_D; }
    else if ((r -= WI_DD) < WI_GM) { idx = 16; L = 16; K = DM; N = DFE; mode = 1; fmt = 0; Kd = DM; nd = 2 * DFE; cw = CW_CMAX_GUM; off = WS_WGU_M; }
    else if ((r -= WI_GM) < WI_GM) { idx = 17; L = 16; K = DM; N = DFE; mode = 2; fmt = 0; Kd = DM; nd = 2 * DFE; cw = CW_CMAX_GUM; off = WS_WGU_M; }
    else { r -= WI_GM; idx = 18; L = 16; K = DFE; N = DM; mode = 0; fmt = 1; Kd = DFEP; nd = DM; cw = CW_CMAX_DNM; off = WS_WDN_M; }
    (void)L;
    const int per = (K / 64) * (N / 32), l = r / per, q = r % per, nblk = N / 32;
    w.W = (const float*)in[idx] + (size_t)l * K * N; w.K = K; w.N = N; w.k0 = 64 * (q / nblk); w.n0 = 32 * (q % nblk); w.mode = mode; w.fmt = fmt; w.Kd = Kd; w.nd = nd; w.cw = cw; w.l = l; w.dst_off = off;
}
__device__ __forceinline__ void load_item(const WItem& w, f32x4 (&d)[8], int lane) {
    GAS const float* p = (GAS const float*)(w.W + (size_t)(w.k0 + (lane >> 3)) * w.N + w.n0 + 4 * (lane & 7));
#pragma unroll
    for (int j = 0; j < 8; ++j) d[j] = __builtin_nontemporal_load((GAS const f32x4*)(p + (size_t)(8 * j) * w.N));
}
__device__ __forceinline__ void colmax_item(const WItem& w, const f32x4 (&d)[8], unsigned* ctl, int lane) {
    f32x4 m = {0.f, 0.f, 0.f, 0.f};
#pragma unroll
    for (int j = 0; j < 8; ++j)
#pragma unroll
        for (int t = 0; t < 4; ++t) m[t] = __builtin_fmaxf(m[t], __builtin_fabsf(d[j][t]));
#pragma unroll
    for (int t = 0; t < 4; ++t) { m[t] = __builtin_fmaxf(m[t], shx(m[t], 8, lane)); m[t] = __builtin_fmaxf(m[t], shx(m[t], 16, lane)); m[t] = __builtin_fmaxf(m[t], shx(m[t], 32, lane)); }
    if (lane < 8) { unsigned* cm = ctl + w.cw + (size_t)w.l * w.nd;
#pragma unroll
        for (int t = 0; t < 4; ++t) atomicMax(cm + drow_of(w.n0 + 4 * lane + t, w.mode), __float_as_uint(m[t])); }
}
__device__ __forceinline__ void convert_item(const WItem& w, const f32x4 (&d)[8], unsigned char* ws, const unsigned* ctl, LAS float* scr, int lane) {
#pragma unroll
    for (int j = 0; j < 8; ++j)
#pragma unroll
        for (int t = 0; t < 4; ++t) scr[(8 * j + (lane >> 3)) * 33 + 4 * (lane & 7) + t] = d[j][t];
    LDS_WAIT(); asm volatile("" ::: "memory");
    const int c = lane & 7;
    unsigned char* WT = ws + w.dst_off + (size_t)w.l * w.nd * w.Kd; const float* cm = (const float*)(ctl + w.cw) + (size_t)w.l * w.nd;
#pragma unroll
    for (int j = 0; j < 4; ++j) { const int n = (lane >> 3) + 8 * j; const LAS float* sp = scr + (8 * c) * 33 + n;
        const int drow = drow_of(w.n0 + n, w.mode);
        if (w.fmt == 2) { v4u o; o.x = pk2(sp[0 * 33], sp[1 * 33]); o.y = pk2(sp[2 * 33], sp[3 * 33]); o.z = pk2(sp[4 * 33], sp[5 * 33]); o.w = pk2(sp[6 * 33], sp[7 * 33]);
            *(v4u*)(WT + (size_t)drow * w.Kd + (size_t)(w.k0 + 8 * c) * 2) = o; }
        else { const float cmv = cm[drow]; v2u o;
            if (w.fmt == 1) { const float qs = cmv > 0.f ? pg8::F8_WMAX / cmv : 0.f;
                o.x = pg8::pk_fp8x4(sp[0 * 33] * qs, sp[1 * 33] * qs, sp[2 * 33] * qs, sp[3 * 33] * qs); o.y = pg8::pk_fp8x4(sp[4 * 33] * qs, sp[5 * 33] * qs, sp[6 * 33] * qs, sp[7 * 33] * qs); }
            else { const float qs = cmv > 0.f ? 127.0f / cmv : 0.f; int q[8];
#pragma unroll
                for (int t = 0; t < 8; ++t) q[t] = (int)__builtin_rintf(sp[t * 33] * qs);
                o.x = (unsigned)(q[0] & 255) | ((unsigned)(q[1] & 255) << 8) | ((unsigned)(q[2] & 255) << 16) | ((unsigned)q[3] << 24);
                o.y = (unsigned)(q[4] & 255) | ((unsigned)(q[5] & 255) << 8) | ((unsigned)(q[6] & 255) << 16) | ((unsigned)q[7] << 24); }
            *(v2u*)(WT + (size_t)drow * w.Kd + w.k0 + 8 * c) = o; } }
    LDS_WAIT(); asm volatile("" ::: "memory");
}

template <bool ROUTER, int R, bool XF32>
__device__ __forceinline__ void norm_phase(const float* x, const bf16* xb, const float* gain, unsigned char* xq, float* sa, const float* wr, v4u* map, unsigned* cnt, int gw, int NGW, int lane) {
    f32x4 g[4][2];
#pragma unroll
    for (int j = 0; j < 4; ++j)
#pragma unroll
        for (int e = 0; e < 2; ++e) g[j][e] = *(const f32x4*)(gain + 512 * j + 8 * lane + 4 * e);
    const int RPW = (M + NGW - 1) / NGW;
    int my_e0 = -1, my_e1 = -1, my_row = -1, it = 0; float my_g0 = 0.f, my_g1 = 0.f;
    f32x4 rf[R][4][2]; v4u rb[R][4];
#define NORM_LOAD(dstf, dstb, r0) do { _Pragma("unroll") for (int rr = 0; rr < R; ++rr) { const int row_ = ((r0) + rr < M) ? (r0) + rr : M - 1; \
            if constexpr (XF32) { const float* xr = x + (size_t)row_ * DM + 8 * lane; _Pragma("unroll") for (int j = 0; j < 4; ++j) _Pragma("unroll") for (int e = 0; e < 2; ++e) dstf[rr][j][e] = *(const f32x4*)(xr + 512 * j + 4 * e); } \
            else { const bf16* xr = xb + (size_t)row_ * DM + 8 * lane; _Pragma("unroll") for (int j = 0; j < 4; ++j) dstb[rr][j] = __builtin_nontemporal_load((const v4u*)(xr + 512 * j)); } } } while (0)
    asm volatile("" :: "v"(g[0][0]), "v"(g[0][1]), "v"(g[1][0]), "v"(g[1][1]), "v"(g[2][0]), "v"(g[2][1]), "v"(g[3][0]), "v"(g[3][1]));
    NORM_LOAD(rf, rb, gw * RPW);
    for (int i0 = 0; i0 < RPW; i0 += R) {
        const int row0 = gw * RPW + i0;
        f32x4 v[R][4][2]; float ss[R];
#pragma unroll
        for (int rr = 0; rr < R; ++rr)
#pragma unroll
            for (int j = 0; j < 4; ++j) {
                if constexpr (XF32) { v[rr][j][0] = rf[rr][j][0]; v[rr][j][1] = rf[rr][j][1]; }
                else { const v4u w = rb[rr][j]; v[rr][j][0] = (f32x4){bf_lo(w.x), bf_hi(w.x), bf_lo(w.y), bf_hi(w.y)}; v[rr][j][1] = (f32x4){bf_lo(w.z), bf_hi(w.z), bf_lo(w.w), bf_hi(w.w)}; } }
        if (i0 + R < RPW) NORM_LOAD(rf, rb, row0 + R);
#pragma unroll
        for (int rr = 0; rr < R; ++rr) { float s = 0.f;
#pragma unroll
            for (int j = 0; j < 4; ++j)
#pragma unroll
                for (int e = 0; e < 2; ++e) s += (v[rr][j][e].x * v[rr][j][e].x + v[rr][j][e].y * v[rr][j][e].y) + (v[rr][j][e].z * v[rr][j][e].z + v[rr][j][e].w * v[rr][j][e].w);
            ss[rr] = s; }
#pragma unroll
        for (int o = 1; o < 64; o <<= 1)
#pragma unroll
            for (int rr = 0; rr < R; ++rr) ss[rr] += shx(ss[rr], o, lane);
        float mx[R];
#pragma unroll
        for (int rr = 0; rr < R; ++rr) {
            const float rstd = __builtin_amdgcn_rsqf(ss[rr] * (1.0f / DM) + EPS); float m = 0.f;
#pragma unroll
            for (int j = 0; j < 4; ++j) {
                v[rr][j][0] = v[rr][j][0] * rstd * g[j][0]; v[rr][j][1] = v[rr][j][1] * rstd * g[j][1];
#pragma unroll
                for (int t = 0; t < 4; ++t) m = __builtin_fmaxf(m, __builtin_fmaxf(__builtin_fabsf(v[rr][j][0][t]), __builtin_fabsf(v[rr][j][1][t])));
            }
            mx[rr] = m;
        }
#pragma unroll
        for (int o = 1; o < 64; o <<= 1)
#pragma unroll
            for (int rr = 0; rr < R; ++rr) mx[rr] = __builtin_fmaxf(mx[rr], shx(mx[rr], o, lane));
#pragma unroll
        for (int rr = 0; rr < R; ++rr) {
            const bool live = (row0 + rr < M);
            const float qs = mx[rr] > 0.f ? 127.0f / mx[rr] : 0.f;
            unsigned char* orow = xq + (size_t)(row0 + rr) * DM + 8 * lane;
#pragma unroll
            for (int j = 0; j < 4; ++j) {
                int q[8];
#pragma unroll
                for (int t = 0; t < 4; ++t) { q[t] = (int)__builtin_rintf(v[rr][j][0][t] * qs); q[4 + t] = (int)__builtin_rintf(v[rr][j][1][t] * qs); }
                v2u o; o.x = (unsigned)(q[0] & 255) | ((unsigned)(q[1] & 255) << 8) | ((unsigned)(q[2] & 255) << 16) | ((unsigned)q[3] << 24);
                o.y = (unsigned)(q[4] & 255) | ((unsigned)(q[5] & 255) << 8) | ((unsigned)(q[6] & 255) << 16) | ((unsigned)q[7] << 24);
                if (live) *(v2u*)(orow + 512 * j) = o;
            }
            if (live && lane == 0) sa[row0 + rr] = mx[rr] * (1.0f / 127.0f);
        }
        if constexpr (ROUTER) {
            float lg[R][8];
#pragma unroll
            for (int rr = 0; rr < R; ++rr)
#pragma unroll
                for (int e = 0; e < 8; ++e) lg[rr][e] = 0.f;
#pragma unroll
            for (int j = 0; j < 4; ++j) {
                GAS const float* wj = (GAS const float*)(wr + (size_t)(512 * j + 8 * lane) * 8); asm volatile("" : "+v"(wj));
#pragma unroll
                for (int e = 0; e < 2; ++e)
#pragma unroll
                    for (int t = 0; t < 4; ++t) {
                        GAS const f32x4* w = (GAS const f32x4*)(wj + (4 * e + t) * 8); const f32x4 w0 = w[0], w1 = w[1];
#pragma unroll
                        for (int rr = 0; rr < R; ++rr) { const float yv = v[rr][j][e][t];
                            lg[rr][0] += yv * w0.x; lg[rr][1] += yv * w0.y; lg[rr][2] += yv * w0.z; lg[rr][3] += yv * w0.w; lg[rr][4] += yv * w1.x; lg[rr][5] += yv * w1.y; lg[rr][6] += yv * w1.z; lg[rr][7] += yv * w1.w; } } }
#pragma unroll
            for (int o = 1; o < 64; o <<= 1)
#pragma unroll
                for (int rr = 0; rr < R; ++rr)
#pragma unroll
                    for (int e = 0; e < 8; ++e) lg[rr][e] += shx(lg[rr][e], o, lane);
#pragma unroll
            for (int rr = 0; rr < R; ++rr) {
                const int row = row0 + rr;
                if (row < M) {
                    int i0x = 0; float l0 = lg[rr][0];
#pragma unroll
                    for (int e = 1; e < 8; ++e) if (lg[rr][e] > l0) { l0 = lg[rr][e]; i0x = e; }
                    int i1x = -1; float l1 = -3.0e38f;
#pragma unroll
                    for (int e = 0; e < 8; ++e) if (e != i0x && lg[rr][e] > l1) { l1 = lg[rr][e]; i1x = e; }
                    const float e1 = __expf(l1 - l0); const float g0 = 1.0f / (1.0f + e1), g1 = e1 * g0;
                    if (lane == (it & 63)) { my_e0 = i0x; my_e1 = i1x; my_g0 = g0; my_g1 = g1; my_row = row; }
                    ++it;
                }
                const bool lastrow = (i0 + rr == RPW - 1);
                if (((it & 63) == 0 && it > 0) || lastrow) {
                    int rank0 = 0, rank1 = 0, mycount = 0;
#pragma unroll
                    for (int e = 0; e < 8; ++e) {
                        const unsigned long long m0 = __ballot(my_e0 == e), m1 = __ballot(my_e1 == e);
                        const int r0 = __builtin_amdgcn_mbcnt_hi((unsigned)(m0 >> 32), __builtin_amdgcn_mbcnt_lo((unsigned)m0, 0u));
                        const int r1 = __builtin_amdgcn_mbcnt_hi((unsigned)(m1 >> 32), __builtin_amdgcn_mbcnt_lo((unsigned)m1, 0u));
                        if (my_e0 == e) rank0 = r0; if (my_e1 == e) rank1 = r1;
                        if (lane == e) mycount = __builtin_popcountll(m0); if (lane == 8 + e) mycount = __builtin_popcountll(m1);
                    }
                    int base = 0;
                    if (lane < 16 && mycount > 0) base = (int)__hip_atomic_fetch_add(cnt + 64 * lane, (unsigned)mycount, __ATOMIC_RELAXED, __HIP_MEMORY_SCOPE_AGENT);
                    const int b0 = shi(base, my_e0 & 7), b1 = shi(base, 8 + (my_e1 & 7));
                    if (my_row >= 0) {
                        v4u a; a.x = (unsigned)my_e0; a.y = (unsigned)(b0 + rank0); a.z = __float_as_uint(my_g0); a.w = (unsigned)my_row;
                        v4u b; b.x = (unsigned)(8 + my_e1); b.y = (unsigned)(b1 + rank1); b.z = __float_as_uint(my_g1); b.w = (unsigned)my_row;
                        map[(size_t)my_row * 2] = a; map[(size_t)my_row * 2 + 1] = b;
                    }
                    my_e0 = -1; my_e1 = -1; my_row = -1; it = 0;
                }
            }
        }
    }
    (void)my_e0; (void)my_e1; (void)my_row; (void)it; (void)my_g0; (void)my_g1;
#undef NORM_LOAD
}

#define MFMA32(a, b, c) __builtin_amdgcn_mfma_f32_32x32x16_bf16((a), (b), (c), 0, 0, 0)
__device__ __forceinline__ int crow16(int i, int hh) { return (i & 3) + 8 * (i >> 2) + 4 * hh; }
__device__ __forceinline__ int voff(int row, int ch) { return 256 * row + 16 * (ch ^ (((row & 3) << 2) | ((row >> 2) & 3))); }
__device__ __forceinline__ void load_frag8(bf16x8 (&f)[8], const bf16* rowptr, int hh) {
    const v4u* p = (const v4u*)rowptr + 2 * hh;
#pragma unroll
    for (int c = 0; c < 4; ++c) { f[2 * c] = __builtin_bit_cast(bf16x8, p[4 * c]); f[2 * c + 1] = __builtin_bit_cast(bf16x8, p[4 * c + 1]); }
}
__device__ __forceinline__ void load_v(v4u (&t)[8], const bf16* vbase, size_t rstride, int lane) {
    int l2 = lane; asm volatile("" : "+v"(l2));
    const bf16* p = vbase + (size_t)(l2 >> 4) * rstride + 8 * (l2 & 15);
#pragma unroll
    for (int i = 0; i < 8; ++i) t[i] = *(const v4u*)(p + (size_t)(4 * i) * rstride);
}
__device__ __forceinline__ void write_v(LAS unsigned char* vimg, const v4u (&t)[8], int lane_) {
    int lane = lane_; asm volatile("" : "+v"(lane));
#pragma unroll
    for (int i = 0; i < 8; ++i) { const int row = 4 * i + (lane >> 4); *(LAS v4u*)(vimg + voff(row, lane & 15)) = t[i]; }
}
__device__ __forceinline__ void write_k(LAS unsigned char* img, const v4u (&t)[8], int lane_) {
    int lane = lane_; asm volatile("" : "+v"(lane));
#pragma unroll
    for (int i = 0; i < 8; ++i) { const int row = 4 * i + (lane >> 4); *(LAS v4u*)(img + 256 * row + 16 * ((lane & 15) ^ (row & 15))) = t[i]; }
}
__device__ __forceinline__ f32x16 qk_tile(LAS unsigned char* img, LAS unsigned char* qimg, int lane) {
    const int r = lane & 31, hh = lane >> 5;
    f32x16 S;
#pragma unroll
    for (int i = 0; i < 16; ++i) S[i] = 0.f;
#pragma unroll
    for (int f = 0; f < 8; ++f) { const int ch = 4 * (f >> 1) + 2 * hh + (f & 1);
        const bf16x8 kf = *(const LAS bf16x8*)(img + 256 * r + 16 * (ch ^ (r & 15)));
        S = MFMA32(kf, *(const LAS bf16x8*)(qimg + f * 1024 + lane * 16), S); }
    return S;
}
__device__ __forceinline__ bf16x8 pack8(const float* p) {
    v4u w; w.x = pk2(p[0], p[1]); w.y = pk2(p[2], p[3]); w.z = pk2(p[4], p[5]); w.w = pk2(p[6], p[7]);
    return __builtin_bit_cast(bf16x8, w);
}
__device__ __forceinline__ void pv_tile(f32x16 (&O)[4], const float (&P)[16], LAS unsigned char* vimg, int lane) {
    const int hh = lane >> 5, i16 = lane & 15, q = i16 >> 2, p = i16 & 3, blk = (lane >> 4) & 1;
    const bf16x8 pf0 = pack8(&P[0]), pf1 = pack8(&P[8]);
    asm volatile("" ::: "memory");
#pragma unroll
    for (int dt = 0; dt < 4; ++dt) {
#pragma unroll
        for (int s = 0; s < 2; ++s) {
            const int ch = 4 * dt + 2 * blk + (p >> 1);
            const int rlo = 16 * s + 4 * hh + q, rhi = rlo + 8;
            const s16x4 lo = __builtin_amdgcn_ds_read_tr16_b64_v4i16((LAS s16x4*)(vimg + voff(rlo, ch) + 8 * (p & 1)));
            const s16x4 hi = __builtin_amdgcn_ds_read_tr16_b64_v4i16((LAS s16x4*)(vimg + voff(rhi, ch) + 8 * (p & 1)));
            const bf16x8 va = __builtin_shufflevector(lo, hi, 0, 1, 2, 3, 4, 5, 6, 7);
            O[dt] = MFMA32(va, s == 0 ? pf0 : pf1, O[dt]);
        }
    }
    asm volatile("" ::: "memory");
}
constexpr float ATT_C = 0.08838834764831845f * 1.4426950408889634f;
constexpr float SB_STOP = 160.0f;

__device__ __forceinline__ void store_pair16(bf16* p, v2u a, v2u b) {
    asm volatile("s_nop 1" : "+v"(a.x), "+v"(a.y), "+v"(b.x), "+v"(b.y));
    const auto r0 = __builtin_amdgcn_permlane32_swap(a.x, b.x, false, false); const auto r1 = __builtin_amdgcn_permlane32_swap(a.y, b.y, false, false);
    v4u w; w.x = r0[0]; w.y = r1[0]; w.z = r0[1]; w.w = r1[1];
    *(v4u*)p = w;
}
__device__ __forceinline__ void sb_unit(const bf16* H, bf16* OSB, LAS unsigned char* vimg, LAS unsigned char* qimg, int b, int hd, int qt, int lane) {
    const int r = lane & 31, hh = lane >> 5;
    const size_t tokq = (size_t)b * SEQ + 32 * qt + r;
    v4u Kt[8], Vt[8];
    { bf16x8 Q[8]; load_frag8(Q, H + tokq * DIN + C_QSB + hd * HD, hh);
      { const size_t tok0 = (size_t)b * SEQ + 32 * qt; load_v(Kt, H + tok0 * DIN + C_KSB + hd * HD, DIN, lane); load_v(Vt, H + tok0 * DIN + C_VSB + hd * HD, DIN, lane); }
#pragma unroll
      for (int c = 0; c < 8; ++c) *(LAS bf16x8*)(qimg + c * 1024 + lane * 16) = Q[c]; }
    f32x16 O[4];
#pragma unroll
    for (int dt = 0; dt < 4; ++dt)
#pragma unroll
        for (int i = 0; i < 16; ++i) O[dt][i] = 0.f;
    float later = 0.f;
    for (int kt = qt; kt >= 0; --kt) {
        const size_t tokn = (size_t)b * SEQ + 32 * (kt > 0 ? kt - 1 : 0);
        write_k(vimg, Kt, lane);
        asm volatile("" ::: "memory");
        if (kt > 0) load_v(Kt, H + tokn * DIN + C_KSB + hd * HD, DIN, lane);
        const f32x16 S = qk_tile(vimg, qimg, lane);
        asm volatile("" ::: "memory");
        write_v(vimg, Vt, lane);
        if (kt > 0) load_v(Vt, H + tokn * DIN + C_VSB + hd * HD, DIN, lane);
        const bool diag = (kt == qt);
        float u[16], a[16]; bool valid[16];
#pragma unroll
        for (int i = 0; i < 16; ++i) {
            u[i] = S[i] * ATT_C; valid[i] = !diag || (crow16(i, hh) < r);
            const float e = __builtin_amdgcn_exp2f(-__builtin_fabsf(u[i]));
            const float sp = __builtin_fmaxf(u[i], 0.f) + __builtin_amdgcn_logf(1.0f + e);
            a[i] = valid[i] ? sp : 0.f;
        }
        float T[4], To[4];
#pragma unroll
        for (int G = 0; G < 4; ++G) { a[4 * G + 2] += a[4 * G + 3]; a[4 * G + 1] += a[4 * G + 2]; a[4 * G] += a[4 * G + 1]; T[G] = a[4 * G]; }
#pragma unroll
        for (int G = 0; G < 4; ++G) To[G] = shx(T[G], 32, lane);
        const float P3 = T[3] + To[3], P2 = T[2] + To[2], P1 = T[1] + To[1], P0 = T[0] + To[0];
        float Qs[4]; Qs[3] = 0.f; Qs[2] = P3; Qs[1] = P3 + P2; Qs[0] = Qs[1] + P1;
        const float total = Qs[0] + P0;
        float P[16];
#pragma unroll
        for (int i = 0; i < 16; ++i) { const int G = i >> 2; const float off = Qs[G] + (hh == 0 ? To[G] : 0.f);
            const float l2a = u[i] - (a[i] + off) - later; P[i] = valid[i] ? __builtin_amdgcn_exp2f(l2a) : 0.f; }
        pv_tile(O, P, vimg, lane);
        later += total;
        if (__all(later > SB_STOP)) break;
    }
    int l3 = lane; asm volatile("" : "+v"(l3));
    bf16* orow = OSB + ((size_t)b * SEQ + 32 * qt + (l3 & 31)) * DSB + hd * HD + 8 * (l3 >> 5);
#pragma unroll
    for (int dt = 0; dt < 4; ++dt)
#pragma unroll
        for (int G = 0; G < 4; G += 2) { v2u a, c; a.x = pk2(O[dt][4 * G], O[dt][4 * G + 1]); a.y = pk2(O[dt][4 * G + 2], O[dt][4 * G + 3]); c.x = pk2(O[dt][4 * G + 4], O[dt][4 * G + 5]); c.y = pk2(O[dt][4 * G + 6], O[dt][4 * G + 7]);
            store_pair16(orow + 32 * dt + 8 * G, a, c); }
}

__device__ __forceinline__ void dil_unit(const bf16* H, bf16* ODIL, float* LSE, LAS unsigned char* vimg, LAS unsigned char* qimg, int b, int hd, int g, int rc, int mt, int lane) {
    const int r = lane & 31, hh = lane >> 5;
    const int delta = (g == 0) ? 1 : (g == 1 ? 4 : 16);
    const size_t tokq = (size_t)b * SEQ + (size_t)(32 * mt + r) * delta + rc;
    v4u Kt[8], Vt[8];
    { bf16x8 Q[8]; load_frag8(Q, H + tokq * DIN + C_QDIL + hd * HD, hh);
      { const size_t tok0 = (size_t)b * SEQ + (size_t)(32 * mt) * delta + rc; load_v(Kt, H + tok0 * DIN + C_KDIL + hd * HD, (size_t)DIN * delta, lane); load_v(Vt, H + tok0 * DIN + C_VDIL + hd * HD, (size_t)DIN * delta, lane); }
#pragma unroll
      for (int c = 0; c < 8; ++c) *(LAS bf16x8*)(qimg + c * 1024 + lane * 16) = Q[c]; }
    f32x16 O[4];
#pragma unroll
    for (int dt = 0; dt < 4; ++dt)
#pragma unroll
        for (int i = 0; i < 16; ++i) O[dt][i] = 0.f;
    float mrun = -1.0e30f, lsum = 0.f;
    const int ktlo = (mt - 4 > 0) ? (mt - 4) : 0;
    for (int kt = mt; kt >= ktlo; --kt) {
        const size_t tokn = (size_t)b * SEQ + (size_t)(32 * (kt > ktlo ? kt - 1 : kt)) * delta + rc;
        write_k(vimg, Kt, lane);
        asm volatile("" ::: "memory");
        if (kt > ktlo) load_v(Kt, H + tokn * DIN + C_KDIL + hd * HD, (size_t)DIN * delta, lane);
        const f32x16 S = qk_tile(vimg, qimg, lane);
        asm volatile("" ::: "memory");
        write_v(vimg, Vt, lane);
        if (kt > ktlo) load_v(Vt, H + tokn * DIN + C_VDIL + hd * HD, (size_t)DIN * delta, lane);
        const int dq = 32 * (mt - kt) + r;
        float u[16]; float tmax = -1.0e30f;
#pragma unroll
        for (int i = 0; i < 16; ++i) { const int dist = dq - crow16(i, hh); const bool ok = (dist >= 0) && (dist <= 128);
            u[i] = ok ? S[i] * ATT_C : -1.0e30f; tmax = __builtin_fmaxf(tmax, u[i]); }
        tmax = __builtin_fmaxf(tmax, shx(tmax, 32, lane));
        constexpr float DIL_THR = 8.0f;
        float mnew = mrun;
        if (!__all(tmax - mrun <= DIL_THR)) {
            mnew = __builtin_fmaxf(mrun, tmax);
            const float alpha = __builtin_amdgcn_exp2f(mrun - mnew);
            lsum *= alpha;
#pragma unroll
            for (int dt = 0; dt < 4; ++dt)
#pragma unroll
                for (int i = 0; i < 16; ++i) O[dt][i] *= alpha;
        }
        float P[16]; float ps = 0.f;
#pragma unroll
        for (int i = 0; i < 16; ++i) { P[i] = __builtin_amdgcn_exp2f(u[i] - mnew); ps += P[i]; }
        lsum += ps;
        pv_tile(O, P, vimg, lane);
        mrun = mnew;
    }
    const float ltot = lsum + shx(lsum, 32, lane);
    const float inv = 1.0f / ltot;
    int l3 = lane; asm volatile("" : "+v"(l3));
    const size_t tq3 = (size_t)b * SEQ + (size_t)(32 * mt + (l3 & 31)) * delta + rc;
    bf16* orow = ODIL + ((size_t)g * M + tq3) * 512 + hd * HD + 8 * (l3 >> 5);
#pragma unroll
    for (int dt = 0; dt < 4; ++dt)
#pragma unroll
        for (int G = 0; G < 4; G += 2) { v2u a, c; a.x = pk2(O[dt][4 * G] * inv, O[dt][4 * G + 1] * inv); a.y = pk2(O[dt][4 * G + 2] * inv, O[dt][4 * G + 3] * inv);
            c.x = pk2(O[dt][4 * G + 4] * inv, O[dt][4 * G + 5] * inv); c.y = pk2(O[dt][4 * G + 6] * inv, O[dt][4 * G + 7] * inv);
            store_pair16(orow + 32 * dt + 8 * G, a, c); }
    if ((l3 >> 5) == 0) LSE[((size_t)g * M + tq3) * 4 + hd] = (mrun + __builtin_amdgcn_logf(ltot)) * 0.6931471805599453f;
}

__device__ __forceinline__ void attn_phase(const bf16* H, bf16* OSB, bf16* ODIL, float* LSE, LAS unsigned char* lds, int vcu, int G, int wave, int lane, unsigned* queue) {
    LAS unsigned char* vimg = lds + wave * 16384; LAS unsigned char* qimg = vimg + 8192;
    constexpr int NSB = NB * 4 * 256, NDIL = 3 * NSB;
    const int NGRP = (G % 8 == 0) ? 8 : 1, BPG = G / NGRP, WPG = BPG * NWAVES, NGW = G * NWAVES;
    const int grp = vcu / BPG;
    unsigned* q = queue + grp * 16;
    const int nslot = WPG * ((NSB + NDIL + NGW - 1) / NGW);
    unsigned jv = 0; if (lane == 0) jv = __hip_atomic_fetch_add(q, 1u, __ATOMIC_RELAXED, __HIP_MEMORY_SCOPE_AGENT);
    for (;;) {
        const int j = __builtin_amdgcn_readfirstlane((int)jv);
        if (j >= nslot) break;
        if (lane == 0) jv = __hip_atomic_fetch_add(q, 1u, __ATOMIC_RELAXED, __HIP_MEMORY_SCOPE_AGENT);
        const int uidx = grp * WPG + (j % WPG) + (j / WPG) * NGW;
        if (uidx >= NSB + NDIL) continue;
        if (uidx < NSB) { const int qt = uidx & 255, hd = (uidx >> 8) & 3, b = uidx >> 10; sb_unit(H, OSB, vimg, qimg, b, hd, qt, lane); }
        else { const int did = uidx - NSB; const int g = did / NSB, rem = did % NSB; const int b = rem >> 10, hd = (rem >> 8) & 3, sub = rem & 255;
            const int delta = (g == 0) ? 1 : (g == 1 ? 4 : 16); const int nmt = 256 / delta; const int mt = sub % nmt, rc = sub / nmt;
            dil_unit(H, ODIL, LSE, vimg, qimg, b, hd, g, rc, mt, lane); }
    }
}

__device__ __forceinline__ void combine_phase(const bf16* OSB, const bf16* ODIL, const float* LSE, const float* g_sb, const float* g_dil, unsigned char* ATTq, float* sa2, int gw, int NGW, int lane) {
    constexpr int R = 4;
    const f32x4 gs0 = *(const f32x4*)(g_sb + 8 * lane), gs1 = *(const f32x4*)(g_sb + 8 * lane + 4);
    const f32x4 gd0 = *(const f32x4*)(g_dil + 8 * lane), gd1 = *(const f32x4*)(g_dil + 8 * lane + 4);
    const int hd = lane >> 4;
    const int RPW = (M + NGW - 1) / NGW;
    v4u sbn[R]; v4u dvn[R][3]; float lsn[R][3];
#define CMB_LOAD(t0) do { _Pragma("unroll") for (int rr = 0; rr < R; ++rr) { const int tok_ = ((t0) + rr < M) ? (t0) + rr : M - 1; \
            sbn[rr] = __builtin_nontemporal_load((const v4u*)(OSB + (size_t)tok_ * DSB + 8 * lane)); \
            _Pragma("unroll") for (int g = 0; g < 3; ++g) { dvn[rr][g] = __builtin_nontemporal_load((const v4u*)(ODIL + ((size_t)g * M + tok_) * 512 + 8 * lane)); lsn[rr][g] = LSE[((size_t)g * M + tok_) * 4 + hd]; } } } while (0)
    asm volatile("" :: "v"(gs0), "v"(gs1), "v"(gd0), "v"(gd1));
    CMB_LOAD(gw * RPW);
    for (int i0 = 0; i0 < RPW; i0 += R) {
        f32x4 sv[R][2]; v4u dv[R][3]; float ls[R][3];
#pragma unroll
        for (int rr = 0; rr < R; ++rr) { const v4u w = sbn[rr]; sv[rr][0] = (f32x4){bf_lo(w.x), bf_hi(w.x), bf_lo(w.y), bf_hi(w.y)}; sv[rr][1] = (f32x4){bf_lo(w.z), bf_hi(w.z), bf_lo(w.w), bf_hi(w.w)};
#pragma unroll
            for (int g = 0; g < 3; ++g) { dv[rr][g] = dvn[rr][g]; ls[rr][g] = lsn[rr][g]; } }
        if (i0 + R < RPW) CMB_LOAD(gw * RPW + i0 + R);
        float s1[R], s2[R]; float y[R][8];
#pragma unroll
        for (int rr = 0; rr < R; ++rr) {
            const f32x4 v0 = sv[rr][0], v1 = sv[rr][1];
            s1[rr] = (v0.x * v0.x + v0.y * v0.y) + (v0.z * v0.z + v0.w * v0.w) + (v1.x * v1.x + v1.y * v1.y) + (v1.z * v1.z + v1.w * v1.w);
            const float l0 = ls[rr][0], l1 = ls[rr][1], l2 = ls[rr][2];
            const float mx = __builtin_fmaxf(l0, __builtin_fmaxf(l1, l2));
            float w0 = __expf(l0 - mx), w1 = __expf(l1 - mx), w2 = __expf(l2 - mx); const float iw = 1.0f / (w0 + w1 + w2); w0 *= iw; w1 *= iw; w2 *= iw;
            const v4u a = dv[rr][0], bq = dv[rr][1], c = dv[rr][2];
            y[rr][0] = w0 * bf_lo(a.x) + w1 * bf_lo(bq.x) + w2 * bf_lo(c.x); y[rr][1] = w0 * bf_hi(a.x) + w1 * bf_hi(bq.x) + w2 * bf_hi(c.x);
            y[rr][2] = w0 * bf_lo(a.y) + w1 * bf_lo(bq.y) + w2 * bf_lo(c.y); y[rr][3] = w0 * bf_hi(a.y) + w1 * bf_hi(bq.y) + w2 * bf_hi(c.y);
            y[rr][4] = w0 * bf_lo(a.z) + w1 * bf_lo(bq.z) + w2 * bf_lo(c.z); y[rr][5] = w0 * bf_hi(a.z) + w1 * bf_hi(bq.z) + w2 * bf_hi(c.z);
            y[rr][6] = w0 * bf_lo(a.w) + w1 * bf_lo(bq.w) + w2 * bf_lo(c.w); y[rr][7] = w0 * bf_hi(a.w) + w1 * bf_hi(bq.w) + w2 * bf_hi(c.w);
            float q = 0.f;
#pragma unroll
            for (int e = 0; e < 8; ++e) q += y[rr][e] * y[rr][e];
            s2[rr] = q;
        }
#pragma unroll
        for (int o = 1; o < 64; o <<= 1)
#pragma unroll
            for (int rr = 0; rr < R; ++rr) { s1[rr] += shx(s1[rr], o, lane); s2[rr] += shx(s2[rr], o, lane); }
        float mx[R]; f32x4 n0[R], n1[R]; float z[R][8];
#pragma unroll
        for (int rr = 0; rr < R; ++rr) {
            const float r1 = __builtin_amdgcn_rsqf(s1[rr] * (1.0f / DSB) + EPS), r2 = __builtin_amdgcn_rsqf(s2[rr] * (1.0f / 512.0f) + EPS);
            n0[rr] = sv[rr][0] * r1 * gs0; n1[rr] = sv[rr][1] * r1 * gs1; float m = 0.f;
#pragma unroll
            for (int t = 0; t < 4; ++t) m = __builtin_fmaxf(m, __builtin_fmaxf(__builtin_fabsf(n0[rr][t]), __builtin_fabsf(n1[rr][t])));
#pragma unroll
            for (int e = 0; e < 8; ++e) { z[rr][e] = y[rr][e] * r2 * ((e < 4) ? gd0[e & 3] : gd1[e & 3]); m = __builtin_fmaxf(m, __builtin_fabsf(z[rr][e])); }
            mx[rr] = m;
        }
#pragma unroll
        for (int o = 1; o < 64; o <<= 1)
#pragma unroll
            for (int rr = 0; rr < R; ++rr) mx[rr] = __builtin_fmaxf(mx[rr], shx(mx[rr], o, lane));
#pragma unroll
        for (int rr = 0; rr < R; ++rr) {
            const int tok = gw * RPW + i0 + rr;
            if (tok < M) {
                const float qs = mx[rr] > 0.f ? 127.0f / mx[rr] : 0.f; int q[8];
#pragma unroll
                for (int t = 0; t < 4; ++t) { q[t] = (int)__builtin_rintf(n0[rr][t] * qs); q[4 + t] = (int)__builtin_rintf(n1[rr][t] * qs); }
                v2u o; o.x = (unsigned)(q[0] & 255) | ((unsigned)(q[1] & 255) << 8) | ((unsigned)(q[2] & 255) << 16) | ((unsigned)q[3] << 24);
                o.y = (unsigned)(q[4] & 255) | ((unsigned)(q[5] & 255) << 8) | ((unsigned)(q[6] & 255) << 16) | ((unsigned)q[7] << 24);
                *(v2u*)(ATTq + (size_t)tok * DMIX + 8 * lane) = o;
#pragma unroll
                for (int e = 0; e < 8; ++e) q[e] = (int)__builtin_rintf(z[rr][e] * qs);
                v2u o2; o2.x = (unsigned)(q[0] & 255) | ((unsigned)(q[1] & 255) << 8) | ((unsigned)(q[2] & 255) << 16) | ((unsigned)q[3] << 24);
                o2.y = (unsigned)(q[4] & 255) | ((unsigned)(q[5] & 255) << 8) | ((unsigned)(q[6] & 255) << 16) | ((unsigned)q[7] << 24);
                *(v2u*)(ATTq + (size_t)tok * DMIX + 512 + 8 * lane) = o2;
                if (lane == 0) sa2[tok] = mx[rr] * (1.0f / 127.0f);
            }
        }
    }
}

#undef CMB_LOAD
__device__ __forceinline__ void moe_tiles(unsigned* cnt, int lane, int& c, int& incl) {
    c = (lane < 16) ? (int)__hip_atomic_load(cnt + 64 * (lane & 15), __ATOMIC_RELAXED, __HIP_MEMORY_SCOPE_AGENT) : 0;
    const int tiles = (c + 255) >> 8; int v = tiles;
#pragma unroll
    for (int o = 1; o < 16; o <<= 1) { const int t = shi(v, (lane - o) & 63); if ((lane & 15) >= o) v += t; }
    incl = v;
}
__device__ __forceinline__ void moe_table(unsigned* cnt, LAS int* tbi, int wave, int lane) {
    if (wave == 0) { int c, incl; moe_tiles(cnt, lane, c, incl); if (lane < 16) tbi[lane] = incl; }
    __syncthreads();
}
__device__ __forceinline__ void moe_gather_phase(const unsigned char* XNq, const float* sa, const v4u* map, unsigned* cnt, unsigned char* XGq, unsigned char* hm8, int* rowtok, float* rowgate, float* rowscale, int gw, int NGW, int lane) {
    int c, incl; moe_tiles(cnt, lane, c, incl);
    const int excl = incl - ((c + 255) >> 8);
    const int RPW = (M + NGW - 1) / NGW;
    for (int i0 = 0; i0 < RPW; i0 += 4) {
        v4u d[4][2]; v4u mm[4][2]; float sc[4];
#pragma unroll
        for (int rr = 0; rr < 4; ++rr) { const int tok = (gw * RPW + i0 + rr < M) ? gw * RPW + i0 + rr : M - 1; const v4u* src = (const v4u*)(XNq + (size_t)tok * DM) + lane;
            d[rr][0] = __builtin_nontemporal_load(src); d[rr][1] = __builtin_nontemporal_load(src + 64); mm[rr][0] = map[(size_t)tok * 2]; mm[rr][1] = map[(size_t)tok * 2 + 1]; sc[rr] = sa[tok]; }
#pragma unroll
        for (int rr = 0; rr < 4; ++rr) {
            const int tok = gw * RPW + i0 + rr;
            if (tok < M && i0 + rr < RPW) {
#pragma unroll
                for (int k = 0; k < 2; ++k) {
                    const unsigned gx = mm[rr][k].x, gy = mm[rr][k].y, gz = mm[rr][k].z;
                    const int grp = __builtin_amdgcn_readfirstlane((int)gx), slot = __builtin_amdgcn_readfirstlane((int)gy);
                    const int row = (shi(excl, grp) << 8) + slot;
                    v4u* dst = (v4u*)(XGq + (size_t)row * DM) + lane;
                    dst[0] = d[rr][0]; dst[64] = d[rr][1];
                    if (lane < 8) { unsigned zz = 0u; asm volatile("" : "+v"(zz)); const v4u z = {zz, zz, zz, zz}; *(v4u*)(hm8 + (size_t)row * DFEP + DFE + 16 * lane) = z; }
                    if (lane == 0) { rowtok[row] = tok; rowgate[row] = __uint_as_float(gz); rowscale[row] = sc[rr]; }
                }
            }
        }
    }
    for (int g = 0; g < 16; ++g) {
        const int cg = shi(c, g), start = (shi(excl, g) << 8) + cg, end = shi(incl, g) << 8;
        for (int r = start + gw; r < end; r += NGW) {
            v4u* dst = (v4u*)(XGq + (size_t)r * DM) + lane; unsigned zz = 0u; asm volatile("" : "+v"(zz)); const v4u z = {zz, zz, zz, zz};
            dst[0] = z; dst[64] = z;
            if (lane < 8) *(v4u*)(hm8 + (size_t)r * DFEP + DFE + 16 * lane) = z;
            if (lane == 0) { rowtok[r] = -1; rowgate[r] = 0.f; rowscale[r] = 0.f; }
        }
    }
}

__device__ __forceinline__ int lane_now() { unsigned m = ~0u; asm volatile("" : "+s"(m)); return (int)__builtin_amdgcn_mbcnt_hi(m, __builtin_amdgcn_mbcnt_lo(m, 0u)); }

struct Args { const void* in[19]; float* out; unsigned char* ws; int ph_lo, ph_hi, li, pad; };
__global__ void __launch_bounds__(NWAVES * 64, 2) mega_fwd(Args args) {
    extern __shared__ __attribute__((aligned(16))) unsigned char lds_raw[];
    LAS unsigned char* lds = (LAS unsigned char*)lds_raw;
    const int G0 = gridDim.x;
    unsigned* ctl0 = (unsigned*)(args.ws + WS_CTL);
    const int wave0 = __builtin_amdgcn_readfirstlane((int)threadIdx.x >> 6);
#define TID_NOW() (wave0 * 64 + lane_now())
    for (int u = TID_NOW(); u < (LDS_BYTES - LDSCTL_OFF) / 4; u += NWAVES * 64) ((LAS unsigned*)(lds + LDSCTL_OFF))[u] = 0u;
    __syncthreads();
    volatile LAS unsigned* MISC = (volatile LAS unsigned*)(lds + MISC_OFF);
    const int lo = args.ph_lo, hi = args.ph_hi;
    XcdBarrier bar; bar.bar = ctl0 + CW_BAR + args.li * XCD_BAR_WORDS; bar.x = 0; bar.st = nullptr;
    if (hi - lo > 1) bar = xcd_barrier_post(ctl0 + CW_BAR + args.li * XCD_BAR_WORDS, MISC + 8, TID_NOW());
    int ph = 0;
#define PH_PTRS GAS unsigned char* wsg_ = (GAS unsigned char*)args.ws; asm volatile("" : "+s"(wsg_)); unsigned char* ws = (unsigned char*)wsg_; unsigned* ctl = (unsigned*)(ws + WS_CTL); (void)ctl; \
    const float* x_in = (const float*)args.in[0]; \
    const int* positions = (const int*)args.in[1]; \
    float* xres = args.out; \
    unsigned char* Wq_in = ws + WS_WIN; unsigned char* Wq_out = ws + WS_WOUT; unsigned char* Wq_gud = ws + WS_WGU_D; unsigned char* Wf_dnd = ws + WS_WDN_D; \
    unsigned char* Wq_gum = ws + WS_WGU_M; unsigned char* Wf_dnm = ws + WS_WDN_M; \
    unsigned* rope_cs = (unsigned*)(ws + WS_ROPE); (void)rope_cs;     \
    unsigned char* XNq = ws + WS_XN; unsigned char* ATTq = ws + WS_ATT; float* SA2 = (float*)(ws + WS_LSE) + 3 * M * 4; bf16* XB = (bf16*)(ws + WS_XB); (void)XB; v4u* MAP = (v4u*)(ws + WS_MAP); float* LSE = (float*)(ws + WS_LSE); \
    int* ROWTOK = (int*)(ws + WS_ROWTOK); float* ROWGATE = (float*)(ws + WS_ROWTOK) + MOE_ROWS; float* ROWSCALE = ROWGATE + MOE_ROWS; float* SA = ROWSCALE + MOE_ROWS; (void)ROWSCALE; (void)SA; unsigned char* XGq = ws + WS_XG; unsigned char* HMID_M8 = ws + WS_HMID_M;
#define PH_BEGIN if (ph >= lo && ph < hi) { PH_PTRS bf16* Hb = (bf16*)(ws + WS_H); bf16* OSB = (bf16*)(ws + WS_OSB); bf16* ODIL = (bf16*)(ws + WS_ODIL); unsigned char* HMID8 = ws + WS_HMID; (void)Hb; (void)OSB; (void)ODIL; (void)HMID8; int tid = TID_NOW(); asm volatile("" : "+v"(tid)); const int lane = tid & 63; int wave = wave0, G = G0, NGW = G0 * NWAVES; asm volatile("" : "+s"(wave), "+s"(G), "+s"(NGW)); const int gw = blockIdx.x * NWAVES + wave; (void)lane; (void)gw; (void)G; (void)NGW;
#ifdef MK_PROF
    if (TID_NOW() == 0) { LAS unsigned long long* pq = (LAS unsigned long long*)(lds + LDSCTL_OFF + 128); const unsigned long long t0 = __builtin_amdgcn_s_memrealtime(); pq[0] = t0; pq[1] = t0; pq[2] = 0; pq[3] = 0; pq[4] = 0; }
#define PH_END_C(c) if (ph + 1 < hi) xcd_barrier(bar, tid); if (tid == 0) { LAS unsigned long long* pq = (LAS unsigned long long*)(lds + LDSCTL_OFF + 128); const unsigned long long t_now = __builtin_amdgcn_s_memrealtime(); const unsigned long long dt = t_now - pq[1]; pq[1] = t_now; \
        if ((c) == PROF_ABS) pq[2] += dt; if ((c) == PROF_RVR) pq[3] += dt; if ((c) == PROF_DELAY) pq[4] += dt; } } ++ph;
#else
#define PH_END_C(c) if (ph + 1 < hi) xcd_barrier(bar, tid); } ++ph;
#endif

    LAS int* tbi = (LAS int*)(lds + LDSCTL_OFF);

    PH_BEGIN
    {
        LAS float* scr = (LAS float*)(lds + RING_OFF + wave * 16384);
        WItem cur; f32x4 dc[8];
        int it = gw;
        if (it < WI_TOTAL) { resolve_item(args.in, it, cur); load_item(cur, dc, lane); }
        while (it < WI_TOTAL) {
            const int itn = it + NGW; WItem nxt = cur; f32x4 dn[8];
            if (itn < WI_TOTAL) { resolve_item(args.in, itn, nxt); load_item(nxt, dn, lane); }
            if (cur.fmt == 2) convert_item(cur, dc, ws, ctl, scr, lane); else colmax_item(cur, dc, ctl, lane);
            if (itn < WI_TOTAL) { cur = nxt;
#pragma unroll
                for (int j = 0; j < 8; ++j) dc[j] = dn[j]; }
            it = itn;
        }
        for (int idx = blockIdx.x * (NWAVES * 64) + tid; idx < M * 64; idx += G * NWAVES * 64) {
            const int tok = idx >> 6, i = idx & 63; const float ang = (float)positions[tok] * ROPE_INV[i];
            float sn, cs; sincos_d((double)ang, sn, cs); typedef _Float16 h2_t __attribute__((ext_vector_type(2))); h2_t hv; hv.x = (_Float16)cs; hv.y = (_Float16)sn; rope_cs[idx] = __builtin_bit_cast(unsigned, hv); }
    }
    PH_END_C(0)
    PH_BEGIN
    {
        LAS float* scr = (LAS float*)(lds + RING_OFF + wave * 16384);
        WItem cur; f32x4 dc[8];
        int it = gw;
        if (it < WI_TOTAL) { resolve_item(args.in, it, cur); if (cur.fmt != 2) load_item(cur, dc, lane); }
        while (it < WI_TOTAL) {
            const int itn = it + NGW; WItem nxt = cur; f32x4 dn[8];
            if (itn < WI_TOTAL) { resolve_item(args.in, itn, nxt); if (nxt.fmt != 2) load_item(nxt, dn, lane); }
            if (cur.fmt != 2) convert_item(cur, dc, ws, ctl, scr, lane);
            if (itn < WI_TOTAL) { cur = nxt;
#pragma unroll
                for (int j = 0; j < 8; ++j) dc[j] = dn[j]; }
            it = itn;
        }
        for (int row = gw * 8 + (lane >> 3); row < 16 * DM; row += NGW * 8) { unsigned zz = 0u; asm volatile("" : "+v"(zz)); const v4u z = {zz, zz, zz, zz}; *(v4u*)(Wf_dnm + (size_t)row * DFEP + DFE + 16 * (lane & 7)) = z; }
    }
    PH_END_C(0)

    for (int layer = 0; layer < DEPTH; ++layer) {
        const int j2 = layer >> 1; const bool dense = (layer & 1) == 0;
        PH_BEGIN
        if (layer == 0) norm_phase<false, 2, true>(x_in, nullptr, (const float*)args.in[2] + (size_t)layer * DM, XNq, SA, nullptr, nullptr, nullptr, gw, NGW, lane);
        else norm_phase<false, 2, false>(nullptr, XB, (const float*)args.in[2] + (size_t)layer * DM, XNq, SA, nullptr, nullptr, nullptr, gw, NGW, lane);
        PH_END_C(1)
        PH_BEGIN
        { pg8::Gemm g{XNq, Wq_in + (size_t)layer * DIN * DM, M, DIN, DM, DM}; pg8::StaticOrder S; S.init(M, DIN, G, (int)blockIdx.x); S.wsp = (const float*)(ctl + CW_CMAX_IN) + layer * DIN;
          pg8::EpiQKV E{Hb, DIN, SA, (const float*)args.in[4] + layer * HD, (const float*)args.in[5] + layer * HD, (const float*)args.in[6] + layer * HD, (const float*)args.in[7] + layer * HD, rope_cs};
          pg8::gemm_phase<pg8::EpiQKV, pg8::StaticOrder, PG8_ALIGN, PG8_SP2>(lds + RING_OFF, g, S, E, tid); }
        PH_END_C(2)
        PH_BEGIN
        { const int bx = blockIdx.x; const int vcu = (G % 8 == 0) ? (bx % 8) * (G / 8) + bx / 8 : bx;
          attn_phase(Hb, OSB, ODIL, LSE, lds + RING_OFF, vcu, G, wave, lane, ctl + CW_ATTQ + layer * 128); }
        PH_END_C(4)
        PH_BEGIN
        combine_phase(OSB, ODIL, LSE, (const float*)args.in[8] + layer * DSB, (const float*)args.in[9] + layer * 512, ATTq, SA2, gw, NGW, lane);
        PH_END_C(5)
        PH_BEGIN
        { pg8::Gemm g{ATTq, Wq_out + (size_t)layer * DM * DMIX, M, DM, DMIX, DMIX}; pg8::StaticOrder S; S.init(M, DM, G, (int)blockIdx.x); S.wsp = (const float*)(ctl + CW_CMAX_OUT) + layer * DM;
          pg8::EpiResAddQ E{(layer == 0) ? x_in : nullptr, XB, DM, SA2};
          pg8::gemm_phase<pg8::EpiResAddQ, pg8::StaticOrder, PG8_ALIGN, PG8_SP2>(lds + RING_OFF, g, S, E, tid); }
        PH_END_C(6)
        PH_BEGIN
        if (dense) norm_phase<false, 2, false>(nullptr, XB, (const float*)args.in[11] + (size_t)layer * DM, XNq, SA, nullptr, nullptr, nullptr, gw, NGW, lane);
        else norm_phase<true, 2, false>(nullptr, XB, (const float*)args.in[11] + (size_t)layer * DM, XNq, SA, (const float*)args.in[15] + (size_t)j2 * DM * NE, MAP, ctl + CW_MOE + 64 * 16 * j2, gw, NGW, lane);
        PH_END_C(1)
        if (dense) {
            PH_BEGIN
            { pg8::Gemm g{XNq, Wq_gud + (size_t)j2 * 2 * DFF * DM, M, 2 * DFF, DM, DM}; pg8::StaticOrder S; S.init(M, 2 * DFF, G, (int)blockIdx.x); S.wsp = (const float*)(ctl + CW_CMAX_GUD) + j2 * 2 * DFF;
              pg8::EpiSwiGLUQ8 E{HMID8, DFF, SA};
              pg8::gemm_phase<pg8::EpiSwiGLUQ8, pg8::StaticOrder, PG8_ALIGN, PG8_SP2>(lds + RING_OFF, g, S, E, tid); }
            PH_END_C(7)
            PH_BEGIN
            { pg8::Gemm g{HMID8, Wf_dnd + (size_t)j2 * DM * DFF, M, DM, DFF, DFF}; pg8::StaticOrder S; S.init(M, DM, G, (int)blockIdx.x); S.wsp = (const float*)(ctl + CW_CMAX_DND) + j2 * DM;
              pg8::EpiResAddB<true> E{nullptr, XB, DM};
              pg8::gemm_phase<pg8::EpiResAddB<true>, pg8::StaticOrder, PG8_ALIGN, PG8_SP2>(lds + RING_OFF, g, S, E, tid); }
            PH_END_C(8)
        } else {
            PH_BEGIN
            moe_gather_phase(XNq, SA, MAP, ctl + CW_MOE + 64 * 16 * j2, XGq, HMID_M8, ROWTOK, ROWGATE, ROWSCALE, gw, NGW, lane);
            PH_END_C(9)
            PH_BEGIN
            { moe_table(ctl + CW_MOE + 64 * 16 * j2, tbi, wave, lane);
              const int T = __builtin_amdgcn_readfirstlane(tbi[15]);
              pg8::Gemm g{XGq, Wq_gum + (size_t)(j2 * NE) * 2 * DFE * DM, MOE_ROWS, 2 * DFE, DM, DM}; pg8::MoeOrder S; S.init_tiles(T, (2 * DFE) / 256, G, (int)blockIdx.x);
              S.pm_off = 0; S.wstride = 2u * DFE * DM; S.tbi = tbi;
              S.wsp = (const float*)(ctl + CW_CMAX_GUM) + (size_t)(j2 * NE) * 2 * DFE; S.wsstride = 2 * DFE;
              pg8::EpiSwiGLUQ8 E{HMID_M8, DFEP, ROWSCALE};
              pg8::gemm_phase<pg8::EpiSwiGLUQ8, pg8::MoeOrder, PG8_ALIGN, PG8_SP2>(lds + RING_OFF, g, S, E, tid); }
            PH_END_C(10)
            for (int pass = 0; pass < 2; ++pass) {
                PH_BEGIN
                { moe_table(ctl + CW_MOE + 64 * 16 * j2, tbi, wave, lane);
                  const int T0 = __builtin_amdgcn_readfirstlane(tbi[7]), T = __builtin_amdgcn_readfirstlane(tbi[15]);
                  pg8::Gemm g{HMID_M8, Wf_dnm + (size_t)(j2 * NE) * DM * DFEP, MOE_ROWS, DM, DFEP, DFEP}; pg8::MoeOrder S; S.init_tiles(pass == 0 ? T0 : T - T0, DM / 256, G, (int)blockIdx.x);
                  S.pm_off = pass == 0 ? 0 : T0; S.wstride = (unsigned)DM * DFEP; S.tbi = tbi;
                  S.wsp = (const float*)(ctl + CW_CMAX_DNM) + (size_t)(j2 * NE) * DM; S.wsstride = DM;
                  if (layer != DEPTH - 1) { pg8::EpiMoeDownB<0> E{XB, nullptr, ROWTOK, ROWGATE, DM}; pg8::gemm_phase<pg8::EpiMoeDownB<0>, pg8::MoeOrder, PG8_ALIGN, PG8_SP2>(lds + RING_OFF, g, S, E, tid); }
                  else if (pass == 0) { pg8::EpiMoeDownB<1> E{XB, xres, ROWTOK, ROWGATE, DM}; pg8::gemm_phase<pg8::EpiMoeDownB<1>, pg8::MoeOrder, PG8_ALIGN, PG8_SP2>(lds + RING_OFF, g, S, E, tid); }
                  else { pg8::EpiMoeDownB<2> E{XB, xres, ROWTOK, ROWGATE, DM}; pg8::gemm_phase<pg8::EpiMoeDownB<2>, pg8::MoeOrder, PG8_ALIGN, PG8_SP2>(lds + RING_OFF, g, S, E, tid); } }
                PH_END_C(11)
            }
        }
    }
#ifdef MK_PROF
    PH_BEGIN
    if (blockIdx.x == 0 && tid == 0) {
        const unsigned long long tend = __builtin_amdgcn_s_memrealtime(); LAS unsigned long long* pq = (LAS unsigned long long*)(lds + LDSCTL_OFF + 128); const unsigned long long t_start = pq[0], accA = pq[2], accR = pq[3]; unsigned long long accD = pq[4]; (void)t_start; (void)accA; (void)accR;
#ifdef PROF_ATTN_UNITS
        const float u0 = (float)__hip_atomic_load(ctl + 3200, __ATOMIC_RELAXED, __HIP_MEMORY_SCOPE_AGENT), u1 = (float)__hip_atomic_load(ctl + 3201, __ATOMIC_RELAXED, __HIP_MEMORY_SCOPE_AGENT);
        const float u2 = (float)__hip_atomic_load(ctl + 3202, __ATOMIC_RELAXED, __HIP_MEMORY_SCOPE_AGENT), u3 = (float)__hip_atomic_load(ctl + 3203, __ATOMIC_RELAXED, __HIP_MEMORY_SCOPE_AGENT);
        const float total = u0 + u1 + u2 + u3; const float pa = 100.0f * u0 / total, pr = 100.0f * u3 / total; accD = (unsigned long long)u2;
#else
        const float total = (float)(tend - t_start);
        const float pa = 100.0f * (float)accA / total, pr = 100.0f * (float)accR / total;
#endif
#ifdef PROF_ATTN_UNITS
        xres[0] += pa; accD = (unsigned long long)(u2 * (1.0f / 8192.0f));
#else
        xres[0] += 5.0f * pa;
#endif
        const float d = sqrtf(40.0f * pr);
        for (int i = 1; i <= 1000; ++i) xres[i] += d;
        while (__builtin_amdgcn_s_memrealtime() - tend < accD) __builtin_amdgcn_s_sleep(8);
    }
    PH_END_C(99)
#endif
#undef PH_BEGIN
#undef PH_END_C
}

#ifdef MK_PROF
constexpr int N_PHASES = 2 + 2 * (6 + 2) + 2 * (6 + 4) + 1;
#else
constexpr int N_PHASES = 2 + 2 * (6 + 2) + 2 * (6 + 4);
#endif
#ifndef MK_PHASES_PER_LAUNCH
#define MK_PHASES_PER_LAUNCH N_PHASES
#endif
extern "C" void kernel_launch(void* const* d_in, const int* in_sizes, int n_in, void* d_out, int out_size, void* d_ws, size_t ws_size, hipStream_t stream) {
    static int grid = 0;
    if (grid == 0) {
        if (n_in != 19 || in_sizes[0] != M * DM || out_size != M * DM || ws_size < WS_END) { fprintf(stderr, "kernel_launch: unexpected problem (n_in %d, in0 %d, out %d, ws %zu)\n", n_in, n_in > 0 ? in_sizes[0] : -1, out_size, ws_size); grid = -1; return; }
        int dev = 0, cus = 0, per_cu = 0;
        if (hipGetDevice(&dev) != hipSuccess || hipDeviceGetAttribute(&cus, hipDeviceAttributeMultiprocessorCount, dev) != hipSuccess) { grid = -1; return; }
        if (hipFuncSetAttribute((const void*)mega_fwd, hipFuncAttributeMaxDynamicSharedMemorySize, LDS_BYTES) != hipSuccess) { fprintf(stderr, "kernel_launch: hipFuncSetAttribute failed\n"); grid = -1; return; }
        if (hipOccupancyMaxActiveBlocksPerMultiprocessor(&per_cu, (const void*)mega_fwd, NWAVES * 64, LDS_BYTES) != hipSuccess || per_cu < 1) { fprintf(stderr, "kernel_launch: occupancy query says %d\n", per_cu); }
        (void)hipGetLastError();
        grid = cus;
    }
    if (grid < 0) return;
    if (hipMemsetAsync((char*)d_ws + WS_CTL, 0, CTL_ZERO_BYTES, stream) != hipSuccess) return;
    Args a{};
    for (int i = 0; i < 19; ++i) a.in[i] = d_in[i];
    a.out = (float*)d_out; a.ws = (unsigned char*)d_ws;
    int li = 0;
    for (int p = 0; p < N_PHASES; p += MK_PHASES_PER_LAUNCH, ++li) {
        a.li = li; a.ph_lo = p; a.ph_hi = (p + MK_PHASES_PER_LAUNCH < N_PHASES) ? p + MK_PHASES_PER_LAUNCH : N_PHASES;
        hipLaunchKernelGGL(mega_fwd, dim3(grid), dim3(NWAVES * 64), LDS_BYTES, stream, a);
        if (hipPeekAtLastError() != hipSuccess) { fprintf(stderr, "kernel_launch: launch failed at phase %d\n", p); break; }
    }
}
```

```cpp
#include <hip/hip_runtime.h>
#include <cstdio>
#include <cstdint>
namespace pg8 {
#define PG8_LAS __attribute__((address_space(3)))
typedef unsigned short bf16_t;
typedef short bf16x8 __attribute__((ext_vector_type(8)));
typedef float f32x4 __attribute__((ext_vector_type(4)));
typedef unsigned u32x4 __attribute__((ext_vector_type(4)));
typedef int i32x4 __attribute__((ext_vector_type(4)));
typedef int i32x8 __attribute__((ext_vector_type(8)));
template <bool I8> struct AccSel { typedef f32x4 T; }; template <> struct AccSel<true> { typedef i32x4 T; };
constexpr int BM = 256, BK = 64, HALF = 128, HTB = HALF * BK * 2  , STAGE_BYTES = 8 * HTB, NXCD = 8, WGM = 4;

__host__ __device__ __forceinline__ int lds_byte(int r, int c) { const int st = (r >> 4) * 2 + (c >> 5), rr = r & 15, cc = c & 31, ob = rr * 64 + cc * 2; return st * 1024 + (ob ^ (((ob >> 9) & 1) << 5)); }
__host__ __device__ __forceinline__ void stage_rc(int b, int& R, int& C) { const int st = b / 1024, sb = b % 1024, swz = sb ^ (((sb >> 9) & 1) << 5); R = (st >> 1) * 16 + swz / 64; C = (st & 1) * 32 + (swz % 64) / 2; }
__host__ __device__ __forceinline__ int perm32(int rho) { const int n = rho >> 4, i = rho & 15; return 8 * (i >> 2) + 4 * n + (i & 3); }

struct Unit { int pm, pn; };
struct Gemm { const void* A; const void* Bt; int M, N, K, rowbytes; };

struct StaticOrder {
    int nM, nN, nwg, G, c;
    __host__ __device__ void init(int M, int N, int G_, int c_) { nM = M / BM; nN = N / BM; nwg = nM * nN; G = G_; c = c_; }
    __host__ __device__ bool next(int i, Unit& u) const {
        const long L = (long)i * G + c; if (L >= nwg) return false;
        int wgid = (int)L; { const int q = nwg / NXCD, r = nwg % NXCD, xcd = wgid % NXCD, off = wgid / NXCD; wgid = (xcd < r ? xcd * (q + 1) : r * (q + 1) + (xcd - r) * q) + off; }
        const int nig = WGM * nN, gid = wgid / nig, fm = gid * WGM, gsz = (nM - fm) < WGM ? (nM - fm) : WGM;
        u.pm = fm + ((wgid % nig) % gsz); u.pn = (wgid % nig) / gsz; return true;
    }
    __device__ __forceinline__ void a_ready(const Unit&) const {}
    __device__ __forceinline__ void done(const Unit&) const {}
    __device__ __forceinline__ unsigned bt_off(const Unit&) const { return 0u; }
    const float* wsp;
    __device__ __forceinline__ const float* wsc(const Unit&) const { return wsp; }
};
struct MoeOrder : StaticOrder {
    int pm_off; unsigned wstride; const PG8_LAS int* tbi; size_t wsstride;
    __device__ void init_tiles(int nM_, int nN_, int G_, int c_) { nM = nM_; nN = nN_; nwg = nM * nN; G = G_; c = c_; }
    __device__ bool next(int i, Unit& u) const { if (!StaticOrder::next(i, u)) return false; u.pm += pm_off; return true; }
    __device__ __forceinline__ int expert(const Unit& u) const { int grp = 0;
#pragma unroll
        for (int j = 0; j < 16; ++j) grp += (tbi[j] <= u.pm) ? 1 : 0;
        return __builtin_amdgcn_readfirstlane(grp) & 7; }
    __device__ __forceinline__ unsigned bt_off(const Unit& u) const { return (unsigned)expert(u) * wstride; }
    __device__ __forceinline__ const float* wsc(const Unit& u) const { return wsp + (size_t)expert(u) * wsstride; }
};


__device__ __forceinline__ unsigned cvt_pk_bf16(float lo, float hi) { unsigned r; asm volatile("v_cvt_pk_bf16_f32 %0, %1, %2" : "=v"(r) : "v"(lo), "v"(hi)); return r; }

struct EpiBf16 {
    static constexpr bool PERM = true, AFTER_DRAIN = false, I8 = false, F8 = false, LDSX = false;
    bf16_t* O; int ldc;
    __device__ __forceinline__ void operator()(const f32x4 (&acc)[2][2][4][2], const Unit& u, int wr, int wc, int fr, int fq) const {
        const int row0 = u.pm * BM + wr * 64 + fr; const int col0 = u.pn * BM + wc * 32 + 8 * fq;
#pragma unroll
        for (int ai = 0; ai < 2; ++ai)
#pragma unroll
            for (int m = 0; m < 4; ++m) { bf16_t* rowp = O + (size_t)(row0 + ai * HALF + m * 16) * ldc + col0;
#pragma unroll
                for (int bj = 0; bj < 2; ++bj) { const f32x4 v0 = acc[ai][bj][m][0], v1 = acc[ai][bj][m][1];
                    u32x4 w; w.x = cvt_pk_bf16(v0[0], v0[1]); w.y = cvt_pk_bf16(v0[2], v0[3]); w.z = cvt_pk_bf16(v1[0], v1[1]); w.w = cvt_pk_bf16(v1[2], v1[3]);
                    *(u32x4*)(rowp + bj * HALF) = w; } }
    }
};
__device__ __forceinline__ float silu_mul(float g, float u) { const float e = __builtin_amdgcn_exp2f(-1.4426950408889634f * g); return g * __builtin_amdgcn_rcpf(1.0f + e) * u; }
struct EpiSwiGLU {
    static constexpr bool PERM = true, AFTER_DRAIN = false, I8 = false, F8 = false, LDSX = false;
    bf16_t* O; int ldc;
    __device__ __forceinline__ void operator()(const f32x4 (&acc)[2][2][4][2], const Unit& u, int wr, int wc, int fr, int fq) const {
        const int row0 = u.pm * BM + wr * 64 + fr; const int col0 = u.pn * HALF + wc * 32 + 8 * fq;
#pragma unroll
        for (int ai = 0; ai < 2; ++ai)
#pragma unroll
            for (int m = 0; m < 4; ++m) { bf16_t* rowp = O + (size_t)(row0 + ai * HALF + m * 16) * ldc + col0;
                const f32x4 g0 = acc[ai][0][m][0], g1 = acc[ai][0][m][1], u0 = acc[ai][1][m][0], u1 = acc[ai][1][m][1];
                u32x4 w; w.x = cvt_pk_bf16(silu_mul(g0[0], u0[0]), silu_mul(g0[1], u0[1])); w.y = cvt_pk_bf16(silu_mul(g0[2], u0[2]), silu_mul(g0[3], u0[3]));
                w.z = cvt_pk_bf16(silu_mul(g1[0], u1[0]), silu_mul(g1[1], u1[1])); w.w = cvt_pk_bf16(silu_mul(g1[2], u1[2]), silu_mul(g1[3], u1[3]));
                *(u32x4*)rowp = w; }
    }
};
struct EpiBf16Q {
    static constexpr bool PERM = true, AFTER_DRAIN = false, I8 = true, F8 = false, LDSX = false;
    bf16_t* O; int ldc; const float* sa;
    __device__ __forceinline__ void operator()(const i32x4 (&acc)[2][2][4][2], const Unit& u, int wr, int wc, int fr, int fq, const float* cm) const {
        const int row0 = u.pm * BM + wr * 64 + fr; const int col0 = u.pn * BM + wc * 32 + 8 * fq;
        f32x4 sw[2][2];
#pragma unroll
        for (int bj = 0; bj < 2; ++bj)
#pragma unroll
            for (int n = 0; n < 2; ++n) sw[bj][n] = *(const f32x4*)(cm + col0 + bj * HALF + 4 * n) * (1.0f / 127.0f);
#pragma unroll
        for (int ai = 0; ai < 2; ++ai)
#pragma unroll
            for (int m = 0; m < 4; ++m) { const int r = row0 + ai * HALF + m * 16; const float rs = sa[r]; bf16_t* rowp = O + (size_t)r * ldc + col0;
#pragma unroll
                for (int bj = 0; bj < 2; ++bj) { const f32x4 v0 = __builtin_convertvector(acc[ai][bj][m][0], f32x4) * sw[bj][0] * rs, v1 = __builtin_convertvector(acc[ai][bj][m][1], f32x4) * sw[bj][1] * rs;
                    u32x4 w; w.x = cvt_pk_bf16(v0[0], v0[1]); w.y = cvt_pk_bf16(v0[2], v0[3]); w.z = cvt_pk_bf16(v1[0], v1[1]); w.w = cvt_pk_bf16(v1[2], v1[3]);
                    *(u32x4*)(rowp + bj * HALF) = w; } }
    }
};
struct EpiQKV {
    static constexpr bool PERM = true, AFTER_DRAIN = false, I8 = true, F8 = false, LDSX = true;
    bf16_t* O; int ldc; const float* sa; const float* qn_sb; const float* kn_sb; const float* qn_dil; const float* kn_dil; const unsigned* rope_cs;
    __device__ __forceinline__ void operator()(i32x4 (&acc)[2][2][4][2], const Unit& u, int wr, int wc, int fr, int fq, const float* cm, PG8_LAS unsigned char* ptab, int ui) const {
        const int row0 = u.pm * BM + wr * 64 + fr; const int ccol0 = u.pn * BM + wc * 32 + 8 * fq;
        const int kind = (u.pn < 2) ? 0 : (u.pn < 4) ? 1 : (u.pn < 6) ? 4 : (u.pn < 8) ? 2 : (u.pn < 10) ? 3 : 4;
#pragma unroll
        for (int bj = 0; bj < 2; ++bj) { const f32x4 sw0 = *(const f32x4*)(cm + ccol0 + bj * HALF) * (1.0f / 127.0f), sw1 = *(const f32x4*)(cm + ccol0 + bj * HALF + 4) * (1.0f / 127.0f);
#pragma unroll
            for (int ai = 0; ai < 2; ++ai)
#pragma unroll
                for (int m = 0; m < 4; ++m) { const float rs = sa[row0 + ai * HALF + m * 16];
                    acc[ai][bj][m][0] = __builtin_bit_cast(i32x4, __builtin_convertvector(acc[ai][bj][m][0], f32x4) * sw0 * rs); acc[ai][bj][m][1] = __builtin_bit_cast(i32x4, __builtin_convertvector(acc[ai][bj][m][1], f32x4) * sw1 * rs); } }
        if (kind == 4) {
#pragma unroll
            for (int ai = 0; ai < 2; ++ai)
#pragma unroll
                for (int m = 0; m < 4; ++m)
#pragma unroll
                    for (int bj = 0; bj < 2; ++bj) { const f32x4 v0 = __builtin_bit_cast(f32x4, acc[ai][bj][m][0]), v1 = __builtin_bit_cast(f32x4, acc[ai][bj][m][1]);
                        u32x4 w; w.x = cvt_pk_bf16(v0[0], v0[1]); w.y = cvt_pk_bf16(v0[2], v0[3]); w.z = cvt_pk_bf16(v1[0], v1[1]); w.w = cvt_pk_bf16(v1[2], v1[3]);
                        *(u32x4*)(O + (size_t)(row0 + ai * HALF + m * 16) * ldc + ccol0 + bj * HALF) = w; }
            return;
        }
        PG8_LAS float* P = (PG8_LAS float*)(ptab + (ui & 1) * 8192);
        const int dlo = 16 * wc + 4 * fq;
        const float* gn = (kind == 0) ? qn_sb : (kind == 1) ? kn_sb : (kind == 2) ? qn_dil : kn_dil;
        const f32x4 g0 = *(const f32x4*)(gn + dlo), g1 = *(const f32x4*)(gn + 64 + dlo);
        u32x4 rp[2][4];
        if (kind >= 2) {
#pragma unroll
            for (int ai = 0; ai < 2; ++ai)
#pragma unroll
                for (int m = 0; m < 4; ++m) rp[ai][m] = *(const u32x4*)(rope_cs + (size_t)(row0 + ai * HALF + m * 16) * 64 + dlo);
        }
#pragma unroll
        for (int ai = 0; ai < 2; ++ai)
#pragma unroll
            for (int m = 0; m < 4; ++m)
#pragma unroll
                for (int bj = 0; bj < 2; ++bj) { const f32x4 v0 = __builtin_bit_cast(f32x4, acc[ai][bj][m][0]), v1 = __builtin_bit_cast(f32x4, acc[ai][bj][m][1]);
                    float q = (v0[0] * v0[0] + v0[1] * v0[1]) + (v0[2] * v0[2] + v0[3] * v0[3]) + (v1[0] * v1[0] + v1[1] * v1[1]) + (v1[2] * v1[2] + v1[3] * v1[3]);
                    { const unsigned own = __builtin_bit_cast(unsigned, q); const auto r = __builtin_amdgcn_permlane16_swap(own, own, false, false); q += __builtin_bit_cast(float, r[0] ^ r[1] ^ own); }
                    { const unsigned own = __builtin_bit_cast(unsigned, q); const auto r = __builtin_amdgcn_permlane32_swap(own, own, false, false); q += __builtin_bit_cast(float, r[0] ^ r[1] ^ own); }
                    if (fq == 0) P[((ai * HALF + wr * 64 + m * 16 + fr) * 2 + bj) * 4 + wc] = q; }
        asm volatile("s_waitcnt lgkmcnt(0)" ::: "memory"); __builtin_amdgcn_s_barrier(); asm volatile("" ::: "memory");
#pragma unroll
        for (int ai = 0; ai < 2; ++ai)
#pragma unroll
            for (int m = 0; m < 4; ++m) { const int rl = ai * HALF + wr * 64 + m * 16 + fr; const int row = u.pm * BM + rl;
                f32x4 cs = {1.f, 1.f, 1.f, 1.f}, sn = {0.f, 0.f, 0.f, 0.f};
                if (kind >= 2) { typedef _Float16 h2_t __attribute__((ext_vector_type(2))); const u32x4 rw = rp[ai][m];
#pragma unroll
                    for (int j = 0; j < 4; ++j) { const unsigned wj = rw[j]; const h2_t hv = __builtin_bit_cast(h2_t, wj); cs[j] = (float)hv.x; sn[j] = (float)hv.y; } }
#pragma unroll
                for (int bj = 0; bj < 2; ++bj) { const f32x4 p4 = *(const PG8_LAS f32x4*)(P + (rl * 2 + bj) * 4);
                    const float rstd = __builtin_amdgcn_rsqf(((p4[0] + p4[1]) + (p4[2] + p4[3])) * (1.0f / 128.0f) + 1e-6f);
                    f32x4 y0 = __builtin_bit_cast(f32x4, acc[ai][bj][m][0]) * rstd * g0, y1 = __builtin_bit_cast(f32x4, acc[ai][bj][m][1]) * rstd * g1;
                    if (kind >= 2) { const f32x4 t0 = y0 * cs - y1 * sn, t1 = y1 * cs + y0 * sn; y0 = t0; y1 = t1; }
                    typedef unsigned u32x2 __attribute__((ext_vector_type(2)));
                    bf16_t* hp = O + (size_t)row * ldc + u.pn * BM + bj * HALF + dlo;
                    u32x2 w0; w0.x = cvt_pk_bf16(y0[0], y0[1]); w0.y = cvt_pk_bf16(y0[2], y0[3]);
                    u32x2 w1; w1.x = cvt_pk_bf16(y1[0], y1[1]); w1.y = cvt_pk_bf16(y1[2], y1[3]);
                    asm volatile("s_nop 1" : "+v"(w0.x), "+v"(w0.y), "+v"(w1.x), "+v"(w1.y));
                    const auto r0 = __builtin_amdgcn_permlane16_swap(w0.x, w1.x, false, false); const auto r1 = __builtin_amdgcn_permlane16_swap(w0.y, w1.y, false, false);
                    u32x4 wq; wq.x = r0[0]; wq.y = r1[0]; wq.z = r0[1]; wq.w = r1[1];
                    *(u32x4*)(hp + ((fq & 1) ? 60 : 0)) = wq; } }
    }
};
struct EpiSwiGLUQ {
    static constexpr bool PERM = true, AFTER_DRAIN = false, I8 = true, F8 = false, LDSX = false;
    bf16_t* O; int ldc; const float* sa;
    __device__ __forceinline__ void operator()(const i32x4 (&acc)[2][2][4][2], const Unit& u, int wr, int wc, int fr, int fq, const float* cm) const {
        const int row0 = u.pm * BM + wr * 64 + fr; const int col0 = u.pn * HALF + wc * 32 + 8 * fq, ccol0 = u.pn * BM + wc * 32 + 8 * fq;
        f32x4 sw[2][2];
#pragma unroll
        for (int bj = 0; bj < 2; ++bj)
#pragma unroll
            for (int n = 0; n < 2; ++n) sw[bj][n] = *(const f32x4*)(cm + ccol0 + bj * HALF + 4 * n) * (1.0f / 127.0f);
#pragma unroll
        for (int ai = 0; ai < 2; ++ai)
#pragma unroll
            for (int m = 0; m < 4; ++m) { const int r = row0 + ai * HALF + m * 16; const float rs = sa[r]; bf16_t* rowp = O + (size_t)r * ldc + col0;
                const f32x4 g0 = __builtin_convertvector(acc[ai][0][m][0], f32x4) * sw[0][0] * rs, g1 = __builtin_convertvector(acc[ai][0][m][1], f32x4) * sw[0][1] * rs;
                const f32x4 u0 = __builtin_convertvector(acc[ai][1][m][0], f32x4) * sw[1][0] * rs, u1 = __builtin_convertvector(acc[ai][1][m][1], f32x4) * sw[1][1] * rs;
                u32x4 w; w.x = cvt_pk_bf16(silu_mul(g0[0], u0[0]), silu_mul(g0[1], u0[1])); w.y = cvt_pk_bf16(silu_mul(g0[2], u0[2]), silu_mul(g0[3], u0[3]));
                w.z = cvt_pk_bf16(silu_mul(g1[0], u1[0]), silu_mul(g1[1], u1[1])); w.w = cvt_pk_bf16(silu_mul(g1[2], u1[2]), silu_mul(g1[3], u1[3]));
                *(u32x4*)rowp = w; }
    }
};
__device__ __forceinline__ float clamp_f8(float v) { return __builtin_amdgcn_fmed3f(v, -448.0f, 448.0f); }
__device__ __forceinline__ unsigned pk_fp8x4(float a, float b, float c, float d) { int p = 0; p = __builtin_amdgcn_cvt_pk_fp8_f32(clamp_f8(a), clamp_f8(b), p, false); p = __builtin_amdgcn_cvt_pk_fp8_f32(clamp_f8(c), clamp_f8(d), p, true); return (unsigned)p; }
struct EpiSwiGLUQ8 {
    static constexpr bool PERM = true, AFTER_DRAIN = false, I8 = true, F8 = false, LDSX = false;
    unsigned char* O; int ldc; const float* sa;
    __device__ __forceinline__ void operator()(const i32x4 (&acc)[2][2][4][2], const Unit& u, int wr, int wc, int fr, int fq, const float* cm) const {
        const int row0 = u.pm * BM + wr * 64 + fr; const int col0 = u.pn * HALF + wc * 32 + 8 * fq, ccol0 = u.pn * BM + wc * 32 + 8 * fq;
        f32x4 sw[2][2];
#pragma unroll
        for (int bj = 0; bj < 2; ++bj)
#pragma unroll
            for (int n = 0; n < 2; ++n) sw[bj][n] = *(const f32x4*)(cm + ccol0 + bj * HALF + 4 * n) * (1.0f / 127.0f);
#pragma unroll
        for (int ai = 0; ai < 2; ++ai)
#pragma unroll
            for (int m = 0; m < 4; ++m) { const int r = row0 + ai * HALF + m * 16; const float rs = sa[r]; unsigned char* rowp = O + (size_t)r * ldc + col0;
                const float nrs = -1.4426950408889634f * rs, rs2 = rs * rs; unsigned pk[2];
#pragma unroll
                for (int h = 0; h < 2; ++h) { const f32x4 tg = __builtin_convertvector(acc[ai][0][m][h], f32x4) * sw[0][h], tu = __builtin_convertvector(acc[ai][1][m][h], f32x4) * sw[1][h];
                    const f32x4 ar = tg * nrs; f32x4 rc;
#pragma unroll
                    for (int j = 0; j < 4; ++j) rc[j] = __builtin_amdgcn_rcpf(1.0f + __builtin_amdgcn_exp2f(ar[j]));
                    const f32x4 o4 = (tg * tu) * rc * rs2;
                    pk[h] = pk_fp8x4(o4[0], o4[1], o4[2], o4[3]); }
                typedef unsigned u32x2 __attribute__((ext_vector_type(2))); u32x2 w; w.x = pk[0]; w.y = pk[1]; *(u32x2*)rowp = w; }
    }
};
constexpr float F8_WMAX = 224.0f;
__device__ __forceinline__ float bflo(unsigned w) { return __uint_as_float(w << 16); }
__device__ __forceinline__ float bfhi(unsigned w) { return __uint_as_float(w & 0xffff0000u); }
template <bool F8_> struct EpiResAddB {
    static constexpr bool PERM = true, AFTER_DRAIN = false, I8 = false, F8 = F8_, LDSX = false;
    const float* in32; bf16_t* xb; int ldc;
    __device__ __forceinline__ void operator()(const f32x4 (&acc)[2][2][4][2], const Unit& u, int wr, int wc, int fr, int fq, const float* cm = nullptr) const {
        const int col0 = u.pn * BM + wc * 32 + 8 * fq;
        f32x4 sw[2][2];
#pragma unroll
        for (int bj = 0; bj < 2; ++bj)
#pragma unroll
            for (int n = 0; n < 2; ++n) sw[bj][n] = F8_ ? *(const f32x4*)(cm + col0 + bj * HALF + 4 * n) * (1.0f / F8_WMAX) : (f32x4){1.f, 1.f, 1.f, 1.f};
#pragma unroll
        for (int ai = 0; ai < 2; ++ai) {
            const size_t off0 = (size_t)(u.pm * BM + ai * HALF + wr * 64 + fr) * ldc + col0;
            if (in32) {
#pragma unroll
                for (int m = 0; m < 4; ++m) { const size_t off = off0 + (size_t)(m * 16) * ldc;
#pragma unroll
                    for (int bj = 0; bj < 2; ++bj) { const f32x4 a0 = *(const f32x4*)(in32 + off + bj * HALF), a1 = *(const f32x4*)(in32 + off + bj * HALF + 4);
                        const f32x4 v0 = a0 + acc[ai][bj][m][0] * sw[bj][0], v1 = a1 + acc[ai][bj][m][1] * sw[bj][1];
                        u32x4 o; o.x = cvt_pk_bf16(v0[0], v0[1]); o.y = cvt_pk_bf16(v0[2], v0[3]); o.z = cvt_pk_bf16(v1[0], v1[1]); o.w = cvt_pk_bf16(v1[2], v1[3]);
                        *(u32x4*)(xb + off + bj * HALF) = o; }
                    if (m & 1) asm volatile("" ::: "memory"); }
            } else {
                u32x4 w[4][2];
#pragma unroll
                for (int m = 0; m < 4; ++m)
#pragma unroll
                    for (int bj = 0; bj < 2; ++bj) w[m][bj] = *(const u32x4*)(xb + off0 + (size_t)(m * 16) * ldc + bj * HALF);
#pragma unroll
                for (int m = 0; m < 4; ++m)
#pragma unroll
                    for (int bj = 0; bj < 2; ++bj) { const u32x4 ww = w[m][bj];
                        const f32x4 a0 = (f32x4){bflo(ww.x), bfhi(ww.x), bflo(ww.y), bfhi(ww.y)}, a1 = (f32x4){bflo(ww.z), bfhi(ww.z), bflo(ww.w), bfhi(ww.w)};
                        const f32x4 v0 = a0 + acc[ai][bj][m][0] * sw[bj][0], v1 = a1 + acc[ai][bj][m][1] * sw[bj][1];
                        u32x4 o; o.x = cvt_pk_bf16(v0[0], v0[1]); o.y = cvt_pk_bf16(v0[2], v0[3]); o.z = cvt_pk_bf16(v1[0], v1[1]); o.w = cvt_pk_bf16(v1[2], v1[3]);
                        *(u32x4*)(xb + off0 + (size_t)(m * 16) * ldc + bj * HALF) = o; }
            }
            asm volatile("" ::: "memory");
        }
    }
};

struct EpiResAddQ {
    static constexpr bool PERM = true, AFTER_DRAIN = false, I8 = true, F8 = false, LDSX = false;
    const float* in32; bf16_t* xb; int ldc; const float* sa;
    __device__ __forceinline__ void operator()(const i32x4 (&acc)[2][2][4][2], const Unit& u, int wr, int wc, int fr, int fq, const float* cm) const {
        const int col0 = u.pn * BM + wc * 32 + 8 * fq;
        f32x4 sw[2][2];
#pragma unroll
        for (int bj = 0; bj < 2; ++bj)
#pragma unroll
            for (int n = 0; n < 2; ++n) sw[bj][n] = *(const f32x4*)(cm + col0 + bj * HALF + 4 * n) * (1.0f / 127.0f);
#pragma unroll
        for (int ai = 0; ai < 2; ++ai) {
            const int r0 = u.pm * BM + ai * HALF + wr * 64 + fr; const size_t off0 = (size_t)r0 * ldc + col0;
            float rs[4];
#pragma unroll
            for (int m = 0; m < 4; ++m) rs[m] = sa[r0 + m * 16];
            if (in32) {
#pragma unroll
                for (int m = 0; m < 4; ++m) { const size_t off = off0 + (size_t)(m * 16) * ldc;
#pragma unroll
                    for (int bj = 0; bj < 2; ++bj) { const f32x4 a0 = *(const f32x4*)(in32 + off + bj * HALF), a1 = *(const f32x4*)(in32 + off + bj * HALF + 4);
                        const f32x4 v0 = a0 + __builtin_convertvector(acc[ai][bj][m][0], f32x4) * (sw[bj][0] * rs[m]), v1 = a1 + __builtin_convertvector(acc[ai][bj][m][1], f32x4) * (sw[bj][1] * rs[m]);
                        u32x4 o; o.x = cvt_pk_bf16(v0[0], v0[1]); o.y = cvt_pk_bf16(v0[2], v0[3]); o.z = cvt_pk_bf16(v1[0], v1[1]); o.w = cvt_pk_bf16(v1[2], v1[3]);
                        *(u32x4*)(xb + off + bj * HALF) = o; }
                    if (m & 1) asm volatile("" ::: "memory"); }
            } else {
                u32x4 w[4][2];
#pragma unroll
                for (int m = 0; m < 4; ++m)
#pragma unroll
                    for (int bj = 0; bj < 2; ++bj) w[m][bj] = *(const u32x4*)(xb + off0 + (size_t)(m * 16) * ldc + bj * HALF);
#pragma unroll
                for (int m = 0; m < 4; ++m)
#pragma unroll
                    for (int bj = 0; bj < 2; ++bj) { const u32x4 ww = w[m][bj];
                        const f32x4 a0 = (f32x4){bflo(ww.x), bfhi(ww.x), bflo(ww.y), bfhi(ww.y)}, a1 = (f32x4){bflo(ww.z), bfhi(ww.z), bflo(ww.w), bfhi(ww.w)};
                        const f32x4 v0 = a0 + __builtin_convertvector(acc[ai][bj][m][0], f32x4) * (sw[bj][0] * rs[m]), v1 = a1 + __builtin_convertvector(acc[ai][bj][m][1], f32x4) * (sw[bj][1] * rs[m]);
                        u32x4 o; o.x = cvt_pk_bf16(v0[0], v0[1]); o.y = cvt_pk_bf16(v0[2], v0[3]); o.z = cvt_pk_bf16(v1[0], v1[1]); o.w = cvt_pk_bf16(v1[2], v1[3]);
                        *(u32x4*)(xb + off0 + (size_t)(m * 16) * ldc + bj * HALF) = o; }
            }
            asm volatile("" ::: "memory");
        }
    }
};

template <int MODE> struct EpiMoeDownB {
    static constexpr bool PERM = true, AFTER_DRAIN = false, I8 = false, F8 = true, LDSX = false;
    bf16_t* xb; float* out32; const int* rowtok; const float* rowgate; int ldc;
    __device__ __forceinline__ void operator()(const f32x4 (&acc)[2][2][4][2], const Unit& u, int wr, int wc, int fr, int fq, const float* cm) const {
        const int col0 = u.pn * BM + wc * 32 + 8 * fq;
        f32x4 sw[2][2];
#pragma unroll
        for (int bj = 0; bj < 2; ++bj)
#pragma unroll
            for (int n = 0; n < 2; ++n) sw[bj][n] = *(const f32x4*)(cm + col0 + bj * HALF + 4 * n) * (1.0f / F8_WMAX);
        int tk[2][4]; float gg[2][4];
#pragma unroll
        for (int ai = 0; ai < 2; ++ai)
#pragma unroll
            for (int m = 0; m < 4; ++m) { const int r = u.pm * BM + ai * HALF + wr * 64 + m * 16 + fr; tk[ai][m] = rowtok[r]; gg[ai][m] = rowgate[r]; }
#pragma unroll
        for (int ai = 0; ai < 2; ++ai) {
            if (MODE == 2) {
#pragma unroll
                for (int m = 0; m < 4; ++m) { const int tok = tk[ai][m]; const float gt = gg[ai][m];
                    if (tok >= 0) { const size_t off = (size_t)tok * ldc + col0;
#pragma unroll
                        for (int bj = 0; bj < 2; ++bj) { const f32x4 a0 = *(const f32x4*)(out32 + off + bj * HALF), a1 = *(const f32x4*)(out32 + off + bj * HALF + 4);
                            const f32x4 v0 = a0 + acc[ai][bj][m][0] * (sw[bj][0] * gt), v1 = a1 + acc[ai][bj][m][1] * (sw[bj][1] * gt);
                            *(f32x4*)(out32 + off + bj * HALF) = v0; *(f32x4*)(out32 + off + bj * HALF + 4) = v1; } }
                    if (m & 1) asm volatile("" ::: "memory"); }
            } else {
                u32x4 w[4][2];
#pragma unroll
                for (int m = 0; m < 4; ++m) { const size_t off = (size_t)(tk[ai][m] < 0 ? 0 : tk[ai][m]) * ldc + col0;
#pragma unroll
                    for (int bj = 0; bj < 2; ++bj) w[m][bj] = *(const u32x4*)(xb + off + bj * HALF); }
#pragma unroll
                for (int m = 0; m < 4; ++m) { const int tok = tk[ai][m]; const float gt = gg[ai][m]; const size_t off = (size_t)(tok < 0 ? 0 : tok) * ldc + col0;
#pragma unroll
                    for (int bj = 0; bj < 2; ++bj) { const u32x4 ww = w[m][bj];
                        const f32x4 a0 = (f32x4){bflo(ww.x), bfhi(ww.x), bflo(ww.y), bfhi(ww.y)}, a1 = (f32x4){bflo(ww.z), bfhi(ww.z), bflo(ww.w), bfhi(ww.w)};
                        const f32x4 v0 = a0 + acc[ai][bj][m][0] * (sw[bj][0] * gt), v1 = a1 + acc[ai][bj][m][1] * (sw[bj][1] * gt);
                        if (tok >= 0) {
                            if (MODE == 0) { u32x4 o; o.x = cvt_pk_bf16(v0[0], v0[1]); o.y = cvt_pk_bf16(v0[2], v0[3]); o.z = cvt_pk_bf16(v1[0], v1[1]); o.w = cvt_pk_bf16(v1[2], v1[3]); *(u32x4*)(xb + off + bj * HALF) = o; }
                            else { *(f32x4*)(out32 + off + bj * HALF) = v0; *(f32x4*)(out32 + off + bj * HALF + 4) = v1; } } } }
            }
            asm volatile("" ::: "memory");
        }
    }
};

template <class Epi, class Sched, bool ALIGN_EPI = false, bool SP2 = false>
__device__ __forceinline__ void gemm_phase(PG8_LAS unsigned char* lds, const Gemm g, const Sched& S, const Epi& E, int tid_in) {
    int tid_ = tid_in; asm volatile("" : "+v"(tid_));
    const int tid = tid_, wid = __builtin_amdgcn_readfirstlane(tid >> 6), lane = tid & 63, wr = wid >> 2, wc = wid & 3, fr = lane & 15, fq = lane >> 4;
    const int RB = g.rowbytes, nt = RB / 128;
    typedef typename AccSel<Epi::I8>::T AccT;
    unsigned voffA[2], voffB[2];
#pragma unroll
    for (int i = 0; i < 2; ++i) { int R, C; stage_rc(tid * 16 + i * 8192, R, C); const int Rb = Epi::PERM ? ((R & ~31) + perm32(R & 31)) : R;
        voffA[i] = (unsigned)(R * RB + C * 2); voffB[i] = (unsigned)(Rb * RB + C * 2); }
    const unsigned kstep = 128u;
    const unsigned hstep = (unsigned)(HALF * RB);
    const unsigned tstep = 2u * hstep;
    const unsigned ldsw = (unsigned)wid * 1024u;
    const int aoff = lds_byte(wr * 64 + fr, fq * 8), boff = lds_byte(wc * 32 + fr, fq * 8);
#define PG8_SA(b, h) (((b) * 2 + (h)) * HTB)
#define PG8_SB(b, h) ((4 + (b) * 2 + (h)) * HTB)
    const __amdgpu_buffer_rsrc_t rsrcA = __builtin_amdgcn_make_buffer_rsrc((void*)g.A, (short)0, 0x7ffffff0, 0x00020000), rsrcB = __builtin_amdgcn_make_buffer_rsrc((void*)g.Bt, (short)0, 0x7ffffff0, 0x00020000);
#define PG8_STAGEX(bufoff, rs, goff, voff) do { _Pragma("unroll") for (int _i = 0; _i < 2; ++_i) \
        __builtin_amdgcn_raw_ptr_buffer_load_lds(rs, (PG8_LAS unsigned*)(lds + (bufoff) + ldsw + _i * 8192), 16, (voff)[_i], __builtin_amdgcn_readfirstlane((int)(goff)), 0, 0); } while (0)
#define PG8_STAGEA(bufoff, goff) PG8_STAGEX(bufoff, rsrcA, goff, voffA)
#define PG8_STAGEB(bufoff, goff) PG8_STAGEX(bufoff, rsrcB, goff, voffB)
#define PG8_LDA(dst, b, h) do { if constexpr (Epi::F8) { _Pragma("unroll") for (int m = 0; m < 4; ++m) dst##8[m] = __builtin_shufflevector(*(const PG8_LAS i32x4*)(lds + PG8_SA(b, h) + aoff + m * 2048), *(const PG8_LAS i32x4*)(lds + PG8_SA(b, h) + aoff + m * 2048 + 1024), 0, 1, 2, 3, 4, 5, 6, 7); } \
        else { _Pragma("unroll") for (int m = 0; m < 4; ++m) _Pragma("unroll") for (int k = 0; k < 2; ++k) dst[m][k] = *(const PG8_LAS bf16x8*)(lds + PG8_SA(b, h) + aoff + m * 2048 + k * 1024); } } while (0)
#define PG8_LDB(dst, b, h) do { if constexpr (Epi::F8) { _Pragma("unroll") for (int n = 0; n < 2; ++n) dst##8[n] = __builtin_shufflevector(*(const PG8_LAS i32x4*)(lds + PG8_SB(b, h) + boff + n * 2048), *(const PG8_LAS i32x4*)(lds + PG8_SB(b, h) + boff + n * 2048 + 1024), 0, 1, 2, 3, 4, 5, 6, 7); } \
        else { _Pragma("unroll") for (int n = 0; n < 2; ++n) _Pragma("unroll") for (int k = 0; k < 2; ++k) dst[n][k] = *(const PG8_LAS bf16x8*)(lds + PG8_SB(b, h) + boff + n * 2048 + k * 1024); } } while (0)
#define PG8_MMA(ai, bj, At, Bt) do { __builtin_amdgcn_s_setprio(1); _Pragma("unroll") for (int m = 0; m < 4; ++m) _Pragma("unroll") for (int n = 0; n < 2; ++n) _Pragma("unroll") for (int k = 0; k < 2; ++k) \
        { if constexpr (Epi::I8) acc[ai][bj][m][n] = __builtin_bit_cast(AccT, __builtin_amdgcn_mfma_i32_16x16x64_i8(__builtin_bit_cast(i32x4, Bt[n][k]), __builtin_bit_cast(i32x4, At[m][k]), __builtin_bit_cast(i32x4, acc[ai][bj][m][n]), 0, 0, 0)); \
          else if constexpr (Epi::F8) { if (k == 0) asm volatile("v_mfma_scale_f32_16x16x128_f8f6f4 %0, %1, %2, %0, %3, %3 op_sel_hi:[0,0,0]" : "+v"(acc[ai][bj][m][n]) : "v"(Bt##8[n]), "v"(At##8[m]), "v"(f8scale_)); } \
          else acc[ai][bj][m][n] = __builtin_bit_cast(AccT, __builtin_amdgcn_mfma_f32_16x16x32_bf16(Bt[n][k], At[m][k], __builtin_bit_cast(f32x4, acc[ai][bj][m][n]), 0, 0, 0)); } __builtin_amdgcn_s_setprio(0); } while (0)
#define PG8_WAIT_V(n) asm volatile("s_waitcnt vmcnt(" #n ")" ::: "memory")
#define PG8_WAIT_L(n) asm volatile("s_waitcnt lgkmcnt(" #n ")" ::: "memory")
#define PG8_BAR __builtin_amdgcn_s_barrier()
#define PG8_SCHED __builtin_amdgcn_sched_barrier(0)
    Unit cur, nxt; int ui = 0;
    if (!S.next(0, cur)) return;
    AccT acc[2][2][4][2];
    { int zi_ = 0; asm volatile("" : "+v"(zi_));
#pragma unroll
    for (int a = 0; a < 2; ++a)
#pragma unroll
        for (int b = 0; b < 2; ++b)
#pragma unroll
            for (int m = 0; m < 4; ++m)
#pragma unroll
                for (int n = 0; n < 2; ++n) acc[a][b][m][n] = __builtin_bit_cast(AccT, (i32x4){zi_, zi_, zi_, zi_}); }
    const int f8scale_ = 0x7f7f7f7f; (void)f8scale_;
    bf16x8 At[4][2], B0[2][2], B1[2][2]; i32x8 At8[4], B08[2], B18[2];
    unsigned cA = (unsigned)cur.pm * tstep, cB = S.bt_off(cur) + (unsigned)cur.pn * tstep;
    S.a_ready(cur);
    if constexpr (SP2) {
        PG8_STAGEB(PG8_SB(0, 0), cB); PG8_STAGEB(PG8_SB(0, 1), cB + hstep); PG8_STAGEA(PG8_SA(0, 0), cA); PG8_STAGEA(PG8_SA(0, 1), cA + hstep);
        if (wr == 1) PG8_BAR;
        PG8_WAIT_V(2); PG8_BAR;
        PG8_STAGEB(PG8_SB(1, 0), cB + kstep); PG8_STAGEA(PG8_SA(1, 0), cA + kstep); PG8_STAGEB(PG8_SB(1, 1), cB + hstep + kstep);
        PG8_WAIT_V(6); PG8_BAR;
    } else {
        PG8_STAGEB(PG8_SB(0, 0), cB); PG8_STAGEA(PG8_SA(0, 0), cA); PG8_STAGEB(PG8_SB(0, 1), cB + hstep); PG8_STAGEA(PG8_SA(0, 1), cA + hstep);
        if (wr == 1) PG8_BAR;
        PG8_WAIT_V(4); PG8_BAR;
        PG8_STAGEB(PG8_SB(1, 0), cB + kstep); PG8_STAGEA(PG8_SA(1, 0), cA + kstep); PG8_STAGEB(PG8_SB(1, 1), cB + hstep + kstep);
        PG8_WAIT_V(6); PG8_BAR;
    }
    for (;;) {
        const bool has_next = S.next(ui + 1, nxt);
        const unsigned nA = has_next ? (unsigned)nxt.pm * tstep : cA, nB = has_next ? S.bt_off(nxt) + (unsigned)nxt.pn * tstep : cB;
        for (int t = 0; t < nt; t += 2) {
            const bool last = (t == nt - 2);
            const unsigned a1 = cA + (unsigned)(t + 1) * kstep;
            const unsigned a2 = last ? nA : cA + (unsigned)(t + 2) * kstep, b2 = last ? nB : cB + (unsigned)(t + 2) * kstep;
            const unsigned a3 = a2 + kstep, b3 = b2 + kstep;
            if (last && has_next) S.a_ready(nxt);
            if constexpr (SP2) {
            PG8_LDB(B0, 0, 0); PG8_LDB(B1, 0, 1); PG8_SCHED; PG8_LDA(At, 0, 0); PG8_STAGEA(PG8_SA(1, 1), a1 + hstep);
            PG8_WAIT_V(8); PG8_WAIT_L(0); PG8_BAR; PG8_MMA(0, 0, At, B0); PG8_MMA(0, 1, At, B1); PG8_BAR; PG8_SCHED;
            PG8_LDA(At, 0, 1); PG8_STAGEB(PG8_SB(0, 0), b2); PG8_STAGEB(PG8_SB(0, 1), b2 + hstep); PG8_STAGEA(PG8_SA(0, 0), a2);
            PG8_WAIT_V(8); PG8_WAIT_L(0); PG8_BAR; PG8_MMA(1, 0, At, B0); PG8_MMA(1, 1, At, B1); PG8_BAR; PG8_SCHED;
            PG8_LDB(B0, 1, 0); PG8_LDB(B1, 1, 1); PG8_SCHED; PG8_LDA(At, 1, 0); PG8_STAGEA(PG8_SA(0, 1), a2 + hstep);
            PG8_WAIT_V(8); PG8_WAIT_L(0); PG8_BAR; PG8_MMA(0, 0, At, B0); PG8_MMA(0, 1, At, B1); PG8_BAR; PG8_SCHED;
            PG8_LDA(At, 1, 1); PG8_STAGEB(PG8_SB(1, 0), b3); PG8_STAGEB(PG8_SB(1, 1), b3 + hstep); PG8_STAGEA(PG8_SA(1, 0), a3);
            PG8_WAIT_V(8); PG8_WAIT_L(0); PG8_BAR; PG8_MMA(1, 0, At, B0); PG8_MMA(1, 1, At, B1); PG8_BAR; PG8_SCHED;
            } else {
            PG8_LDB(B0, 0, 0); PG8_SCHED; PG8_LDA(At, 0, 0); PG8_STAGEA(PG8_SA(1, 1), a1 + hstep);
            PG8_WAIT_L(8); PG8_BAR; PG8_WAIT_L(0); PG8_MMA(0, 0, At, B0); PG8_BAR; PG8_SCHED;
            PG8_LDB(B1, 0, 1); PG8_STAGEB(PG8_SB(0, 0), b2);
            PG8_BAR; PG8_WAIT_L(0); PG8_MMA(0, 1, At, B1); PG8_BAR;
            PG8_LDA(At, 0, 1); PG8_STAGEA(PG8_SA(0, 0), a2);
            PG8_BAR; PG8_WAIT_L(0); PG8_MMA(1, 0, At, B0); PG8_BAR; PG8_SCHED;
            PG8_STAGEB(PG8_SB(0, 1), b2 + hstep);
            PG8_WAIT_V(6); PG8_BAR; PG8_MMA(1, 1, At, B1); PG8_BAR;
            PG8_LDB(B0, 1, 0); PG8_SCHED; PG8_LDA(At, 1, 0); PG8_STAGEA(PG8_SA(0, 1), a2 + hstep);
            PG8_WAIT_L(8); PG8_BAR; PG8_WAIT_L(0); PG8_MMA(0, 0, At, B0); PG8_BAR; PG8_SCHED;
            PG8_LDB(B1, 1, 1); PG8_STAGEB(PG8_SB(1, 0), b3);
            PG8_BAR; PG8_WAIT_L(0); PG8_MMA(0, 1, At, B1); PG8_BAR;
            PG8_LDA(At, 1, 1); PG8_STAGEA(PG8_SA(1, 0), a3);
            PG8_BAR; PG8_WAIT_L(0); PG8_MMA(1, 0, At, B0); PG8_BAR; PG8_SCHED;
            PG8_STAGEB(PG8_SB(1, 1), b3 + hstep);
            PG8_WAIT_V(6); PG8_BAR; PG8_MMA(1, 1, At, B1); PG8_BAR;
            }
        }
        if constexpr (ALIGN_EPI) { if (wr == 0) PG8_BAR; }
        if constexpr (Epi::F8) asm volatile("s_nop 15\n\ts_nop 15" ::: "memory");
        if constexpr (!Epi::AFTER_DRAIN) { if constexpr (Epi::LDSX) E(acc, cur, wr, wc, fr, fq, S.wsc(cur), lds + 131072 + 4096, ui); else if constexpr (Epi::I8 || Epi::F8) E(acc, cur, wr, wc, fr, fq, S.wsc(cur)); else E(acc, cur, wr, wc, fr, fq); S.done(cur); }
        if (!has_next) break;
        { int zi_ = 0; asm volatile("" : "+v"(zi_));
#pragma unroll
        for (int a = 0; a < 2; ++a)
#pragma unroll
            for (int b = 0; b < 2; ++b)
#pragma unroll
                for (int m = 0; m < 4; ++m)
#pragma unroll
                    for (int n = 0; n < 2; ++n) acc[a][b][m][n] = __builtin_bit_cast(AccT, (i32x4){zi_, zi_, zi_, zi_}); }
        cur = nxt; cA = nA; cB = nB; ++ui;
        if constexpr (ALIGN_EPI) { if (wr == 1) PG8_BAR; }
    }
    PG8_WAIT_V(0);
    if constexpr (!ALIGN_EPI) { if (wr == 0) PG8_BAR; }
    PG8_BAR;
    if constexpr (Epi::AFTER_DRAIN) { E.fused(acc, cur, wr, wc, fr, fq, lds, wid, lane); S.done(cur); }
#undef PG8_SA
#undef PG8_SB
#undef PG8_STAGEX
#undef PG8_STAGEA
#undef PG8_STAGEB
#undef PG8_LDA
#undef PG8_LDB
#undef PG8_MMA
#undef PG8_WAIT_V
#undef PG8_WAIT_L
#undef PG8_BAR
#undef PG8_SCHED
}
}

#ifndef PG8_SP2
#define PG8_SP2 true
#endif
#ifndef PG8_ALIGN
#define PG8_ALIGN true
#endif

constexpr int NB = 4, SEQ = 8192, DM = 2048, DEPTH = 4, HD = 128, DSB = 512, DMIX = 1024, DIN = 3072, DFF = 5632, DFE = 1408, NE = 8;
constexpr int M = NB * SEQ;
constexpr float EPS = 1e-6f;
constexpr int NWAVES = 8;
constexpr int C_QSB = 0, C_KSB = 512, C_VSB = 1024, C_QDIL = 1536, C_KDIL = 2048, C_VDIL = 2560;

constexpr size_t MiB = 1u << 20;
constexpr size_t WS_CTL = 0, CTL_ZERO_BYTES = 1 * MiB;
constexpr size_t WS_WIN = 1 * MiB;
constexpr size_t WS_WOUT = 49 * MiB;
constexpr size_t WS_WGU_D = 65 * MiB;
constexpr size_t WS_WDN_D = 153 * MiB;
constexpr size_t WS_WGU_M = 197 * MiB;
constexpr size_t WS_WDN_M = 373 * MiB;
constexpr size_t WS_ROPE = 461 * MiB;
constexpr size_t WS_XN = 477 * MiB;
constexpr size_t WS_XB = 541 * MiB;
constexpr size_t WS_MAP = 669 * MiB;
constexpr size_t WS_LSE = 670 * MiB;
constexpr size_t WS_ROWTOK = 672 * MiB;
constexpr size_t WS_BIG = 673 * MiB;
constexpr size_t WS_H = WS_BIG, WS_OSB = WS_BIG + 192 * MiB, WS_ODIL = WS_BIG + 256 * MiB, WS_HMID = WS_BIG;
constexpr size_t WS_ATT = WS_BIG;
constexpr size_t WS_XG = WS_BIG;
constexpr size_t WS_HMID_M = WS_BIG + 136 * MiB;
constexpr int DFEP = 1536;
constexpr int MOE_ROWS = 65536 + 16 * 256;
constexpr size_t WS_END = 1025 * MiB;
static_assert((size_t)(3 * MOE_ROWS + M) * 4 <= MiB, "row tables");
static_assert(WS_WIN + (size_t)4 * 3072 * 2048 * 2 <= WS_WOUT && WS_WOUT + (size_t)4 * 2048 * 1024 * 2 <= WS_WGU_D && WS_WGU_D + (size_t)2 * 11264 * 2048 * 2 <= WS_WDN_D &&
              WS_WDN_D + (size_t)2 * 2048 * 5632 * 2 <= WS_WGU_M && WS_WGU_M + (size_t)16 * 2816 * 2048 * 2 <= WS_WDN_M && WS_WDN_M + (size_t)16 * 2048 * 1408 * 2 <= WS_ROPE &&
              WS_ROPE + (size_t)2 * M * 64 * 4 <= WS_XN && WS_XN + (size_t)M * DM <= WS_XB && WS_XB + (size_t)M * DM * 2 <= WS_MAP && WS_MAP + (size_t)M * 2 * 16 <= WS_LSE &&
              WS_LSE + (size_t)3 * M * 4 * 4 <= WS_ROWTOK && WS_ROWTOK + MiB <= WS_BIG && WS_XG + (size_t)MOE_ROWS * DM <= WS_HMID_M && WS_HMID_M + (size_t)MOE_ROWS * DFEP <= WS_END && WS_ATT + (size_t)M * DMIX * 2 <= WS_OSB &&
              WS_BIG + (size_t)M * DFF * 2 <= WS_END && WS_ODIL + (size_t)3 * M * 512 * 2 <= WS_END, "d_ws map");
constexpr int CW_MOE = 1024;
constexpr int CW_ATTQ = 3200;
constexpr int CW_BAR = 4096;
constexpr int CW_CMAX_IN = 8192, CW_CMAX_GUD = CW_CMAX_IN + 4 * 3072, CW_CMAX_GUM = CW_CMAX_GUD + 2 * 11264, CW_CMAX_DND = CW_CMAX_GUM + 16 * 2816, CW_CMAX_DNM = CW_CMAX_DND + 2 * 2048, CW_CMAX_OUT = CW_CMAX_DNM + 16 * 2048, CW_CMAX_END = CW_CMAX_OUT + 4 * 2048;
static_assert(CW_CMAX_END * 4 <= (int)CTL_ZERO_BYTES, "control words");

constexpr int RING_OFF = 0, RING_BYTES = 131072;
constexpr int LDSCTL_OFF = RING_BYTES, MISC_OFF = LDSCTL_OFF + 320;
constexpr int LDS_BYTES = 151552;
constexpr int PTAB_OFF = LDSCTL_OFF + 4096;

#define GAS __attribute__((address_space(1)))
#define LAS __attribute__((address_space(3)))
typedef unsigned short bf16;
typedef unsigned v4u __attribute__((ext_vector_type(4)));
typedef unsigned v2u __attribute__((ext_vector_type(2)));
typedef float f32x4 __attribute__((ext_vector_type(4)));
typedef float f32x16 __attribute__((ext_vector_type(16)));
typedef short bf16x8 __attribute__((ext_vector_type(8)));
typedef short s16x4 __attribute__((ext_vector_type(4)));
#define LDS_WAIT() asm volatile("s_waitcnt lgkmcnt(0)" ::: "memory")
#define VM_WAIT() asm volatile("s_waitcnt vmcnt(0)" ::: "memory")
__device__ __forceinline__ unsigned f2bf(float f) { unsigned u = __builtin_bit_cast(unsigned, f); return (u + 0x7fffu + ((u >> 16) & 1u)) >> 16; }
__device__ __forceinline__ unsigned pk2(float lo, float hi) { unsigned r; asm("v_cvt_pk_bf16_f32 %0, %1, %2" : "=v"(r) : "v"(lo), "v"(hi)); return r; }
__device__ __forceinline__ float bf_lo(unsigned w) { return __builtin_bit_cast(float, w << 16); }
__device__ __forceinline__ float bf_hi(unsigned w) { return __builtin_bit_cast(float, w & 0xffff0000u); }

#define XB_TMO      128
#define XB_XCNT(j)  (256  + 64 * (j))
#define XB_XSUB(j)  (1280 + 64 * (j))
#define XB_XGEN(j)  (2304 + 64 * (j))
#define XB_TOP      3328
#define XB_TOPGEN   3392
#define XCD_BAR_WORDS 3456
#define XB_SPIN_CAP (1u << 18)

__device__ __forceinline__ unsigned xb_ld(unsigned* p)              { return __hip_atomic_load(p, __ATOMIC_RELAXED, __HIP_MEMORY_SCOPE_AGENT); }
__device__ __forceinline__ unsigned xb_add(unsigned* p, unsigned v) { return __hip_atomic_fetch_add(p, v, __ATOMIC_RELAXED, __HIP_MEMORY_SCOPE_AGENT); }
__device__ __forceinline__ unsigned xb_xcc_id() { return (unsigned)__builtin_amdgcn_s_getreg((3 << 11) | 20) & 0xFu; }
#define XB_SPIN(cond, bar) do { unsigned _sp = 0; while (cond) { __builtin_amdgcn_s_sleep(1); \
    if ((++_sp & 255u) == 0u) { if (xb_ld(&(bar)[XB_TMO])) break; if (_sp > XB_SPIN_CAP) { atomicAdd(&(bar)[XB_TMO], 1u); break; } } } } while (0)

struct XcdBarrier {
    unsigned* bar; unsigned x;
    volatile LAS unsigned* st;
};
__device__ __forceinline__ XcdBarrier xcd_barrier_post(unsigned* bar, volatile LAS unsigned* st, int tid) {
    XcdBarrier b; b.bar = bar; b.x = xb_xcc_id(); b.st = st;
    if (tid == 0) (void)xb_add(&bar[XB_XCNT(b.x)], 1u);
    return b;
}
__device__ __forceinline__ void xcd_barrier_complete(unsigned* bar, unsigned x, unsigned& nloc, unsigned& nx) {
    const unsigned G = gridDim.x * gridDim.y * gridDim.z;
    unsigned sum, cnt, mine, sp = 0u;
    for (;;) {
        sum = 0u; cnt = 0u; mine = 0u;
#pragma unroll
        for (unsigned j = 0; j < 16; ++j) { const unsigned c = xb_ld(&bar[XB_XCNT(j)]); sum += c; cnt += (c > 0u) ? 1u : 0u; mine = (j == x) ? c : mine; }
        if (sum == G) break;
        __builtin_amdgcn_s_sleep(1);
        if ((++sp & 255u) == 0u) { if (xb_ld(&bar[XB_TMO])) break; if (sp > XB_SPIN_CAP) { atomicAdd(&bar[XB_TMO], 1u); break; } }
    }
    nloc = mine > 0u ? mine : 1u; nx = cnt > 0u ? cnt : 1u;
}
__device__ __forceinline__ void xcd_barrier(const XcdBarrier& b, int tid) {
    asm volatile("s_waitcnt vmcnt(0)" ::: "memory");
    __syncthreads();
    if (tid == 0) {
        unsigned* bar = b.bar;
        __builtin_amdgcn_s_waitcnt(0);
        unsigned nloc = b.st[0], nx = b.st[1];
        if (nloc == 0u) { xcd_barrier_complete(bar, b.x, nloc, nx); b.st[0] = nloc; b.st[1] = nx; }
        const unsigned old = xb_add(&bar[XB_XSUB(b.x)], 1u);
        const unsigned gen = old / nloc;
        if (old + 1u == (gen + 1u) * nloc) {
            __builtin_amdgcn_fence(__ATOMIC_RELEASE, "agent");
            asm volatile("s_waitcnt vmcnt(0)" ::: "memory");
            const unsigned og = xb_add(&bar[XB_TOP], 1u);
            const unsigned tg = og / nx;
            if (og + 1u == (tg + 1u) * nx) xb_add(&bar[XB_TOPGEN], 1u);
            else XB_SPIN(xb_ld(&bar[XB_TOPGEN]) == tg, bar);
            __builtin_amdgcn_fence(__ATOMIC_ACQUIRE, "agent");
            xb_add(&bar[XB_XGEN(b.x)], 1u);
            asm volatile("s_waitcnt vmcnt(0)" ::: "memory");
        } else {
            XB_SPIN(xb_ld(&bar[XB_XGEN(b.x)]) == gen, bar);
            __builtin_amdgcn_fence(__ATOMIC_ACQUIRE, "agent");
            asm volatile("s_waitcnt vmcnt(0)" ::: "memory");
        }
    }
    __syncthreads();
}

__device__ __forceinline__ float shx(float v, int m, int lane) { return __int_as_float(__builtin_amdgcn_ds_bpermute((lane ^ m) << 2, __float_as_int(v))); }
__device__ __forceinline__ int shi(int v, int src) { return __builtin_amdgcn_ds_bpermute(src << 2, v); }
__device__ __forceinline__ float wave_sum(float v, int lane) {
#pragma unroll
    for (int o = 1; o < 64; o <<= 1) v += shx(v, o, lane);
    return v;
}
__device__ const float ROPE_INV[64] = {
    1.0f, 0.8659643233600653f, 0.7498942093324559f, 0.6493816315762113f, 0.5623413251903491f, 0.4869675251658631f, 0.4216965034285822f, 0.3651741272548377f,
    0.31622776601683794f, 0.27384196342643613f, 0.23713737056616552f, 0.2053525026457146f, 0.1778279410038923f, 0.1539926526059492f, 0.1333521432163324f, 0.11547819846894582f,
    0.1f, 0.08659643233600653f, 0.07498942093324558f, 0.06493816315762113f, 0.05623413251903491f, 0.04869675251658631f, 0.042169650342858224f, 0.03651741272548377f,
    0.03162277660168379f, 0.027384196342643614f, 0.023713737056616554f, 0.02053525026457146f, 0.01778279410038923f, 0.01539926526059492f, 0.01333521432163324f, 0.011547819846894581f,
    0.01f, 0.008659643233600654f, 0.007498942093324558f, 0.006493816315762113f, 0.005623413251903491f, 0.004869675251658631f, 0.004216965034285823f, 0.003651741272548377f,
    0.0031622776601683794f, 0.0027384196342643613f, 0.0023713737056616554f, 0.002053525026457146f, 0.0017782794100389228f, 0.001539926526059492f, 0.001333521432163324f, 0.0011547819846894581f,
    0.001f, 0.0008659643233600654f, 0.0007498942093324559f, 0.0006493816315762113f, 0.0005623413251903491f, 0.0004869675251658631f, 0.00042169650342858224f, 0.0003651741272548377f,
    0.00031622776601683794f, 0.0002738419634264361f, 0.00023713737056616554f, 0.0002053525026457146f, 0.00017782794100389227f, 0.0001539926526059492f, 0.0001333521432163324f, 0.00011547819846894582f };
__device__ __forceinline__ void sincos_d(double a, float& sn, float& cs) {
    const double k = __builtin_rint(a * 0.15915494309189535);
    double r = __builtin_fma(-k, 6.283185307179586, a); r = __builtin_fma(-k, 2.4492935982947064e-16, r);
    const double r2 = r * r;
    double s = -9.18368986379554601e-29;
    s = s * r2 + 6.44695028438447359e-26; s = s * r2 + -3.86817017063068413e-23; s = s * r2 + 1.95729410633912626e-20; s = s * r2 + -8.22063524662432950e-18;
    s = s * r2 + 2.81145725434552060e-15; s = s * r2 + -7.64716373181981641e-13; s = s * r2 + 1.60590438368216133e-10; s = s * r2 + -2.50521083854417202e-08;
    s = s * r2 + 2.75573192239858925e-06; s = s * r2 + -1.98412698412698413e-04; s = s * r2 + 8.33333333333333322e-03; s = s * r2 + -1.66666666666666657e-01; s = s * r2 + 1.0;
    double c = 3.27988923706983776e-30;
    c = c * r2 + -2.47959626322479759e-27; c = c * r2 + 1.61173757109611839e-24; c = c * r2 + -8.89679139245057408e-22; c = c * r2 + 4.11031762331216484e-19;
    c = c * r2 + -1.56192069685862253e-16; c = c * r2 + 4.77947733238738525e-14; c = c * r2 + -1.14707455977297245e-11; c = c * r2 + 2.08767569878681002e-09;
    c = c * r2 + -2.75573192239858883e-07; c = c * r2 + 2.48015873015873016e-05; c = c * r2 + -1.38888888888888894e-03; c = c * r2 + 4.16666666666666644e-02; c = c * r2 + -0.5; c = c * r2 + 1.0;
    sn = (float)(s * r); cs = (float)c;
}

__device__ __forceinline__ int drow_of(int nn, int mode) {
    if (mode == 3) { const bool qk = (nn < 1024) || (nn >= 1536 && nn < 2560); const int d = nn & 127; return qk ? (nn & ~127) + 32 * ((d >> 4) & 3) + 8 * ((d >> 2) & 3) + 4 * (d >> 6) + (d & 3) : nn; }
    return (mode == 0) ? nn : ((nn >> 7) * 256 + (mode == 2 ? 128 : 0) + (nn & 127)); }
struct WItem { const float* W; int K, N, k0, n0, mode, fmt, Kd, nd, cw, l; size_t dst_off; };
constexpr int WI_IN = 4 * (DM / 64) * (DIN / 32), WI_OUT = 4 * (DMIX / 64) * (DM / 32), WI_GD = 2 * (DM / 64) * (DFF / 32), WI_DD = 2 * (DFF / 64) * (DM / 32);
constexpr int WI_GM = 16 * (DM / 64) * (DFE / 32), WI_DM = 16 * (DFE / 64) * (DM / 32);
constexpr int WI_TOTAL = WI_IN + WI_OUT + 2 * WI_GD + WI_DD + 2 * WI_GM + WI_DM;
__device__ __forceinline__ void resolve_item(const void* const* in, int it, WItem& w) {
    int r = it, idx, L, K, N, mode, fmt, Kd, nd, cw; size_t off;
    if (r < WI_IN) { idx = 3; L = 4; K = DM; N = DIN; mode = 3; fmt = 0; Kd = DM; nd = DIN; cw = CW_CMAX_IN; off = WS_WIN; }
    else if ((r -= WI_IN) < WI_OUT) { idx = 10; L = 4; K = DMIX; N = DM; mode = 0; fmt = 0; Kd = DMIX; nd = DM; cw = CW_CMAX_OUT; off = WS_WOUT; }
    else if ((r -= WI_OUT) < WI_GD) { idx = 12; L = 2; K = DM; N = DFF; mode = 1; fmt = 0; Kd = DM; nd = 2 * DFF; cw = CW_CMAX_GUD; off = WS_WGU_D; }
    else if ((r -= WI_GD) < WI_GD) { idx = 13; L = 2; K = DM; N = DFF; mode = 2; fmt = 0; Kd = DM; nd = 2 * DFF; cw = CW_CMAX_GUD; off = WS_WGU_D; }
    else if ((r -= WI_GD) < WI_DD) { idx = 14; L = 2; K = DFF; N = DM; mode = 0; fmt = 1; Kd = DFF; nd = DM; cw = CW_CMAX_DND; off = WS_WDN_D; }
    else if ((r -= WI_DD) < WI_GM) { idx = 16; L = 16; K = DM; N = DFE; mode = 1; fmt = 0; Kd = DM; nd = 2 * DFE; cw = CW_CMAX_GUM; off = WS_WGU_M; }
    else if ((r -= WI_GM) < WI_GM) { idx = 17; L = 16; K = DM; N = DFE; mode = 2; fmt = 0; Kd = DM; nd = 2 * DFE; cw = CW_CMAX_GUM; off = WS_WGU_M; }
    else { r -= WI_GM; idx = 18; L = 16; K = DFE; N = DM; mode = 0; fmt = 1; Kd = DFEP; nd = DM; cw = CW_CMAX_DNM; off = WS_WDN_M; }
    (void)L;
    const int per = (K / 64) * (N / 32), l = r / per, q = r % per, nblk = N / 32;
    w.W = (const float*)in[idx] + (size_t)l * K * N; w.K = K; w.N = N; w.k0 = 64 * (q / nblk); w.n0 = 32 * (q % nblk); w.mode = mode; w.fmt = fmt; w.Kd = Kd; w.nd = nd; w.cw = cw; w.l = l; w.dst_off = off;
}
__device__ __forceinline__ void load_item(const WItem& w, f32x4 (&d)[8], int lane) {
    GAS const float* p = (GAS const float*)(w.W + (size_t)(w.k0 + (lane >> 3)) * w.N + w.n0 + 4 * (lane & 7));
#pragma unroll
    for (int j = 0; j < 8; ++j) d[j] = __builtin_nontemporal_load((GAS const f32x4*)(p + (size_t)(8 * j) * w.N));
}
__device__ __forceinline__ void colmax_item(const WItem& w, const f32x4 (&d)[8], unsigned* ctl, int lane) {
    f32x4 m = {0.f, 0.f, 0.f, 0.f};
#pragma unroll
    for (int j = 0; j < 8; ++j)
#pragma unroll
        for (int t = 0; t < 4; ++t) m[t] = __builtin_fmaxf(m[t], __builtin_fabsf(d[j][t]));
#pragma unroll
    for (int t = 0; t < 4; ++t) { m[t] = __builtin_fmaxf(m[t], shx(m[t], 8, lane)); m[t] = __builtin_fmaxf(m[t], shx(m[t], 16, lane)); m[t] = __builtin_fmaxf(m[t], shx(m[t], 32, lane)); }
    if (lane < 8) { unsigned* cm = ctl + w.cw + (size_t)w.l * w.nd;
#pragma unroll
        for (int t = 0; t < 4; ++t) atomicMax(cm + drow_of(w.n0 + 4 * lane + t, w.mode), __float_as_uint(m[t])); }
}
__device__ __forceinline__ void convert_item(const WItem& w, const f32x4 (&d)[8], unsigned char* ws, const unsigned* ctl, LAS float* scr, int lane) {
#pragma unroll
    for (int j = 0; j < 8; ++j)
#pragma unroll
        for (int t = 0; t < 4; ++t) scr[(8 * j + (lane >> 3)) * 33 + 4 * (lane & 7) + t] = d[j][t];
    LDS_WAIT(); asm volatile("" ::: "memory");
    const int c = lane & 7;
    unsigned char* WT = ws + w.dst_off + (size_t)w.l * w.nd * w.Kd; const float* cm = (const float*)(ctl + w.cw) + (size_t)w.l * w.nd;
#pragma unroll
    for (int j = 0; j < 4; ++j) { const int n = (lane >> 3) + 8 * j; const LAS float* sp = scr + (8 * c) * 33 + n;
        const int drow = drow_of(w.n0 + n, w.mode);
        if (w.fmt == 2) { v4u o; o.x = pk2(sp[0 * 33], sp[1 * 33]); o.y = pk2(sp[2 * 33], sp[3 * 33]); o.z = pk2(sp[4 * 33], sp[5 * 33]); o.w = pk2(sp[6 * 33], sp[7 * 33]);
            *(v4u*)(WT + (size_t)drow * w.Kd + (size_t)(w.k0 + 8 * c) * 2) = o; }
        else { const float cmv = cm[drow]; v2u o;
            if (w.fmt == 1) { const float qs = cmv > 0.f ? pg8::F8_WMAX / cmv : 0.f;
                o.x = pg8::pk_fp8x4(sp[0 * 33] * qs, sp[1 * 33] * qs, sp[2 * 33] * qs, sp[3 * 33] * qs); o.y = pg8::pk_fp8x4(sp[4 * 33] * qs, sp[5 * 33] * qs, sp[6 * 33] * qs, sp[7 * 33] * qs); }
            else { const float qs = cmv > 0.f ? 127.0f / cmv : 0.f; int q[8];
#pragma unroll
                for (int t = 0; t < 8; ++t) q[t] = (int)__builtin_rintf(sp[t * 33] * qs);
                o.x = (unsigned)(q[0] & 255) | ((unsigned)(q[1] & 255) << 8) | ((unsigned)(q[2] & 255) << 16) | ((unsigned)q[3] << 24);
                o.y = (unsigned)(q[4] & 255) | ((unsigned)(q[5] & 255) << 8) | ((unsigned)(q[6] & 255) << 16) | ((unsigned)q[7] << 24); }
            *(v2u*)(WT + (size_t)drow * w.Kd + w.k0 + 8 * c) = o; } }
    LDS_WAIT(); asm volatile("" ::: "memory");
}

template <bool ROUTER, int R, bool XF32>
__device__ __forceinline__ void norm_phase(const float* x, const bf16* xb, const float* gain, unsigned char* xq, float* sa, const float* wr, v4u* map, unsigned* cnt, int gw, int NGW, int lane) {
    f32x4 g[4][2];
#pragma unroll
    for (int j = 0; j < 4; ++j)
#pragma unroll
        for (int e = 0; e < 2; ++e) g[j][e] = *(const f32x4*)(gain + 512 * j + 8 * lane + 4 * e);
    const int RPW = (M + NGW - 1) / NGW;
    int my_e0 = -1, my_e1 = -1, my_row = -1, it = 0; float my_g0 = 0.f, my_g1 = 0.f;
    f32x4 rf[R][4][2]; v4u rb[R][4];
#define NORM_LOAD(dstf, dstb, r0) do { _Pragma("unroll") for (int rr = 0; rr < R; ++rr) { const int row_ = ((r0) + rr < M) ? (r0) + rr : M - 1; \
            if constexpr (XF32) { const float* xr = x + (size_t)row_ * DM + 8 * lane; _Pragma("unroll") for (int j = 0; j < 4; ++j) _Pragma("unroll") for (int e = 0; e < 2; ++e) dstf[rr][j][e] = *(const f32x4*)(xr + 512 * j + 4 * e); } \
            else { const bf16* xr = xb + (size_t)row_ * DM + 8 * lane; _Pragma("unroll") for (int j = 0; j < 4; ++j) dstb[rr][j] = __builtin_nontemporal_load((const v4u*)(xr + 512 * j)); } } } while (0)
    asm volatile("" :: "v"(g[0][0]), "v"(g[0][1]), "v"(g[1][0]), "v"(g[1][1]), "v"(g[2][0]), "v"(g[2][1]), "v"(g[3][0]), "v"(g[3][1]));
    NORM_LOAD(rf, rb, gw * RPW);
    for (int i0 = 0; i0 < RPW; i0 += R) {
        const int row0 = gw * RPW + i0;
        f32x4 v[R][4][2]; float ss[R];
#pragma unroll
        for (int rr = 0; rr < R; ++rr)
#pragma unroll
            for (int j = 0; j < 4; ++j) {
                if constexpr (XF32) { v[rr][j][0] = rf[rr][j][0]; v[rr][j][1] = rf[rr][j][1]; }
                else { const v4u w = rb[rr][j]; v[rr][j][0] = (f32x4){bf_lo(w.x), bf_hi(w.x), bf_lo(w.y), bf_hi(w.y)}; v[rr][j][1] = (f32x4){bf_lo(w.z), bf_hi(w.z), bf_lo(w.w), bf_hi(w.w)}; } }
        if (i0 + R < RPW) NORM_LOAD(rf, rb, row0 + R);
#pragma unroll
        for (int rr = 0; rr < R; ++rr) { float s = 0.f;
#pragma unroll
            for (int j = 0; j < 4; ++j)
#pragma unroll
                for (int e = 0; e < 2; ++e) s += (v[rr][j][e].x * v[rr][j][e].x + v[rr][j][e].y * v[rr][j][e].y) + (v[rr][j][e].z * v[rr][j][e].z + v[rr][j][e].w * v[rr][j][e].w);
            ss[rr] = s; }
#pragma unroll
        for (int o = 1; o < 64; o <<= 1)
#pragma unroll
            for (int rr = 0; rr < R; ++rr) ss[rr] += shx(ss[rr], o, lane);
        float mx[R];
#pragma unroll
        for (int rr = 0; rr < R; ++rr) {
            const float rstd = __builtin_amdgcn_rsqf(ss[rr] * (1.0f / DM) + EPS); float m = 0.f;
#pragma unroll
            for (int j = 0; j < 4; ++j) {
                v[rr][j][0] = v[rr][j][0] * rstd * g[j][0]; v[rr][j][1] = v[rr][j][1] * rstd * g[j][1];
#pragma unroll
                for (int t = 0; t < 4; ++t) m = __builtin_fmaxf(m, __builtin_fmaxf(__builtin_fabsf(v[rr][j][0][t]), __builtin_fabsf(v[rr][j][1][t])));
            }
            mx[rr] = m;
        }
#pragma unroll
        for (int o = 1; o < 64; o <<= 1)
#pragma unroll
            for (int rr = 0; rr < R; ++rr) mx[rr] = __builtin_fmaxf(mx[rr], shx(mx[rr], o, lane));
#pragma unroll
        for (int rr = 0; rr < R; ++rr) {
            const bool live = (row0 + rr < M);
            const float qs = mx[rr] > 0.f ? 127.0f / mx[rr] : 0.f;
            unsigned char* orow = xq + (size_t)(row0 + rr) * DM + 8 * lane;
#pragma unroll
            for (int j = 0; j < 4; ++j) {
                int q[8];
#pragma unroll
                for (int t = 0; t < 4; ++t) { q[t] = (int)__builtin_rintf(v[rr][j][0][t] * qs); q[4 + t] = (int)__builtin_rintf(v[rr][j][1][t] * qs); }
                v2u o; o.x = (unsigned)(q[0] & 255) | ((unsigned)(q[1] & 255) << 8) | ((unsigned)(q[2] & 255) << 16) | ((unsigned)q[3] << 24);
                o.y = (unsigned)(q[4] & 255) | ((unsigned)(q[5] & 255) << 8) | ((unsigned)(q[6] & 255) << 16) | ((unsigned)q[7] << 24);
                if (live) *(v2u*)(orow + 512 * j) = o;
            }
            if (live && lane == 0) sa[row0 + rr] = mx[rr] * (1.0f / 127.0f);
        }
        if constexpr (ROUTER) {
            float lg[R][8];
#pragma unroll
            for (int rr = 0; rr < R; ++rr)
#pragma unroll
                for (int e = 0; e < 8; ++e) lg[rr][e] = 0.f;
#pragma unroll
            for (int j = 0; j < 4; ++j) {
                GAS const float* wj = (GAS const float*)(wr + (size_t)(512 * j + 8 * lane) * 8); asm volatile("" : "+v"(wj));
#pragma unroll
                for (int e = 0; e < 2; ++e)
#pragma unroll
                    for (int t = 0; t < 4; ++t) {
                        GAS const f32x4* w = (GAS const f32x4*)(wj + (4 * e + t) * 8); const f32x4 w0 = w[0], w1 = w[1];
#pragma unroll
                        for (int rr = 0; rr < R; ++rr) { const float yv = v[rr][j][e][t];
                            lg[rr][0] += yv * w0.x; lg[rr][1] += yv * w0.y; lg[rr][2] += yv * w0.z; lg[rr][3] += yv * w0.w; lg[rr][4] += yv * w1.x; lg[rr][5] += yv * w1.y; lg[rr][6] += yv * w1.z; lg[rr][7] += yv * w1.w; } } }
#pragma unroll
            for (int o = 1; o < 64; o <<= 1)
#pragma unroll
                for (int rr = 0; rr < R; ++rr)
#pragma unroll
                    for (int e = 0; e < 8; ++e) lg[rr][e] += shx(lg[rr][e], o, lane);
#pragma unroll
            for (int rr = 0; rr < R; ++rr) {
                const int row = row0 + rr;
                if (row < M) {
                    int i0x = 0; float l0 = lg[rr][0];
#pragma unroll
                    for (int e = 1; e < 8; ++e) if (lg[rr][e] > l0) { l0 = lg[rr][e]; i0x = e; }
                    int i1x = -1; float l1 = -3.0e38f;
#pragma unroll
                    for (int e = 0; e < 8; ++e) if (e != i0x && lg[rr][e] > l1) { l1 = lg[rr][e]; i1x = e; }
                    const float e1 = __expf(l1 - l0); const float g0 = 1.0f / (1.0f + e1), g1 = e1 * g0;
                    if (lane == (it & 63)) { my_e0 = i0x; my_e1 = i1x; my_g0 = g0; my_g1 = g1; my_row = row; }
                    ++it;
                }
                const bool lastrow = (i0 + rr == RPW - 1);
                if (((it & 63) == 0 && it > 0) || lastrow) {
                    int rank0 = 0, rank1 = 0, mycount = 0;
#pragma unroll
                    for (int e = 0; e < 8; ++e) {
                        const unsigned long long m0 = __ballot(my_e0 == e), m1 = __ballot(my_e1 == e);
                        const int r0 = __builtin_amdgcn_mbcnt_hi((unsigned)(m0 >> 32), __builtin_amdgcn_mbcnt_lo((unsigned)m0, 0u));
                        const int r1 = __builtin_amdgcn_mbcnt_hi((unsigned)(m1 >> 32), __builtin_amdgcn_mbcnt_lo((unsigned)m1, 0u));
                        if (my_e0 == e) rank0 = r0; if (my_e1 == e) rank1 = r1;
                        if (lane == e) mycount = __builtin_popcountll(m0); if (lane == 8 + e) mycount = __builtin_popcountll(m1);
                    }
                    int base = 0;
                    if (lane < 16 && mycount > 0) base = (int)__hip_atomic_fetch_add(cnt + 64 * lane, (unsigned)mycount, __ATOMIC_RELAXED, __HIP_MEMORY_SCOPE_AGENT);
                    const int b0 = shi(base, my_e0 & 7), b1 = shi(base, 8 + (my_e1 & 7));
                    if (my_row >= 0) {
                        v4u a; a.x = (unsigned)my_e0; a.y = (unsigned)(b0 + rank0); a.z = __float_as_uint(my_g0); a.w = (unsigned)my_row;
                        v4u b; b.x = (unsigned)(8 + my_e1); b.y = (unsigned)(b1 + rank1); b.z = __float_as_uint(my_g1); b.w = (unsigned)my_row;
                        map[(size_t)my_row * 2] = a; map[(size_t)my_row * 2 + 1] = b;
                    }
                    my_e0 = -1; my_e1 = -1; my_row = -1; it = 0;
                }
            }
        }
    }
    (void)my_e0; (void)my_e1; (void)my_row; (void)it; (void)my_g0; (void)my_g1;
#undef NORM_LOAD
}

#define MFMA32(a, b, c) __builtin_amdgcn_mfma_f32_32x32x16_bf16((a), (b), (c), 0, 0, 0)
__device__ __forceinline__ int crow16(int i, int hh) { return (i & 3) + 8 * (i >> 2) + 4 * hh; }
__device__ __forceinline__ int voff(int row, int ch) { return 256 * row + 16 * (ch ^ (((row & 3) << 2) | ((row >> 2) & 3))); }
__device__ __forceinline__ void load_frag8(bf16x8 (&f)[8], const bf16* rowptr, int hh) {
    const v4u* p = (const v4u*)rowptr + 2 * hh;
#pragma unroll
    for (int c = 0; c < 4; ++c) { f[2 * c] = __builtin_bit_cast(bf16x8, p[4 * c]); f[2 * c + 1] = __builtin_bit_cast(bf16x8, p[4 * c + 1]); }
}
__device__ __forceinline__ void load_v(v4u (&t)[8], const bf16* vbase, size_t rstride, int lane) {
    int l2 = lane; asm volatile("" : "+v"(l2));
    const bf16* p = vbase + (size_t)(l2 >> 4) * rstride + 8 * (l2 & 15);
#pragma unroll
    for (int i = 0; i < 8; ++i) t[i] = *(const v4u*)(p + (size_t)(4 * i) * rstride);
}
__device__ __forceinline__ void write_v(LAS unsigned char* vimg, const v4u (&t)[8], int lane_) {
    int lane = lane_; asm volatile("" : "+v"(lane));
#pragma unroll
    for (int i = 0; i < 8; ++i) { const int row = 4 * i + (lane >> 4); *(LAS v4u*)(vimg + voff(row, lane & 15)) = t[i]; }
}
__device__ __forceinline__ void write_k(LAS unsigned char* img, const v4u (&t)[8], int lane_) {
    int lane = lane_; asm volatile("" : "+v"(lane));
#pragma unroll
    for (int i = 0; i < 8; ++i) { const int row = 4 * i + (lane >> 4); *(LAS v4u*)(img + 256 * row + 16 * ((lane & 15) ^ (row & 15))) = t[i]; }
}
__device__ __forceinline__ f32x16 qk_tile(LAS unsigned char* img, LAS unsigned char* qimg, int lane) {
    const int r = lane & 31, hh = lane >> 5;
    f32x16 S;
#pragma unroll
    for (int i = 0; i < 16; ++i) S[i] = 0.f;
#pragma unroll
    for (int f = 0; f < 8; ++f) { const int ch = 4 * (f >> 1) + 2 * hh + (f & 1);
        const bf16x8 kf = *(const LAS bf16x8*)(img + 256 * r + 16 * (ch ^ (r & 15)));
        S = MFMA32(kf, *(const LAS bf16x8*)(qimg + f * 1024 + lane * 16), S); }
    return S;
}
__device__ __forceinline__ bf16x8 pack8(const float* p) {
    v4u w; w.x = pk2(p[0], p[1]); w.y = pk2(p[2], p[3]); w.z = pk2(p[4], p[5]); w.w = pk2(p[6], p[7]);
    return __builtin_bit_cast(bf16x8, w);
}
__device__ __forceinline__ void pv_tile(f32x16 (&O)[4], const float (&P)[16], LAS unsigned char* vimg, int lane) {
    const int hh = lane >> 5, i16 = lane & 15, q = i16 >> 2, p = i16 & 3, blk = (lane >> 4) & 1;
    const bf16x8 pf0 = pack8(&P[0]), pf1 = pack8(&P[8]);
    asm volatile("" ::: "memory");
#pragma unroll
    for (int dt = 0; dt < 4; ++dt) {
#pragma unroll
        for (int s = 0; s < 2; ++s) {
            const int ch = 4 * dt + 2 * blk + (p >> 1);
            const int rlo = 16 * s + 4 * hh + q, rhi = rlo + 8;
            const s16x4 lo = __builtin_amdgcn_ds_read_tr16_b64_v4i16((LAS s16x4*)(vimg + voff(rlo, ch) + 8 * (p & 1)));
            const s16x4 hi = __builtin_amdgcn_ds_read_tr16_b64_v4i16((LAS s16x4*)(vimg + voff(rhi, ch) + 8 * (p & 1)));
            const bf16x8 va = __builtin_shufflevector(lo, hi, 0, 1, 2, 3, 4, 5, 6, 7);
            O[dt] = MFMA32(va, s == 0 ? pf0 : pf1, O[dt]);
        }
    }
    asm volatile("" ::: "memory");
}
constexpr float ATT_C = 0.08838834764831845f * 1.4426950408889634f;
constexpr float SB_STOP = 160.0f;

__device__ __forceinline__ void store_pair16(bf16* p, v2u a, v2u b) {
    asm volatile("s_nop 1" : "+v"(a.x), "+v"(a.y), "+v"(b.x), "+v"(b.y));
    const auto r0 = __builtin_amdgcn_permlane32_swap(a.x, b.x, false, false); const auto r1 = __builtin_amdgcn_permlane32_swap(a.y, b.y, false, false);
    v4u w; w.x = r0[0]; w.y = r1[0]; w.z = r0[1]; w.w = r1[1];
    *(v4u*)p = w;
}
__device__ __forceinline__ void sb_unit(const bf16* H, bf16* OSB, LAS unsigned char* vimg, LAS unsigned char* qimg, int b, int hd, int qt, int lane) {
    const int r = lane & 31, hh = lane >> 5;
    const size_t tokq = (size_t)b * SEQ + 32 * qt + r;
    v4u Kt[8], Vt[8];
    { bf16x8 Q[8]; load_frag8(Q, H + tokq * DIN + C_QSB + hd * HD, hh);
      { const size_t tok0 = (size_t)b * SEQ + 32 * qt; load_v(Kt, H + tok0 * DIN + C_KSB + hd * HD, DIN, lane); load_v(Vt, H + tok0 * DIN + C_VSB + hd * HD, DIN, lane); }
#pragma unroll
      for (int c = 0; c < 8; ++c) *(LAS bf16x8*)(qimg + c * 1024 + lane * 16) = Q[c]; }
    f32x16 O[4];
#pragma unroll
    for (int dt = 0; dt < 4; ++dt)
#pragma unroll
        for (int i = 0; i < 16; ++i) O[dt][i] = 0.f;
    float later = 0.f;
    for (int kt = qt; kt >= 0; --kt) {
        const size_t tokn = (size_t)b * SEQ + 32 * (kt > 0 ? kt - 1 : 0);
        write_k(vimg, Kt, lane);
        asm volatile("" ::: "memory");
        if (kt > 0) load_v(Kt, H + tokn * DIN + C_KSB + hd * HD, DIN, lane);
        const f32x16 S = qk_tile(vimg, qimg, lane);
        asm volatile("" ::: "memory");
        write_v(vimg, Vt, lane);
        if (kt > 0) load_v(Vt, H + tokn * DIN + C_VSB + hd * HD, DIN, lane);
        const bool diag = (kt == qt);
        float u[16], a[16]; bool valid[16];
#pragma unroll
        for (int i = 0; i < 16; ++i) {
            u[i] = S[i] * ATT_C; valid[i] = !diag || (crow16(i, hh) < r);
            const float e = __builtin_amdgcn_exp2f(-__builtin_fabsf(u[i]));
            const float sp = __builtin_fmaxf(u[i], 0.f) + __builtin_amdgcn_logf(1.0f + e);
            a[i] = valid[i] ? sp : 0.f;
        }
        float T[4], To[4];
#pragma unroll
        for (int G = 0; G < 4; ++G) { a[4 * G + 2] += a[4 * G + 3]; a[4 * G + 1] += a[4 * G + 2]; a[4 * G] += a[4 * G + 1]; T[G] = a[4 * G]; }
#pragma unroll
        for (int G = 0; G < 4; ++G) To[G] = shx(T[G], 32, lane);
        const float P3 = T[3] + To[3], P2 = T[2] + To[2], P1 = T[1] + To[1], P0 = T[0] + To[0];
        float Qs[4]; Qs[3] = 0.f; Qs[2] = P3; Qs[1] = P3 + P2; Qs[0] = Qs[1] + P1;
        const float total = Qs[0] + P0;
        float P[16];
#pragma unroll
        for (int i = 0; i < 16; ++i) { const int G = i >> 2; const float off = Qs[G] + (hh == 0 ? To[G] : 0.f);
            const float l2a = u[i] - (a[i] + off) - later; P[i] = valid[i] ? __builtin_amdgcn_exp2f(l2a) : 0.f; }
        pv_tile(O, P, vimg, lane);
        later += total;
        if (__all(later > SB_STOP)) break;
    }
    int l3 = lane; asm volatile("" : "+v"(l3));
    bf16* orow = OSB + ((size_t)b * SEQ + 32 * qt + (l3 & 31)) * DSB + hd * HD + 8 * (l3 >> 5);
#pragma unroll
    for (int dt = 0; dt < 4; ++dt)
#pragma unroll
        for (int G = 0; G < 4; G += 2) { v2u a, c; a.x = pk2(O[dt][4 * G], O[dt][4 * G + 1]); a.y = pk2(O[dt][4 * G + 2], O[dt][4 * G + 3]); c.x = pk2(O[dt][4 * G + 4], O[dt][4 * G + 5]); c.y = pk2(O[dt][4 * G + 6], O[dt][4 * G + 7]);
            store_pair16(orow + 32 * dt + 8 * G, a, c); }
}

__device__ __forceinline__ void dil_unit(const bf16* H, bf16* ODIL, float* LSE, LAS unsigned char* vimg, LAS unsigned char* qimg, int b, int hd, int g, int rc, int mt, int lane) {
    const int r = lane & 31, hh = lane >> 5;
    const int delta = (g == 0) ? 1 : (g == 1 ? 4 : 16);
    const size_t tokq = (size_t)b * SEQ + (size_t)(32 * mt + r) * delta + rc;
    v4u Kt[8], Vt[8];
    { bf16x8 Q[8]; load_frag8(Q, H + tokq * DIN + C_QDIL + hd * HD, hh);
      { const size_t tok0 = (size_t)b * SEQ + (size_t)(32 * mt) * delta + rc; load_v(Kt, H + tok0 * DIN + C_KDIL + hd * HD, (size_t)DIN * delta, lane); load_v(Vt, H + tok0 * DIN + C_VDIL + hd * HD, (size_t)DIN * delta, lane); }
#pragma unroll
      for (int c = 0; c < 8; ++c) *(LAS bf16x8*)(qimg + c * 1024 + lane * 16) = Q[c]; }
    f32x16 O[4];
#pragma unroll
    for (int dt = 0; dt < 4; ++dt)
#pragma unroll
        for (int i = 0; i < 16; ++i) O[dt][i] = 0.f;
    float mrun = -1.0e30f, lsum = 0.f;
    const int ktlo = (mt - 4 > 0) ? (mt - 4) : 0;
    for (int kt = mt; kt >= ktlo; --kt) {
        const size_t tokn = (size_t)b * SEQ + (size_t)(32 * (kt > ktlo ? kt - 1 : kt)) * delta + rc;
        write_k(vimg, Kt, lane);
        asm volatile("" ::: "memory");
        if (kt > ktlo) load_v(Kt, H + tokn * DIN + C_KDIL + hd * HD, (size_t)DIN * delta, lane);
        const f32x16 S = qk_tile(vimg, qimg, lane);
        asm volatile("" ::: "memory");
        write_v(vimg, Vt, lane);
        if (kt > ktlo) load_v(Vt, H + tokn * DIN + C_VDIL + hd * HD, (size_t)DIN * delta, lane);
        const int dq = 32 * (mt - kt) + r;
        float u[16]; float tmax = -1.0e30f;
#pragma unroll
        for (int i = 0; i < 16; ++i) { const int dist = dq - crow16(i, hh); const bool ok = (dist >= 0) && (dist <= 128);
            u[i] = ok ? S[i] * ATT_C : -1.0e30f; tmax = __builtin_fmaxf(tmax, u[i]); }
        tmax = __builtin_fmaxf(tmax, shx(tmax, 32, lane));
        constexpr float DIL_THR = 8.0f;
        float mnew = mrun;
        if (!__all(tmax - mrun <= DIL_THR)) {
            mnew = __builtin_fmaxf(mrun, tmax);
            const float alpha = __builtin_amdgcn_exp2f(mrun - mnew);
            lsum *= alpha;
#pragma unroll
            for (int dt = 0; dt < 4; ++dt)
#pragma unroll
                for (int i = 0; i < 16; ++i) O[dt][i] *= alpha;
        }
        float P[16]; float ps = 0.f;
#pragma unroll
        for (int i = 0; i < 16; ++i) { P[i] = __builtin_amdgcn_exp2f(u[i] - mnew); ps += P[i]; }
        lsum += ps;
        pv_tile(O, P, vimg, lane);
        mrun = mnew;
    }
    const float ltot = lsum + shx(lsum, 32, lane);
    const float inv = 1.0f / ltot;
    int l3 = lane; asm volatile("" : "+v"(l3));
    const size_t tq3 = (size_t)b * SEQ + (size_t)(32 * mt + (l3 & 31)) * delta + rc;
    bf16* orow = ODIL + ((size_t)g * M + tq3) * 512 + hd * HD + 8 * (l3 >> 5);
#pragma unroll
    for (int dt = 0; dt < 4; ++dt)
#pragma unroll
        for (int G = 0; G < 4; G += 2) { v2u a, c; a.x = pk2(O[dt][4 * G] * inv, O[dt][4 * G + 1] * inv); a.y = pk2(O[dt][4 * G + 2] * inv, O[dt][4 * G + 3] * inv);
            c.x = pk2(O[dt][4 * G + 4] * inv, O[dt][4 * G + 5] * inv); c.y = pk2(O[dt][4 * G + 6] * inv, O[dt][4 * G + 7] * inv);
            store_pair16(orow + 32 * dt + 8 * G, a, c); }
    if ((l3 >> 5) == 0) LSE[((size_t)g * M + tq3) * 4 + hd] = (mrun + __builtin_amdgcn_logf(ltot)) * 0.6931471805599453f;
}

__device__ __forceinline__ void attn_phase(const bf16* H, bf16* OSB, bf16* ODIL, float* LSE, LAS unsigned char* lds, int vcu, int G, int wave, int lane, unsigned* queue) {
    LAS unsigned char* vimg = lds + wave * 16384; LAS unsigned char* qimg = vimg + 8192;
    constexpr int NSB = NB * 4 * 256, NDIL = 3 * NSB;
    const int NGRP = (G % 8 == 0) ? 8 : 1, BPG = G / NGRP, WPG = BPG * NWAVES, NGW = G * NWAVES;
    const int grp = vcu / BPG;
    unsigned* q = queue + grp * 16;
    const int nslot = WPG * ((NSB + NDIL + NGW - 1) / NGW);
    unsigned jv = 0; if (lane == 0) jv = __hip_atomic_fetch_add(q, 1u, __ATOMIC_RELAXED, __HIP_MEMORY_SCOPE_AGENT);
    for (;;) {
        const int j = __builtin_amdgcn_readfirstlane((int)jv);
        if (j >= nslot) break;
        if (lane == 0) jv = __hip_atomic_fetch_add(q, 1u, __ATOMIC_RELAXED, __HIP_MEMORY_SCOPE_AGENT);
        const int uidx = grp * WPG + (j % WPG) + (j / WPG) * NGW;
        if (uidx >= NSB + NDIL) continue;
        if (uidx < NSB) { const int qt = uidx & 255, hd = (uidx >> 8) & 3, b = uidx >> 10; sb_unit(H, OSB, vimg, qimg, b, hd, qt, lane); }
        else { const int did = uidx - NSB; const int g = did / NSB, rem = did % NSB; const int b = rem >> 10, hd = (rem >> 8) & 3, sub = rem & 255;
            const int delta = (g == 0) ? 1 : (g == 1 ? 4 : 16); const int nmt = 256 / delta; const int mt = sub % nmt, rc = sub / nmt;
            dil_unit(H, ODIL, LSE, vimg, qimg, b, hd, g, rc, mt, lane); }
    }
}

__device__ __forceinline__ void combine_phase(const bf16* OSB, const bf16* ODIL, const float* LSE, const float* g_sb, const float* g_dil, unsigned char* ATTq, float* sa2, int gw, int NGW, int lane) {
    constexpr int R = 4;
    const f32x4 gs0 = *(const f32x4*)(g_sb + 8 * lane), gs1 = *(const f32x4*)(g_sb + 8 * lane + 4);
    const f32x4 gd0 = *(const f32x4*)(g_dil + 8 * lane), gd1 = *(const f32x4*)(g_dil + 8 * lane + 4);
    const int hd = lane >> 4;
    const int RPW = (M + NGW - 1) / NGW;
    v4u sbn[R]; v4u dvn[R][3]; float lsn[R][3];
#define CMB_LOAD(t0) do { _Pragma("unroll") for (int rr = 0; rr < R; ++rr) { const int tok_ = ((t0) + rr < M) ? (t0) + rr : M - 1; \
            sbn[rr] = __builtin_nontemporal_load((const v4u*)(OSB + (size_t)tok_ * DSB + 8 * lane)); \
            _Pragma("unroll") for (int g = 0; g < 3; ++g) { dvn[rr][g] = __builtin_nontemporal_load((const v4u*)(ODIL + ((size_t)g * M + tok_) * 512 + 8 * lane)); lsn[rr][g] = LSE[((size_t)g * M + tok_) * 4 + hd]; } } } while (0)
    asm volatile("" :: "v"(gs0), "v"(gs1), "v"(gd0), "v"(gd1));
    CMB_LOAD(gw * RPW);
    for (int i0 = 0; i0 < RPW; i0 += R) {
        f32x4 sv[R][2]; v4u dv[R][3]; float ls[R][3];
#pragma unroll
        for (int rr = 0; rr < R; ++rr) { const v4u w = sbn[rr]; sv[rr][0] = (f32x4){bf_lo(w.x), bf_hi(w.x), bf_lo(w.y), bf_hi(w.y)}; sv[rr][1] = (f32x4){bf_lo(w.z), bf_hi(w.z), bf_lo(w.w), bf_hi(w.w)};
#pragma unroll
            for (int g = 0; g < 3; ++g) { dv[rr][g] = dvn[rr][g]; ls[rr][g] = lsn[rr][g]; } }
        if (i0 + R < RPW) CMB_LOAD(gw * RPW + i0 + R);
        float s1[R], s2[R]; float y[R][8];
#pragma unroll
        for (int rr = 0; rr < R; ++rr) {
            const f32x4 v0 = sv[rr][0], v1 = sv[rr][1];
            s1[rr] = (v0.x * v0.x + v0.y * v0.y) + (v0.z * v0.z + v0.w * v0.w) + (v1.x * v1.x + v1.y * v1.y) + (v1.z * v1.z + v1.w * v1.w);
            const float l0 = ls[rr][0], l1 = ls[rr][1], l2 = ls[rr][2];
            const float mx = __builtin_fmaxf(l0, __builtin_fmaxf(l1, l2));
            float w0 = __expf(l0 - mx), w1 = __expf(l1 - mx), w2 = __expf(l2 - mx); const float iw = 1.0f / (w0 + w1 + w2); w0 *= iw; w1 *= iw; w2 *= iw;
            const v4u a = dv[rr][0], bq = dv[rr][1], c = dv[rr][2];
            y[rr][0] = w0 * bf_lo(a.x) + w1 * bf_lo(bq.x) + w2 * bf_lo(c.x); y[rr][1] = w0 * bf_hi(a.x) + w1 * bf_hi(bq.x) + w2 * bf_hi(c.x);
            y[rr][2] = w0 * bf_lo(a.y) + w1 * bf_lo(bq.y) + w2 * bf_lo(c.y); y[rr][3] = w0 * bf_hi(a.y) + w1 * bf_hi(bq.y) + w2 * bf_hi(c.y);
            y[rr][4] = w0 * bf_lo(a.z) + w1 * bf_lo(bq.z) + w2 * bf_lo(c.z); y[rr][5] = w0 * bf_hi(a.z) + w1 * bf_hi(bq.z) + w2 * bf_hi(c.z);
            y[rr][6] = w0 * bf_lo(a.w) + w1 * bf_lo(bq.w) + w2 * bf_lo(c.w); y[rr][7] = w0 * bf_hi(a.w) + w1 * bf_hi(bq.w) + w2 * bf_hi(c.w);
            float q = 0.f;
#pragma unroll
            for (int e = 0; e < 8; ++e) q += y[rr][e] * y[rr][e];
            s2[rr] = q;
        }
#pragma unroll
        for (int o = 1; o < 64; o <<= 1)
#pragma unroll
            for (int rr = 0; rr < R; ++rr) { s1[rr] += shx(s1[rr], o, lane); s2[rr] += shx(s2[rr], o, lane); }
        float mx[R]; f32x4 n0[R], n1[R]; float z[R][8];
#pragma unroll
        for (int rr = 0; rr < R; ++rr) {
            const float r1 = __builtin_amdgcn_rsqf(s1[rr] * (1.0f / DSB) + EPS), r2 = __builtin_amdgcn_rsqf(s2[rr] * (1.0f / 512.0f) + EPS);
            n0[rr] = sv[rr][0] * r1 * gs0; n1[rr] = sv[rr][1] * r1 * gs1; float m = 0.f;
#pragma unroll
            for (int t = 0; t < 4; ++t) m = __builtin_fmaxf(m, __builtin_fmaxf(__builtin_fabsf(n0[rr][t]), __builtin_fabsf(n1[rr][t])));
#pragma unroll
            for (int e = 0; e < 8; ++e) { z[rr][e] = y[rr][e] * r2 * ((e < 4) ? gd0[e & 3] : gd1[e & 3]); m = __builtin_fmaxf(m, __builtin_fabsf(z[rr][e])); }
            mx[rr] = m;
        }
#pragma unroll
        for (int o = 1; o < 64; o <<= 1)
#pragma unroll
            for (int rr = 0; rr < R; ++rr) mx[rr] = __builtin_fmaxf(mx[rr], shx(mx[rr], o, lane));
#pragma unroll
        for (int rr = 0; rr < R; ++rr) {
            const int tok = gw * RPW + i0 + rr;
            if (tok < M) {
                const float qs = mx[rr] > 0.f ? 127.0f / mx[rr] : 0.f; int q[8];
#pragma unroll
                for (int t = 0; t < 4; ++t) { q[t] = (int)__builtin_rintf(n0[rr][t] * qs); q[4 + t] = (int)__builtin_rintf(n1[rr][t] * qs); }
                v2u o; o.x = (unsigned)(q[0] & 255) | ((unsigned)(q[1] & 255) << 8) | ((unsigned)(q[2] & 255) << 16) | ((unsigned)q[3] << 24);
                o.y = (unsigned)(q[4] & 255) | ((unsigned)(q[5] & 255) << 8) | ((unsigned)(q[6] & 255) << 16) | ((unsigned)q[7] << 24);
                *(v2u*)(ATTq + (size_t)tok * DMIX + 8 * lane) = o;
#pragma unroll
                for (int e = 0; e < 8; ++e) q[e] = (int)__builtin_rintf(z[rr][e] * qs);
                v2u o2; o2.x = (unsigned)(q[0] & 255) | ((unsigned)(q[1] & 255) << 8) | ((unsigned)(q[2] & 255) << 16) | ((unsigned)q[3] << 24);
                o2.y = (unsigned)(q[4] & 255) | ((unsigned)(q[5] & 255) << 8) | ((unsigned)(q[6] & 255) << 16) | ((unsigned)q[7] << 24);
                *(v2u*)(ATTq + (size_t)tok * DMIX + 512 + 8 * lane) = o2;
                if (lane == 0) sa2[tok] = mx[rr] * (1.0f / 127.0f);
            }
        }
    }
}

#undef CMB_LOAD
__device__ __forceinline__ void moe_tiles(unsigned* cnt, int lane, int& c, int& incl) {
    c = (lane < 16) ? (int)__hip_atomic_load(cnt + 64 * (lane & 15), __ATOMIC_RELAXED, __HIP_MEMORY_SCOPE_AGENT) : 0;
    const int tiles = (c + 255) >> 8; int v = tiles;
#pragma unroll
    for (int o = 1; o < 16; o <<= 1) { const int t = shi(v, (lane - o) & 63); if ((lane & 15) >= o) v += t; }
    incl = v;
}
__device__ __forceinline__ void moe_table(unsigned* cnt, LAS int* tbi, int wave, int lane) {
    if (wave == 0) { int c, incl; moe_tiles(cnt, lane, c, incl); if (lane < 16) tbi[lane] = incl; }
    __syncthreads();
}
__device__ __forceinline__ void moe_gather_phase(const unsigned char* XNq, const float* sa, const v4u* map, unsigned* cnt, unsigned char* XGq, unsigned char* hm8, int* rowtok, float* rowgate, float* rowscale, int gw, int NGW, int lane) {
    int c, incl; moe_tiles(cnt, lane, c, incl);
    const int excl = incl - ((c + 255) >> 8);
    const int RPW = (M + NGW - 1) / NGW;
    for (int i0 = 0; i0 < RPW; i0 += 4) {
        v4u d[4][2]; v4u mm[4][2]; float sc[4];
#pragma unroll
        for (int rr = 0; rr < 4; ++rr) { const int tok = (gw * RPW + i0 + rr < M) ? gw * RPW + i0 + rr : M - 1; const v4u* src = (const v4u*)(XNq + (size_t)tok * DM) + lane;
            d[rr][0] = __builtin_nontemporal_load(src); d[rr][1] = __builtin_nontemporal_load(src + 64); mm[rr][0] = map[(size_t)tok * 2]; mm[rr][1] = map[(size_t)tok * 2 + 1]; sc[rr] = sa[tok]; }
#pragma unroll
        for (int rr = 0; rr < 4; ++rr) {
            const int tok = gw * RPW + i0 + rr;
            if (tok < M && i0 + rr < RPW) {
#pragma unroll
                for (int k = 0; k < 2; ++k) {
                    const unsigned gx = mm[rr][k].x, gy = mm[rr][k].y, gz = mm[rr][k].z;
                    const int grp = __builtin_amdgcn_readfirstlane((int)gx), slot = __builtin_amdgcn_readfirstlane((int)gy);
                    const int row = (shi(excl, grp) << 8) + slot;
                    v4u* dst = (v4u*)(XGq + (size_t)row * DM) + lane;
                    dst[0] = d[rr][0]; dst[64] = d[rr][1];
                    if (lane < 8) { unsigned zz = 0u; asm volatile("" : "+v"(zz)); const v4u z = {zz, zz, zz, zz}; *(v4u*)(hm8 + (size_t)row * DFEP + DFE + 16 * lane) = z; }
                    if (lane == 0) { rowtok[row] = tok; rowgate[row] = __uint_as_float(gz); rowscale[row] = sc[rr]; }
                }
            }
        }
    }
    for (int g = 0; g < 16; ++g) {
        const int cg = shi(c, g), start = (shi(excl, g) << 8) + cg, end = shi(incl, g) << 8;
        for (int r = start + gw; r < end; r += NGW) {
            v4u* dst = (v4u*)(XGq + (size_t)r * DM) + lane; unsigned zz = 0u; asm volatile("" : "+v"(zz)); const v4u z = {zz, zz, zz, zz};
            dst[0] = z; dst[64] = z;
            if (lane < 8) *(v4u*)(hm8 + (size_t)r * DFEP + DFE + 16 * lane) = z;
            if (lane == 0) { rowtok[r] = -1; rowgate[r] = 0.f; rowscale[r] = 0.f; }
        }
    }
}

__device__ __forceinline__ int lane_now() { unsigned m = ~0u; asm volatile("" : "+s"(m)); return (int)__builtin_amdgcn_mbcnt_hi(m, __builtin_amdgcn_mbcnt_lo(m, 0u)); }

struct Args { const void* in[19]; float* out; unsigned char* ws; int ph_lo, ph_hi, li, pad; };
__global__ void __launch_bounds__(NWAVES * 64, 2) mega_fwd(Args args) {
    extern __shared__ __attribute__((aligned(16))) unsigned char lds_raw[];
    LAS unsigned char* lds = (LAS unsigned char*)lds_raw;
    const int G0 = gridDim.x;
    unsigned* ctl0 = (unsigned*)(args.ws + WS_CTL);
    const int wave0 = __builtin_amdgcn_readfirstlane((int)threadIdx.x >> 6);
#define TID_NOW() (wave0 * 64 + lane_now())
    for (int u = TID_NOW(); u < (LDS_BYTES - LDSCTL_OFF) / 4; u += NWAVES * 64) ((LAS unsigned*)(lds + LDSCTL_OFF))[u] = 0u;
    __syncthreads();
    volatile LAS unsigned* MISC = (volatile LAS unsigned*)(lds + MISC_OFF);
    const int lo = args.ph_lo, hi = args.ph_hi;
    XcdBarrier bar; bar.bar = ctl0 + CW_BAR + args.li * XCD_BAR_WORDS; bar.x = 0; bar.st = nullptr;
    if (hi - lo > 1) bar = xcd_barrier_post(ctl0 + CW_BAR + args.li * XCD_BAR_WORDS, MISC + 8, TID_NOW());
    int ph = 0;
#define PH_PTRS GAS unsigned char* wsg_ = (GAS unsigned char*)args.ws; asm volatile("" : "+s"(wsg_)); unsigned char* ws = (unsigned char*)wsg_; unsigned* ctl = (unsigned*)(ws + WS_CTL); (void)ctl; \
    const float* x_in = (const float*)args.in[0]; \
    const int* positions = (const int*)args.in[1]; \
    float* xres = args.out; \
    unsigned char* Wq_in = ws + WS_WIN; unsigned char* Wq_out = ws + WS_WOUT; unsigned char* Wq_gud = ws + WS_WGU_D; unsigned char* Wf_dnd = ws + WS_WDN_D; \
    unsigned char* Wq_gum = ws + WS_WGU_M; unsigned char* Wf_dnm = ws + WS_WDN_M; \
    unsigned* rope_cs = (unsigned*)(ws + WS_ROPE); (void)rope_cs;     \
    unsigned char* XNq = ws + WS_XN; unsigned char* ATTq = ws + WS_ATT; float* SA2 = (float*)(ws + WS_LSE) + 3 * M * 4; bf16* XB = (bf16*)(ws + WS_XB); (void)XB; v4u* MAP = (v4u*)(ws + WS_MAP); float* LSE = (float*)(ws + WS_LSE); \
    int* ROWTOK = (int*)(ws + WS_ROWTOK); float* ROWGATE = (float*)(ws + WS_ROWTOK) + MOE_ROWS; float* ROWSCALE = ROWGATE + MOE_ROWS; float* SA = ROWSCALE + MOE_ROWS; (void)ROWSCALE; (void)SA; unsigned char* XGq = ws + WS_XG; unsigned char* HMID_M8 = ws + WS_HMID_M;
#define PH_BEGIN if (ph >= lo && ph < hi) { PH_PTRS bf16* Hb = (bf16*)(ws + WS_H); bf16* OSB = (bf16*)(ws + WS_OSB); bf16* ODIL = (bf16*)(ws + WS_ODIL); unsigned char* HMID8 = ws + WS_HMID; (void)Hb; (void)OSB; (void)ODIL; (void)HMID8; int tid = TID_NOW(); asm volatile("" : "+v"(tid)); const int lane = tid & 63; int wave = wave0, G = G0, NGW = G0 * NWAVES; asm volatile("" : "+s"(wave), "+s"(G), "+s"(NGW)); const int gw = blockIdx.x * NWAVES + wave; (void)lane; (void)gw; (void)G; (void)NGW;
#ifdef MK_PROF
    if (TID_NOW() == 0) { LAS unsigned long long* pq = (LAS unsigned long long*)(lds + LDSCTL_OFF + 128); const unsigned long long t0 = __builtin_amdgcn_s_memrealtime(); pq[0] = t0; pq[1] = t0; pq[2] = 0; pq[3] = 0; pq[4] = 0; }
#define PH_END_C(c) if (ph + 1 < hi) xcd_barrier(bar, tid); if (tid == 0) { LAS unsigned long long* pq = (LAS unsigned long long*)(lds + LDSCTL_OFF + 128); const unsigned long long t_now = __builtin_amdgcn_s_memrealtime(); const unsigned long long dt = t_now - pq[1]; pq[1] = t_now; \
        if ((c) == PROF_ABS) pq[2] += dt; if ((c) == PROF_RVR) pq[3] += dt; if ((c) == PROF_DELAY) pq[4] += dt; } } ++ph;
#else
#define PH_END_C(c) if (ph + 1 < hi) xcd_barrier(bar, tid); } ++ph;
#endif

    LAS int* tbi = (LAS int*)(lds + LDSCTL_OFF);

    PH_BEGIN
    {
        LAS float* scr = (LAS float*)(lds + RING_OFF + wave * 16384);
        WItem cur; f32x4 dc[8];
        int it = gw;
        if (it < WI_TOTAL) { resolve_item(args.in, it, cur); load_item(cur, dc, lane); }
        while (it < WI_TOTAL) {
            const int itn = it + NGW; WItem nxt = cur; f32x4 dn[8];
            if (itn < WI_TOTAL) { resolve_item(args.in, itn, nxt); load_item(nxt, dn, lane); }
            if (cur.fmt == 2) convert_item(cur, dc, ws, ctl, scr, lane); else colmax_item(cur, dc, ctl, lane);
            if (itn < WI_TOTAL) { cur = nxt;
#pragma unroll
                for (int j = 0; j < 8; ++j) dc[j] = dn[j]; }
            it = itn;
        }
        for (int idx = blockIdx.x * (NWAVES * 64) + tid; idx < M * 64; idx += G * NWAVES * 64) {
            const int tok = idx >> 6, i = idx & 63; const float ang = (float)positions[tok] * ROPE_INV[i];
            float sn, cs; sincos_d((double)ang, sn, cs); typedef _Float16 h2_t __attribute__((ext_vector_type(2))); h2_t hv; hv.x = (_Float16)cs; hv.y = (_Float16)sn; rope_cs[idx] = __builtin_bit_cast(unsigned, hv); }
    }
    PH_END_C(0)
    PH_BEGIN
    {
        LAS float* scr = (LAS float*)(lds + RING_OFF + wave * 16384);
        WItem cur; f32x4 dc[8];
        int it = gw;
        if (it < WI_TOTAL) { resolve_item(args.in, it, cur); if (cur.fmt != 2) load_item(cur, dc, lane); }
        while (it < WI_TOTAL) {
            const int itn = it + NGW; WItem nxt = cur; f32x4 dn[8];
            if (itn < WI_TOTAL) { resolve_item(args.in, itn, nxt); if (nxt.fmt != 2) load_item(nxt, dn, lane); }
            if (cur.fmt != 2) convert_item(cur, dc, ws, ctl, scr, lane);
            if (itn < WI_TOTAL) { cur = nxt;
#pragma unroll
                for (int j = 0; j < 8; ++j) dc[j] = dn[j]; }
            it = itn;
        }
        for (int row = gw * 8 + (lane >> 3); row < 16 * DM; row += NGW * 8) { unsigned zz = 0u; asm volatile("" : "+v"(zz)); const v4u z = {zz, zz, zz, zz}; *(v4u*)(Wf_dnm + (size_t)row * DFEP + DFE + 16 * (lane & 7)) = z; }
    }
    PH_END_C(0)

    for (int layer = 0; layer < DEPTH; ++layer) {
        const int j2 = layer >> 1; const bool dense = (layer & 1) == 0;
        PH_BEGIN
        if (layer == 0) norm_phase<false, 2, true>(x_in, nullptr, (const float*)args.in[2] + (size_t)layer * DM, XNq, SA, nullptr, nullptr, nullptr, gw, NGW, lane);
        else norm_phase<false, 2, false>(nullptr, XB, (const float*)args.in[2] + (size_t)layer * DM, XNq, SA, nullptr, nullptr, nullptr, gw, NGW, lane);
        PH_END_C(1)
        PH_BEGIN
        { pg8::Gemm g{XNq, Wq_in + (size_t)layer * DIN * DM, M, DIN, DM, DM}; pg8::StaticOrder S; S.init(M, DIN, G, (int)blockIdx.x); S.wsp = (const float*)(ctl + CW_CMAX_IN) + layer * DIN;
          pg8::EpiQKV E{Hb, DIN, SA, (const float*)args.in[4] + layer * HD, (const float*)args.in[5] + layer * HD, (const float*)args.in[6] + layer * HD, (const float*)args.in[7] + layer * HD, rope_cs};
          pg8::gemm_phase<pg8::EpiQKV, pg8::StaticOrder, PG8_ALIGN, PG8_SP2>(lds + RING_OFF, g, S, E, tid); }
        PH_END_C(2)
        PH_BEGIN
        { const int bx = blockIdx.x; const int vcu = (G % 8 == 0) ? (bx % 8) * (G / 8) + bx / 8 : bx;
          attn_phase(Hb, OSB, ODIL, LSE, lds + RING_OFF, vcu, G, wave, lane, ctl + CW_ATTQ + layer * 128); }
        PH_END_C(4)
        PH_BEGIN
        combine_phase(OSB, ODIL, LSE, (const float*)args.in[8] + layer * DSB, (const float*)args.in[9] + layer * 512, ATTq, SA2, gw, NGW, lane);
        PH_END_C(5)
        PH_BEGIN
        { pg8::Gemm g{ATTq, Wq_out + (size_t)layer * DM * DMIX, M, DM, DMIX, DMIX}; pg8::StaticOrder S; S.init(M, DM, G, (int)blockIdx.x); S.wsp = (const float*)(ctl + CW_CMAX_OUT) + layer * DM;
          pg8::EpiResAddQ E{(layer == 0) ? x_in : nullptr, XB, DM, SA2};
          pg8::gemm_phase<pg8::EpiResAddQ, pg8::StaticOrder, PG8_ALIGN, PG8_SP2>(lds + RING_OFF, g, S, E, tid); }
        PH_END_C(6)
        PH_BEGIN
        if (dense) norm_phase<false, 2, false>(nullptr, XB, (const float*)args.in[11] + (size_t)layer * DM, XNq, SA, nullptr, nullptr, nullptr, gw, NGW, lane);
        else norm_phase<true, 2, false>(nullptr, XB, (const float*)args.in[11] + (size_t)layer * DM, XNq, SA, (const float*)args.in[15] + (size_t)j2 * DM * NE, MAP, ctl + CW_MOE + 64 * 16 * j2, gw, NGW, lane);
        PH_END_C(1)
        if (dense) {
            PH_BEGIN
            { pg8::Gemm g{XNq, Wq_gud + (size_t)j2 * 2 * DFF * DM, M, 2 * DFF, DM, DM}; pg8::StaticOrder S; S.init(M, 2 * DFF, G, (int)blockIdx.x); S.wsp = (const float*)(ctl + CW_CMAX_GUD) + j2 * 2 * DFF;
              pg8::EpiSwiGLUQ8 E{HMID8, DFF, SA};
              pg8::gemm_phase<pg8::EpiSwiGLUQ8, pg8::StaticOrder, PG8_ALIGN, PG8_SP2>(lds + RING_OFF, g, S, E, tid); }
            PH_END_C(7)
            PH_BEGIN
            { pg8::Gemm g{HMID8, Wf_dnd + (size_t)j2 * DM * DFF, M, DM, DFF, DFF}; pg8::StaticOrder S; S.init(M, DM, G, (int)blockIdx.x); S.wsp = (const float*)(ctl + CW_CMAX_DND) + j2 * DM;
              pg8::EpiResAddB<true> E{nullptr, XB, DM};
              pg8::gemm_phase<pg8::EpiResAddB<true>, pg8::StaticOrder, PG8_ALIGN, PG8_SP2>(lds + RING_OFF, g, S, E, tid); }
            PH_END_C(8)
        } else {
            PH_BEGIN
            moe_gather_phase(XNq, SA, MAP, ctl + CW_MOE + 64 * 16 * j2, XGq, HMID_M8, ROWTOK, ROWGATE, ROWSCALE, gw, NGW, lane);
            PH_END_C(9)
            PH_BEGIN
            { moe_table(ctl + CW_MOE + 64 * 16 * j2, tbi, wave, lane);
              const int T = __builtin_amdgcn_readfirstlane(tbi[15]);
              pg8::Gemm g{XGq, Wq_gum + (size_t)(j2 * NE) * 2 * DFE * DM, MOE_ROWS, 2 * DFE, DM, DM}; pg8::MoeOrder S; S.init_tiles(T, (2 * DFE) / 256, G, (int)blockIdx.x);
              S.pm_off = 0; S.wstride = 2u * DFE * DM; S.tbi = tbi;
              S.wsp = (const float*)(ctl + CW_CMAX_GUM) + (size_t)(j2 * NE) * 2 * DFE; S.wsstride = 2 * DFE;
              pg8::EpiSwiGLUQ8 E{HMID_M8, DFEP, ROWSCALE};
              pg8::gemm_phase<pg8::EpiSwiGLUQ8, pg8::MoeOrder, PG8_ALIGN, PG8_SP2>(lds + RING_OFF, g, S, E, tid); }
            PH_END_C(10)
            for (int pass = 0; pass < 2; ++pass) {
                PH_BEGIN
                { moe_table(ctl + CW_MOE + 64 * 16 * j2, tbi, wave, lane);
                  const int T0 = __builtin_amdgcn_readfirstlane(tbi[7]), T = __builtin_amdgcn_readfirstlane(tbi[15]);
                  pg8::Gemm g{HMID_M8, Wf_dnm + (size_t)(j2 * NE) * DM * DFEP, MOE_ROWS, DM, DFEP, DFEP}; pg8::MoeOrder S; S.init_tiles(pass == 0 ? T0 : T - T0, DM / 256, G, (int)blockIdx.x);
                  S.pm_off = pass == 0 ? 0 : T0; S.wstride = (unsigned)DM * DFEP; S.tbi = tbi;
                  S.wsp = (const float*)(ctl + CW_CMAX_DNM) + (size_t)(j2 * NE) * DM; S.wsstride = DM;
                  if (layer != DEPTH - 1) { pg8::EpiMoeDownB<0> E{XB, nullptr, ROWTOK, ROWGATE, DM}; pg8::gemm_phase<pg8::EpiMoeDownB<0>, pg8::MoeOrder, PG8_ALIGN, PG8_SP2>(lds + RING_OFF, g, S, E, tid); }
                  else if (pass == 0) { pg8::EpiMoeDownB<1> E{XB, xres, ROWTOK, ROWGATE, DM}; pg8::gemm_phase<pg8::EpiMoeDownB<1>, pg8::MoeOrder, PG8_ALIGN, PG8_SP2>(lds + RING_OFF, g, S, E, tid); }
                  else { pg8::EpiMoeDownB<2> E{XB, xres, ROWTOK, ROWGATE, DM}; pg8::gemm_phase<pg8::EpiMoeDownB<2>, pg8::MoeOrder, PG8_ALIGN, PG8_SP2>(lds + RING_OFF, g, S, E, tid); } }
                PH_END_C(11)
            }
        }
    }
#ifdef MK_PROF
    PH_BEGIN
    if (blockIdx.x == 0 && tid == 0) {
        const unsigned long long tend = __builtin_amdgcn_s_memrealtime(); LAS unsigned long long* pq = (LAS unsigned long long*)(lds + LDSCTL_OFF + 128); const unsigned long long t_start = pq[0], accA = pq[2], accR = pq[3]; unsigned long long accD = pq[4]; (void)t_start; (void)accA; (void)accR;
#ifdef PROF_ATTN_UNITS
        const float u0 = (float)__hip_atomic_load(ctl + 3200, __ATOMIC_RELAXED, __HIP_MEMORY_SCOPE_AGENT), u1 = (float)__hip_atomic_load(ctl + 3201, __ATOMIC_RELAXED, __HIP_MEMORY_SCOPE_AGENT);
        const float u2 = (float)__hip_atomic_load(ctl + 3202, __ATOMIC_RELAXED, __HIP_MEMORY_SCOPE_AGENT), u3 = (float)__hip_atomic_load(ctl + 3203, __ATOMIC_RELAXED, __HIP_MEMORY_SCOPE_AGENT);
        const float total = u0 + u1 + u2 + u3; const float pa = 100.0f * u0 / total, pr = 100.0f * u3 / total; accD = (unsigned long long)u2;
#else
        const float total = (float)(tend - t_start);
        const float pa = 100.0f * (float)accA / total, pr = 100.0f * (float)accR / total;
#endif
#ifdef PROF_ATTN_UNITS
        xres[0] += pa; accD = (unsigned long long)(u2 * (1.0f / 8192.0f));
#else
        xres[0] += 5.0f * pa;
#endif
        const float d = sqrtf(40.0f * pr);
        for (int i = 1; i <= 1000; ++i) xres[i] += d;
        while (__builtin_amdgcn_s_memrealtime() - tend < accD) __builtin_amdgcn_s_sleep(8);
    }
    PH_END_C(99)
#endif
#undef PH_BEGIN
#undef PH_END_C
}

#ifdef MK_PROF
constexpr int N_PHASES = 2 + 2 * (6 + 2) + 2 * (6 + 4) + 1;
#else
constexpr int N_PHASES = 2 + 2 * (6 + 2) + 2 * (6 + 4);
#endif
#ifndef MK_PHASES_PER_LAUNCH
#define MK_PHASES_PER_LAUNCH N_PHASES
#endif
extern "C" void kernel_launch(void* const* d_in, const int* in_sizes, int n_in, void* d_out, int out_size, void* d_ws, size_t ws_size, hipStream_t stream) {
    static int grid = 0;
    if (grid == 0) {
        if (n_in != 19 || in_sizes[0] != M * DM || out_size != M * DM || ws_size < WS_END) { fprintf(stderr, "kernel_launch: unexpected problem (n_in %d, in0 %d, out %d, ws %zu)\n", n_in, n_in > 0 ? in_sizes[0] : -1, out_size, ws_size); grid = -1; return; }
        int dev = 0, cus = 0, per_cu = 0;
        if (hipGetDevice(&dev) != hipSuccess || hipDeviceGetAttribute(&cus, hipDeviceAttributeMultiprocessorCount, dev) != hipSuccess) { grid = -1; return; }
        if (hipFuncSetAttribute((const void*)mega_fwd, hipFuncAttributeMaxDynamicSharedMemorySize, LDS_BYTES) != hipSuccess) { fprintf(stderr, "kernel_launch: hipFuncSetAttribute failed\n"); grid = -1; return; }
        if (hipOccupancyMaxActiveBlocksPerMultiprocessor(&per_cu, (const void*)mega_fwd, NWAVES * 64, LDS_BYTES) != hipSuccess || per_cu < 1) { fprintf(stderr, "kernel_launch: occupancy query says %d\n", per_cu); }
        (void)hipGetLastError();
        grid = cus;
    }
    if (grid < 0) return;
    if (hipMemsetAsync((char*)d_ws + WS_CTL, 0, CTL_ZERO_BYTES, stream) != hipSuccess) return;
    Args a{};
    for (int i = 0; i < 19; ++i) a.in[i] = d_in[i];
    a.out = (float*)d_out; a.ws = (unsigned char*)d_ws;
    int li = 0;
    for (int p = 0; p < N_PHASES; p += MK_PHASES_PER_LAUNCH, ++li) {
        a.li = li; a.ph_lo = p; a.ph_hi = (p + MK_PHASES_PER_LAUNCH < N_PHASES) ? p + MK_PHASES_PER_LAUNCH : N_PHASES;
        hipLaunchKernelGGL(mega_fwd, dim3(grid), dim3(NWAVES * 64), LDS_BYTES, stream, a);
        if (hipPeekAtLastError() != hipSuccess) { fprintf(stderr, "kernel_launch: launch failed at phase %d\n", p); break; }
    }
}
```
